# Optimizing an MI355X kernel written in HIP

```python
import math
import jax, jax.numpy as jnp
from jax import lax
import numpy as np

D_MODEL = 1024
BATCH = 1
SEQ = 16384
DEPTH = 1

GLA_HEADS = 4
GLA_DK = 64
GLA_DV = 128
GLA_LOWRANK = 16
GLA_TAU = 16.0
GLA_CHUNK = 64
MOBA_HEADS = 8
MOBA_HD = 64
MOBA_BLOCK = 256
MOBA_TOPK = 3
Q_BLOCK = 128
REL_BUCKETS = 32
REL_MAX_DIST = 4096
D_FF = 2816
D_PLE = 256
EPS = 1e-6
NEG = -1e30

GLA_QK = GLA_HEADS * GLA_DK
GLA_V = GLA_HEADS * GLA_DV
MOBA_W = MOBA_HEADS * MOBA_HD
MIX_WIDTH = GLA_V + MOBA_W
IN_SIZES = (GLA_QK, GLA_QK, GLA_V, GLA_V, GLA_LOWRANK, MOBA_W, MOBA_W, MOBA_W)
IN_WIDTH = 2 * GLA_QK + 2 * GLA_V + GLA_LOWRANK + 3 * MOBA_W

kernel_name = "hymba_gla_moba_macaron_t5bias_ple"


def rmsnorm(x, g):
    xf = x.astype(jnp.float32)
    y = xf * lax.rsqrt(jnp.mean(xf * xf, axis=-1, keepdims=True) + EPS)
    return (y * g.astype(jnp.float32)).astype(x.dtype)


def swiglu(x, w_gu, w_down):
    gate, up = jnp.split(x @ w_gu, 2, axis=-1)
    return (jax.nn.silu(gate) * up) @ w_down


def rel_bucket(dist):
    n = jnp.maximum(dist, 0)
    max_exact = REL_BUCKETS // 2
    nf = jnp.maximum(n, 1).astype(jnp.float32)
    large = max_exact + (jnp.log(nf / max_exact) / math.log(REL_MAX_DIST / max_exact)
                         * (REL_BUCKETS - max_exact)).astype(jnp.int32)
    large = jnp.minimum(large, REL_BUCKETS - 1)
    return jnp.where(n < max_exact, n, large)


def gla_chunked(q, k, v, log_a):
    B, H, T, dk = q.shape
    dv = v.shape[-1]
    C = GLA_CHUNK
    n = T // C

    def to_chunks(t):
        return t.astype(jnp.float32).reshape(B, H, n, C, t.shape[-1]).transpose(2, 0, 1, 3, 4)

    qc, kc, vc, ac = to_chunks(q), to_chunks(k), to_chunks(v), to_chunks(log_a)
    causal = jnp.tril(jnp.ones((C, C), dtype=bool))[:, :, None]

    def step(S, inp):
        qi, ki, vi, ai = inp
        b = jnp.cumsum(ai, axis=-2)
        b_last = b[..., -1:, :]
        o_inter = jnp.einsum('bhcd,bhde->bhce', qi * jnp.exp(b), S)
        diff = b[..., :, None, :] - b[..., None, :, :]
        decay = jnp.exp(jnp.where(causal, diff, -jnp.inf))
        attn = jnp.einsum('bhid,bhjd,bhijd->bhij', qi, ki, decay)
        o_intra = jnp.einsum('bhij,bhje->bhie', attn, vi)
        S_new = (jnp.exp(b_last)[..., 0, :, None] * S
                 + jnp.einsum('bhcd,bhce->bhde', ki * jnp.exp(b_last - b), vi))
        return S_new, o_inter + o_intra

    S0 = jnp.zeros((B, H, dk, dv), jnp.float32)
    _, o = lax.scan(step, S0, (qc, kc, vc, ac))
    return o.transpose(1, 2, 0, 3, 4).reshape(B, H, T, dv).astype(v.dtype)


def moba_attention(q, k, v, rel_bias):
    B, H, T, hd = q.shape
    nb = -(-T // MOBA_BLOCK)
    pad = nb * MOBA_BLOCK - T
    kb = jnp.pad(k, ((0, 0), (0, 0), (0, pad), (0, 0))).reshape(B, H, nb, MOBA_BLOCK, hd)
    vb = jnp.pad(v, ((0, 0), (0, 0), (0, pad), (0, 0))).reshape(B, H, nb, MOBA_BLOCK, hd)
    k_mean = jnp.mean(kb.astype(jnp.float32), axis=3)
    topk = min(MOBA_TOPK, nb)
    scale = hd ** -0.5
    bias_tab = rel_bias.astype(jnp.float32).T
    bi = jnp.arange(B)[:, None, None, None]
    hi = jnp.arange(H)[None, :, None, None]
    blk_off = jnp.arange(MOBA_BLOCK)
    nq = T // Q_BLOCK
    qs = q.reshape(B, H, nq, Q_BLOCK, hd).transpose(2, 0, 1, 3, 4)

    def per_block(args):
        qi, iq = args
        qpos = iq * Q_BLOCK + jnp.arange(Q_BLOCK)
        own = (iq * Q_BLOCK) // MOBA_BLOCK
        gate = jnp.einsum('bhqd,bhnd->bhqn', qi.astype(jnp.float32), k_mean)
        gate = jnp.where(jnp.arange(nb) < own, gate, -jnp.inf)
        _, sel = lax.top_k(gate, topk)
        valid = sel < own
        k_sel = kb[bi, hi, sel]
        v_sel = vb[bi, hi, sel]
        s_past = jnp.einsum('bhqd,bhqnsd->bhqns', qi, k_sel,
                            preferred_element_type=jnp.float32) * scale
        kpos = sel[..., None] * MOBA_BLOCK + blk_off
        s_past = s_past + bias_tab[hi[..., None], rel_bucket(qpos[:, None, None] - kpos)]
        s_past = jnp.where(valid[..., None], s_past, NEG).reshape(B, H, Q_BLOCK, topk * MOBA_BLOCK)
        k_own = lax.dynamic_index_in_dim(kb, own, axis=2, keepdims=False)
        v_own = lax.dynamic_index_in_dim(vb, own, axis=2, keepdims=False)
        dist_own = qpos[:, None] - (own * MOBA_BLOCK + blk_off)[None, :]
        s_own = (jnp.einsum('bhqd,bhsd->bhqs', qi, k_own, preferred_element_type=jnp.float32) * scale
                 + bias_tab[:, rel_bucket(dist_own)])
        s_own = jnp.where(dist_own >= 0, s_own, NEG)
        probs = jax.nn.softmax(jnp.concatenate([s_past, s_own], axis=-1), axis=-1)
        p_past = probs[..., :topk * MOBA_BLOCK].reshape(B, H, Q_BLOCK, topk, MOBA_BLOCK).astype(v.dtype)
        p_own = probs[..., topk * MOBA_BLOCK:].astype(v.dtype)
        o = (jnp.einsum('bhqns,bhqnsd->bhqd', p_past, v_sel, preferred_element_type=jnp.float32)
             + jnp.einsum('bhqs,bhsd->bhqd', p_own, v_own, preferred_element_type=jnp.float32))
        return o.astype(q.dtype)

    o = lax.map(per_block, (qs, jnp.arange(nq)))
    return o.transpose(1, 2, 0, 3, 4).reshape(B, H, T, hd)


def hybrid_mixer(xn, w_in, w_gk_up, b_gk, gla_out_norm, w_out, rel_bias):
    B, T, _ = xn.shape
    split_points = np.cumsum(IN_SIZES)[:-1].tolist()
    q_g, k_g, v_g, g_g, gk_lr, q_m, k_m, v_m = jnp.split(xn @ w_in, split_points, axis=-1)

    def heads(t, nh):
        return t.reshape(B, T, nh, -1).transpose(0, 2, 1, 3)

    log_a = jax.nn.log_sigmoid((gk_lr @ w_gk_up + b_gk).astype(jnp.float32)) / GLA_TAU
    o_g = gla_chunked(heads(q_g, GLA_HEADS) * (GLA_DK ** -0.5), heads(k_g, GLA_HEADS),
                      heads(v_g, GLA_HEADS), heads(log_a, GLA_HEADS))
    o_g = rmsnorm(o_g, gla_out_norm)
    o_g = o_g.transpose(0, 2, 1, 3).reshape(B, T, GLA_V) * jax.nn.silu(g_g)
    o_m = moba_attention(heads(q_m, MOBA_HEADS), heads(k_m, MOBA_HEADS), heads(v_m, MOBA_HEADS), rel_bias)
    o_m = o_m.transpose(0, 2, 1, 3).reshape(B, T, MOBA_W)
    return jnp.concatenate([o_g, o_m], axis=-1) @ w_out


def setup_inputs(seed: int = 0) -> dict:
    key = jax.random.key(seed)
    ks = jax.random.split(key, 24)
    f32 = jnp.float32

    def w(k, shape, fan_in):
        return jax.random.normal(k, shape, f32) * (fan_in ** -0.5)

    def gain(k, shape):
        return 1.0 + 0.02 * jax.random.normal(k, shape, f32)

    L = DEPTH
    return {
        "x": jax.random.normal(ks[0], (BATCH, SEQ, D_MODEL), f32),
        "p": jax.random.normal(ks[1], (DEPTH, BATCH, SEQ, D_PLE), f32),
        "ffn1_norm": gain(ks[2], (L, D_MODEL)),
        "ffn1_w_gu": w(ks[3], (L, D_MODEL, 2 * D_FF), D_MODEL),
        "ffn1_w_down": w(ks[4], (L, D_FF, D_MODEL), D_FF),
        "mix_norm": gain(ks[5], (L, D_MODEL)),
        "w_in": w(ks[6], (L, D_MODEL, IN_WIDTH), D_MODEL),
        "w_gk_up": w(ks[7], (L, GLA_LOWRANK, GLA_QK), GLA_LOWRANK),
        "b_gk": 0.01 * jax.random.normal(ks[8], (L, GLA_QK), f32),
        "gla_out_norm": gain(ks[9], (L, GLA_DV)),
        "w_out": w(ks[10], (L, MIX_WIDTH, D_MODEL), MIX_WIDTH),
        "ffn2_norm": gain(ks[11], (L, D_MODEL)),
        "ffn2_w_gu": w(ks[12], (L, D_MODEL, 2 * D_FF), D_MODEL),
        "ffn2_w_down": w(ks[13], (L, D_FF, D_MODEL), D_FF),
        "ple_norm": gain(ks[14], (L, D_MODEL)),
        "w_ple_gate": w(ks[15], (L, D_MODEL, D_MODEL), D_MODEL),
        "w_ple_proj": w(ks[16], (L, D_PLE, D_MODEL), D_PLE),
        "rel_bias": 0.2 * jax.random.normal(ks[17], (REL_BUCKETS, MOBA_HEADS), f32),
        "final_norm": gain(ks[18], (D_MODEL,)),
    }


def reference(x, p, ffn1_norm, ffn1_w_gu, ffn1_w_down, mix_norm, w_in, w_gk_up, b_gk,
              gla_out_norm, w_out, ffn2_norm, ffn2_w_gu, ffn2_w_down, ple_norm,
              w_ple_gate, w_ple_proj, rel_bias, final_norm):
    h = x
    for i in range(DEPTH):
        h = h + 0.5 * swiglu(rmsnorm(h, ffn1_norm[i]), ffn1_w_gu[i], ffn1_w_down[i])
        h = h + hybrid_mixer(rmsnorm(h, mix_norm[i]), w_in[i], w_gk_up[i], b_gk[i],
                             gla_out_norm[i], w_out[i], rel_bias)
        h = h + 0.5 * swiglu(rmsnorm(h, ffn2_norm[i]), ffn2_w_gu[i], ffn2_w_down[i])
        ple_gate = jax.nn.sigmoid(rmsnorm(h, ple_norm[i]) @ w_ple_gate[i])
        h = h + ple_gate * (p[i] @ w_ple_proj[i])
    return rmsnorm(h, final_norm)
```

```cpp
#include <hip/hip_runtime.h>
#include <cstdio>
#include <cstdint>
namespace pg8 {
#define PG8_LAS __attribute__((address_space(3)))
typedef unsigned short bf16_t;
typedef short bf16x8 __attribute__((ext_vector_type(8)));
typedef float f32x4 __attribute__((ext_vector_type(4)));
typedef unsigned u32x4 __attribute__((ext_vector_type(4)));
constexpr int BM = 256, BK = 64, HALF = 128, HTB = HALF * BK * 2  , STAGE_BYTES = 8 * HTB, NXCD = 8, WGM = 8;

__host__ __device__ __forceinline__ int lds_byte(int r, int c) { const int st = (r >> 4) * 2 + (c >> 5), rr = r & 15, cc = c & 31, ob = rr * 64 + cc * 2; return st * 1024 + (ob ^ (((ob >> 9) & 1) << 5)); }
__host__ __device__ __forceinline__ void stage_rc(int b, int& R, int& C) { const int st = b / 1024, sb = b % 1024, swz = sb ^ (((sb >> 9) & 1) << 5); R = (st >> 1) * 16 + swz / 64; C = (st & 1) * 32 + (swz % 64) / 2; }
__host__ __device__ __forceinline__ int perm32(int rho) { const int n = rho >> 4, i = rho & 15; return 8 * (i >> 2) + 4 * n + (i & 3); }

struct Unit { int pm, pn; };
struct Gemm { const bf16_t* A; const bf16_t* Bt; int M, N, K; };

struct StaticOrder {
    int nM, nN, nwg, G, c;
    __host__ __device__ void init(int M, int N, int G_, int c_) { nM = M / BM; nN = N / BM; nwg = nM * nN; G = G_; c = c_; }
    __host__ __device__ bool next(int i, Unit& u) const {
        const long L = (long)i * G + c; if (L >= nwg) return false;
        int wgid = (int)L; { const int q = nwg / NXCD, r = nwg % NXCD, xcd = wgid % NXCD, off = wgid / NXCD; wgid = (xcd < r ? xcd * (q + 1) : r * (q + 1) + (xcd - r) * q) + off; }
        const int nig = WGM * nN, gid = wgid / nig, fm = gid * WGM, gsz = (nM - fm) < WGM ? (nM - fm) : WGM;
        u.pm = fm + ((wgid % nig) % gsz); u.pn = (wgid % nig) / gsz; return true;
    }
    __device__ __forceinline__ void a_ready(const Unit&) const {}
    __device__ __forceinline__ void done(const Unit&) const {}
};

__device__ __forceinline__ unsigned cvt_pk_bf16(float lo, float hi) { unsigned r; asm volatile("v_cvt_pk_bf16_f32 %0, %1, %2" : "=v"(r) : "v"(lo), "v"(hi)); return r; }
__device__ __forceinline__ float bf_lo(unsigned w) { return __uint_as_float(w << 16); }
__device__ __forceinline__ float bf_hi(unsigned w) { return __uint_as_float(w & 0xffff0000u); }
constexpr float RMS_EPS = 1e-6f;
__device__ __forceinline__ float row_rstd(const float* ssqp, int r, int fq) {
    const f32x4 p = *(const f32x4*)(ssqp + (size_t)r * 16 + 4 * fq);
    float s = (p[0] + p[1]) + (p[2] + p[3]);
    s += __shfl_xor(s, 16); s += __shfl_xor(s, 32);
    return __builtin_amdgcn_rsqf(s * (1.0f / 1024.0f) + RMS_EPS);
}
__device__ __forceinline__ float fast_sigmoid(float x) { return __builtin_amdgcn_rcpf(1.0f + __builtin_amdgcn_exp2f(-1.4426950408889634f * x)); }
struct EpiSwiGLU {
    static constexpr bool PERM = true, AFTER_DRAIN = false;
    bf16_t* O; int ldc; const float* ssqp;
    __device__ __forceinline__ void operator()(const f32x4 (&acc)[2][2][4][2], const Unit& u, int wr, int wc, int fr, int fq) const {
        const int row0 = u.pm * BM + wr * 64 + fr, col0 = u.pn * HALF + wc * 32 + 8 * fq;
#pragma unroll
        for (int ai = 0; ai < 2; ++ai)
#pragma unroll
            for (int m = 0; m < 4; ++m) { const int r = row0 + ai * HALF + m * 16; const float rs = row_rstd(ssqp, r, fq);
                float h[8];
#pragma unroll
                for (int n = 0; n < 2; ++n)
#pragma unroll
                    for (int j = 0; j < 4; ++j) { const float g = acc[ai][0][m][n][j] * rs, up = acc[ai][1][m][n][j] * rs; h[n * 4 + j] = g * fast_sigmoid(g) * up; }
                u32x4 w; w.x = cvt_pk_bf16(h[0], h[1]); w.y = cvt_pk_bf16(h[2], h[3]); w.z = cvt_pk_bf16(h[4], h[5]); w.w = cvt_pk_bf16(h[6], h[7]);
                *(u32x4*)(O + (size_t)r * ldc + col0) = w; }
    }
};
template <int HALF_ALPHA> struct EpiResid {
    static constexpr bool PERM = true, AFTER_DRAIN = false; static constexpr float alpha = HALF_ALPHA ? 0.5f : 1.0f;
    const float* base; float* out; bf16_t* ob; float* ssq_out;
    __device__ __forceinline__ void operator()(const f32x4 (&acc)[2][2][4][2], const Unit& u, int wr, int wc, int fr, int fq) const {
        const int row0 = u.pm * BM + wr * 64 + fr, col0 = u.pn * BM + wc * 32 + 8 * fq;
#pragma unroll
        for (int ai = 0; ai < 2; ++ai)
#pragma unroll
            for (int m = 0; m < 4; ++m) { const int r = row0 + ai * HALF + m * 16; float ss = 0.f;
#pragma unroll
                for (int bj = 0; bj < 2; ++bj) { const size_t off = (size_t)r * 1024 + col0 + bj * HALF;
                    const f32x4 b0 = *(const f32x4*)(base + off), b1 = *(const f32x4*)(base + off + 4);
                    const f32x4 v0 = b0 + acc[ai][bj][m][0] * alpha, v1 = b1 + acc[ai][bj][m][1] * alpha;
                    *(f32x4*)(out + off) = v0; *(f32x4*)(out + off + 4) = v1;
                    u32x4 w; w.x = cvt_pk_bf16(v0[0], v0[1]); w.y = cvt_pk_bf16(v0[2], v0[3]); w.z = cvt_pk_bf16(v1[0], v1[1]); w.w = cvt_pk_bf16(v1[2], v1[3]);
                    *(u32x4*)(ob + off) = w;
                    ss += (v0[0] * v0[0] + v0[1] * v0[1]) + (v0[2] * v0[2] + v0[3] * v0[3]) + (v1[0] * v1[0] + v1[1] * v1[1]) + (v1[2] * v1[2] + v1[3] * v1[3]); }
                ss += __shfl_xor(ss, 16); ss += __shfl_xor(ss, 32);
                if (fq == 0) ssq_out[(size_t)r * 16 + 4 * u.pn + wc] = ss; }
    }
};
constexpr int UW = 3328;
struct EpiWin {
    static constexpr bool PERM = true, AFTER_DRAIN = false;
    bf16_t* U; float* loga; const float* ssqp; const float* bgk;
    __device__ __forceinline__ void operator()(const f32x4 (&acc)[2][2][4][2], const Unit& u, int wr, int wc, int fr, int fq) const {
        const int row0 = u.pm * BM + wr * 64 + fr, cl0 = wc * 32 + 8 * fq;
        const float sc = (u.pn == 0) ? 0.125f : 1.0f;
#pragma unroll
        for (int ai = 0; ai < 2; ++ai)
#pragma unroll
            for (int m = 0; m < 4; ++m) { const int r = row0 + ai * HALF + m * 16; const float rs = row_rstd(ssqp, r, fq);
#pragma unroll
                for (int bj = 0; bj < 2; ++bj) { const int cl = cl0 + bj * HALF;
                    const f32x4 v0 = acc[ai][bj][m][0] * rs, v1 = acc[ai][bj][m][1] * rs;
                    if (u.pn == 6) {
                        const f32x4 c0 = *(const f32x4*)(bgk + cl), c1 = *(const f32x4*)(bgk + cl + 4); f32x4 o0, o1;
#pragma unroll
                        for (int j = 0; j < 4; ++j) { const float x0 = v0[j] + c0[j], x1 = v1[j] + c1[j];
                            o0[j] = (fminf(x0, 0.f) - log1pf(__expf(-fabsf(x0)))) * (1.0f / 16.0f); o1[j] = (fminf(x1, 0.f) - log1pf(__expf(-fabsf(x1)))) * (1.0f / 16.0f); }
                        *(f32x4*)(loga + (size_t)r * 256 + cl) = o0; *(f32x4*)(loga + (size_t)r * 256 + cl + 4) = o1;
                    } else {
                        u32x4 w; w.x = cvt_pk_bf16(v0[0] * sc, v0[1] * sc); w.y = cvt_pk_bf16(v0[2] * sc, v0[3] * sc); w.z = cvt_pk_bf16(v1[0] * sc, v1[1] * sc); w.w = cvt_pk_bf16(v1[2] * sc, v1[3] * sc);
                        *(u32x4*)(U + (size_t)r * UW + u.pn * BM + cl) = w; } } }
    }
};
struct EpiPlain {
    static constexpr bool PERM = true, AFTER_DRAIN = false;
    bf16_t* O;
    __device__ __forceinline__ void operator()(const f32x4 (&acc)[2][2][4][2], const Unit& u, int wr, int wc, int fr, int fq) const {
        const int row0 = u.pm * BM + wr * 64 + fr, col0 = u.pn * BM + wc * 32 + 8 * fq;
#pragma unroll
        for (int ai = 0; ai < 2; ++ai)
#pragma unroll
            for (int m = 0; m < 4; ++m) { const int r = row0 + ai * HALF + m * 16;
#pragma unroll
                for (int bj = 0; bj < 2; ++bj) { const f32x4 v0 = acc[ai][bj][m][0], v1 = acc[ai][bj][m][1];
                    u32x4 w; w.x = cvt_pk_bf16(v0[0], v0[1]); w.y = cvt_pk_bf16(v0[2], v0[3]); w.z = cvt_pk_bf16(v1[0], v1[1]); w.w = cvt_pk_bf16(v1[2], v1[3]);
                    *(u32x4*)(O + (size_t)r * 1024 + col0 + bj * HALF) = w; } }
    }
};
struct EpiPle {
    static constexpr bool PERM = true, AFTER_DRAIN = false;
    const float* base; float* out; const bf16_t* pp; const float* ssqp; float* ssq_out;
    __device__ __forceinline__ void operator()(const f32x4 (&acc)[2][2][4][2], const Unit& u, int wr, int wc, int fr, int fq) const {
        const int row0 = u.pm * BM + wr * 64 + fr, col0 = u.pn * BM + wc * 32 + 8 * fq;
#pragma unroll
        for (int ai = 0; ai < 2; ++ai)
#pragma unroll
            for (int m = 0; m < 4; ++m) { const int r = row0 + ai * HALF + m * 16; const float rs = row_rstd(ssqp, r, fq); float ss = 0.f;
#pragma unroll
                for (int bj = 0; bj < 2; ++bj) { const size_t off = (size_t)r * 1024 + col0 + bj * HALF;
                    const f32x4 b0 = *(const f32x4*)(base + off), b1 = *(const f32x4*)(base + off + 4);
                    const u32x4 pw = *(const u32x4*)(pp + off);
                    f32x4 v0, v1;
                    v0[0] = b0[0] + fast_sigmoid(acc[ai][bj][m][0][0] * rs) * bf_lo(pw.x); v0[1] = b0[1] + fast_sigmoid(acc[ai][bj][m][0][1] * rs) * bf_hi(pw.x);
                    v0[2] = b0[2] + fast_sigmoid(acc[ai][bj][m][0][2] * rs) * bf_lo(pw.y); v0[3] = b0[3] + fast_sigmoid(acc[ai][bj][m][0][3] * rs) * bf_hi(pw.y);
                    v1[0] = b1[0] + fast_sigmoid(acc[ai][bj][m][1][0] * rs) * bf_lo(pw.z); v1[1] = b1[1] + fast_sigmoid(acc[ai][bj][m][1][1] * rs) * bf_hi(pw.z);
                    v1[2] = b1[2] + fast_sigmoid(acc[ai][bj][m][1][2] * rs) * bf_lo(pw.w); v1[3] = b1[3] + fast_sigmoid(acc[ai][bj][m][1][3] * rs) * bf_hi(pw.w);
                    *(f32x4*)(out + off) = v0; *(f32x4*)(out + off + 4) = v1;
                    ss += (v0[0] * v0[0] + v0[1] * v0[1]) + (v0[2] * v0[2] + v0[3] * v0[3]) + (v1[0] * v1[0] + v1[1] * v1[1]) + (v1[2] * v1[2] + v1[3] * v1[3]); }
                ss += __shfl_xor(ss, 16); ss += __shfl_xor(ss, 32);
                if (fq == 0) ssq_out[(size_t)r * 16 + 4 * u.pn + wc] = ss; }
    }
};
template <class Epi, class Sched, bool ALIGN_EPI = false, bool SP2 = false>
__device__ __forceinline__ void gemm_phase(PG8_LAS unsigned char* lds, const Gemm g, const Sched& S, const Epi& E) {
    const int tid = threadIdx.x, wid = __builtin_amdgcn_readfirstlane(tid >> 6), lane = tid & 63, wr = wid >> 2, wc = wid & 3, fr = lane & 15, fq = lane >> 4;
    const int K = g.K, nt = K / BK;
    unsigned voffA[2], voffB[2];
#pragma unroll
    for (int i = 0; i < 2; ++i) { int R, C; stage_rc(tid * 16 + i * 8192, R, C); const int Rb = Epi::PERM ? ((R & ~31) + perm32(R & 31)) : R;
        voffA[i] = (unsigned)(R * K + C) * 2u; voffB[i] = (unsigned)(Rb * K + C) * 2u; }
    const size_t kstep = (size_t)(BK * 2);
    const size_t hstep = (size_t)HALF * K * 2;
    const size_t tstep = 2 * hstep;
    const unsigned ldsw = (unsigned)wid * 1024u;
    const int aoff = lds_byte(wr * 64 + fr, fq * 8), boff = lds_byte(wc * 32 + fr, fq * 8);
#define PG8_SA(b, h) (((b) * 2 + (h)) * HTB)
#define PG8_SB(b, h) ((4 + (b) * 2 + (h)) * HTB)
#define PG8_STAGE(bufoff, gbase, voff) do { _Pragma("unroll") for (int _i = 0; _i < 2; ++_i) \
        __builtin_amdgcn_global_load_lds((const unsigned*)((const char*)(gbase) + (voff)[_i]), (PG8_LAS unsigned*)(lds + (bufoff) + ldsw + _i * 8192), 16, 0, 0); } while (0)
#define PG8_LDA(dst, b, h) do { _Pragma("unroll") for (int m = 0; m < 4; ++m) _Pragma("unroll") for (int k = 0; k < 2; ++k) dst[m][k] = *(const PG8_LAS bf16x8*)(lds + PG8_SA(b, h) + aoff + m * 2048 + k * 1024); } while (0)
#define PG8_LDB(dst, b, h) do { _Pragma("unroll") for (int n = 0; n < 2; ++n) _Pragma("unroll") for (int k = 0; k < 2; ++k) dst[n][k] = *(const PG8_LAS bf16x8*)(lds + PG8_SB(b, h) + boff + n * 2048 + k * 1024); } while (0)
#define PG8_MMA(ai, bj, At, Bt) do { __builtin_amdgcn_s_setprio(1); _Pragma("unroll") for (int m = 0; m < 4; ++m) _Pragma("unroll") for (int n = 0; n < 2; ++n) _Pragma("unroll") for (int k = 0; k < 2; ++k) \
        acc[ai][bj][m][n] = __builtin_amdgcn_mfma_f32_16x16x32_bf16(Bt[n][k], At[m][k], acc[ai][bj][m][n], 0, 0, 0); __builtin_amdgcn_s_setprio(0); } while (0)
#define PG8_WAIT_V(n) asm volatile("s_waitcnt vmcnt(" #n ")" ::: "memory")
#define PG8_WAIT_L(n) asm volatile("s_waitcnt lgkmcnt(" #n ")" ::: "memory")
#define PG8_BAR __builtin_amdgcn_s_barrier()
#define PG8_SCHED __builtin_amdgcn_sched_barrier(0)
    Unit cur, nxt; int ui = 0;
    if (!S.next(0, cur)) return;
    f32x4 acc[2][2][4][2];
#pragma unroll
    for (int a = 0; a < 2; ++a)
#pragma unroll
        for (int b = 0; b < 2; ++b)
#pragma unroll
            for (int m = 0; m < 4; ++m)
#pragma unroll
                for (int n = 0; n < 2; ++n) acc[a][b][m][n] = (f32x4){0.f, 0.f, 0.f, 0.f};
    bf16x8 At[4][2], B0[2][2], B1[2][2];
    const char* cA = (const char*)g.A + (size_t)cur.pm * tstep; const char* cB = (const char*)g.Bt + (size_t)cur.pn * tstep;
    S.a_ready(cur);
    if constexpr (SP2) {
        PG8_STAGE(PG8_SB(0, 0), cB, voffB); PG8_STAGE(PG8_SB(0, 1), cB + hstep, voffB); PG8_STAGE(PG8_SA(0, 0), cA, voffA); PG8_STAGE(PG8_SA(0, 1), cA + hstep, voffA);
        if (wr == 1) PG8_BAR;
        PG8_WAIT_V(2); PG8_BAR;
        PG8_STAGE(PG8_SB(1, 0), cB + kstep, voffB); PG8_STAGE(PG8_SA(1, 0), cA + kstep, voffA); PG8_STAGE(PG8_SB(1, 1), cB + hstep + kstep, voffB);
        PG8_WAIT_V(6); PG8_BAR;
    } else {
        PG8_STAGE(PG8_SB(0, 0), cB, voffB); PG8_STAGE(PG8_SA(0, 0), cA, voffA); PG8_STAGE(PG8_SB(0, 1), cB + hstep, voffB); PG8_STAGE(PG8_SA(0, 1), cA + hstep, voffA);
        if (wr == 1) PG8_BAR;
        PG8_WAIT_V(4); PG8_BAR;
        PG8_STAGE(PG8_SB(1, 0), cB + kstep, voffB); PG8_STAGE(PG8_SA(1, 0), cA + kstep, voffA); PG8_STAGE(PG8_SB(1, 1), cB + hstep + kstep, voffB);
        PG8_WAIT_V(6); PG8_BAR;
    }
    for (;;) {
        const bool has_next = S.next(ui + 1, nxt);
        const char* nA = has_next ? (const char*)g.A + (size_t)nxt.pm * tstep : cA; const char* nB = has_next ? (const char*)g.Bt + (size_t)nxt.pn * tstep : cB;
        for (int t = 0; t < nt; t += 2) {
            const bool last = (t == nt - 2);
            const char* a1 = cA + (size_t)(t + 1) * kstep;
            const char* a2 = last ? nA : cA + (size_t)(t + 2) * kstep; const char* b2 = last ? nB : cB + (size_t)(t + 2) * kstep;
            const char* a3 = a2 + kstep; const char* b3 = b2 + kstep;
            if (last && has_next) S.a_ready(nxt);
            if constexpr (SP2) {
            PG8_LDB(B0, 0, 0); PG8_LDB(B1, 0, 1); PG8_SCHED; PG8_LDA(At, 0, 0); PG8_STAGE(PG8_SA(1, 1), a1 + hstep, voffA);
            PG8_WAIT_V(8); PG8_WAIT_L(0); PG8_BAR; PG8_MMA(0, 0, At, B0); PG8_MMA(0, 1, At, B1); PG8_BAR; PG8_SCHED;
            PG8_LDA(At, 0, 1); PG8_STAGE(PG8_SB(0, 0), b2, voffB); PG8_STAGE(PG8_SB(0, 1), b2 + hstep, voffB); PG8_STAGE(PG8_SA(0, 0), a2, voffA);
            PG8_WAIT_V(8); PG8_WAIT_L(0); PG8_BAR; PG8_MMA(1, 0, At, B0); PG8_MMA(1, 1, At, B1); PG8_BAR; PG8_SCHED;
            PG8_LDB(B0, 1, 0); PG8_LDB(B1, 1, 1); PG8_SCHED; PG8_LDA(At, 1, 0); PG8_STAGE(PG8_SA(0, 1), a2 + hstep, voffA);
            PG8_WAIT_V(8); PG8_WAIT_L(0); PG8_BAR; PG8_MMA(0, 0, At, B0); PG8_MMA(0, 1, At, B1); PG8_BAR; PG8_SCHED;
            PG8_LDA(At, 1, 1); PG8_STAGE(PG8_SB(1, 0), b3, voffB); PG8_STAGE(PG8_SB(1, 1), b3 + hstep, voffB); PG8_STAGE(PG8_SA(1, 0), a3, voffA);
            PG8_WAIT_V(8); PG8_WAIT_L(0); PG8_BAR; PG8_MMA(1, 0, At, B0); PG8_MMA(1, 1, At, B1); PG8_BAR; PG8_SCHED;
            } else {
            PG8_LDB(B0, 0, 0); PG8_SCHED; PG8_LDA(At, 0, 0); PG8_STAGE(PG8_SA(1, 1), a1 + hstep, voffA);
            PG8_WAIT_L(8); PG8_BAR; PG8_WAIT_L(0); PG8_MMA(0, 0, At, B0); PG8_BAR; PG8_SCHED;
            PG8_LDB(B1, 0, 1); PG8_STAGE(PG8_SB(0, 0), b2, voffB);
            PG8_BAR; PG8_WAIT_L(0); PG8_MMA(0, 1, At, B1); PG8_BAR;
            PG8_LDA(At, 0, 1); PG8_STAGE(PG8_SA(0, 0), a2, voffA);
            PG8_BAR; PG8_WAIT_L(0); PG8_MMA(1, 0, At, B0); PG8_BAR; PG8_SCHED;
            PG8_STAGE(PG8_SB(0, 1), b2 + hstep, voffB);
            PG8_WAIT_V(6); PG8_BAR; PG8_MMA(1, 1, At, B1); PG8_BAR;
            PG8_LDB(B0, 1, 0); PG8_SCHED; PG8_LDA(At, 1, 0); PG8_STAGE(PG8_SA(0, 1), a2 + hstep, voffA);
            PG8_WAIT_L(8); PG8_BAR; PG8_WAIT_L(0); PG8_MMA(0, 0, At, B0); PG8_BAR; PG8_SCHED;
            PG8_LDB(B1, 1, 1); PG8_STAGE(PG8_SB(1, 0), b3, voffB);
            PG8_BAR; PG8_WAIT_L(0); PG8_MMA(0, 1, At, B1); PG8_BAR;
            PG8_LDA(At, 1, 1); PG8_STAGE(PG8_SA(1, 0), a3, voffA);
            PG8_BAR; PG8_WAIT_L(0); PG8_MMA(1, 0, At, B0); PG8_BAR; PG8_SCHED;
            PG8_STAGE(PG8_SB(1, 1), b3 + hstep, voffB);
            PG8_WAIT_V(6); PG8_BAR; PG8_MMA(1, 1, At, B1); PG8_BAR;
            }
        }
        if constexpr (ALIGN_EPI) { if (wr == 0) PG8_BAR; }
        if constexpr (!Epi::AFTER_DRAIN) { E(acc, cur, wr, wc, fr, fq); S.done(cur); }
        if (!has_next) break;
#pragma unroll
        for (int a = 0; a < 2; ++a)
#pragma unroll
            for (int b = 0; b < 2; ++b)
#pragma unroll
                for (int m = 0; m < 4; ++m)
#pragma unroll
                    for (int n = 0; n < 2; ++n) acc[a][b][m][n] = (f32x4){0.f, 0.f, 0.f, 0.f};
        cur = nxt; cA = nA; cB = nB; ++ui;
        if constexpr (ALIGN_EPI) { if (wr == 1) PG8_BAR; }
    }
    PG8_WAIT_V(0);
    if constexpr (!ALIGN_EPI) { if (wr == 0) PG8_BAR; }
    PG8_BAR;
    if constexpr (Epi::AFTER_DRAIN) { E.fused(acc, cur, wr, wc, fr, fq, lds, wid, lane); S.done(cur); }
#undef PG8_SA
#undef PG8_SB
#undef PG8_STAGE
#undef PG8_LDA
#undef PG8_LDB
#undef PG8_MMA
#undef PG8_WAIT_V
#undef PG8_WAIT_L
#undef PG8_BAR
#undef PG8_SCHED
}
}
#ifndef PG8_SP2
#define PG8_SP2 true
#endif
#ifndef PG8_ALIGN
#define PG8_ALIGN true
#endif
constexpr int NWAVES = 8;
constexpr int N_PHASES = 12;
#ifndef MK_N_LAUNCHES
#define MK_N_LAUNCHES 12
#endif
constexpr int N_LAUNCHES = MK_N_LAUNCHES;

constexpr int M = 16384, D = 1024, FF = 2816, NGU = 2 * FF, DPLE = 256;
constexpr int GH = 4, GDK = 64, GDV = 128, MH = 8, MHD = 64, MBLK = 256, NBLK = M / MBLK;
constexpr int UWID = 3328;
constexpr int U_QG = 0, U_KG = 256, U_VG = 512, U_GG = 1024, U_QM = 1792, U_KM = 2304, U_VM = 2816;
constexpr float EPS = 1e-6f;

constexpr size_t MiB = 1u << 20;
constexpr size_t WS_CTL = 0, CTL_ZERO_BYTES = 1 * MiB;
constexpr size_t WS_WGU1 = 1 * MiB, WS_WD1 = 12 * MiB, WS_WIN = 18 * MiB, WS_WOUT = 25 * MiB, WS_WGU2 = 27 * MiB, WS_WD2 = 38 * MiB, WS_WPG = 44 * MiB, WS_WPP = 46 * MiB;
constexpr size_t WS_SSQ1 = 47 * MiB, WS_SSQ2 = 48 * MiB, WS_SSQ3 = 49 * MiB, WS_SSQ4 = 50 * MiB, WS_SSQ5 = 51 * MiB, WS_KMEAN = 52 * MiB;
constexpr size_t WS_HB = 54 * MiB;
constexpr size_t WS_PB = 86 * MiB;
constexpr size_t WS_MIX = 94 * MiB;
constexpr size_t WS_U = 126 * MiB;
constexpr size_t WS_LOGA = 230 * MiB;
constexpr size_t WS_PP = 214 * MiB;
constexpr size_t WS_END = 256 * MiB;
static_assert(WS_U + (size_t)M * UWID * 2 <= WS_LOGA && WS_LOGA + (size_t)M * 256 * 4 <= WS_END && WS_U + (size_t)M * FF * 2 <= WS_PP && WS_PP + (size_t)M * D * 2 <= WS_END, "d_ws map");
constexpr int CW_TMO = 0, CW_CODE = 1;
constexpr int CW_BAR = 4096;

constexpr int RING_OFF = 0, RING_BYTES = 131072;
constexpr int LDSCTL_OFF = RING_BYTES, MISC_OFF = LDSCTL_OFF + 320;
constexpr int LDS_BYTES = 147456;
#define GAS __attribute__((address_space(1)))
#define LAS __attribute__((address_space(3)))
typedef unsigned short bf16;
typedef unsigned v4u __attribute__((ext_vector_type(4)));
typedef float f32x4 __attribute__((ext_vector_type(4)));
typedef short bf16x8 __attribute__((ext_vector_type(8)));
typedef GAS unsigned gu32;
typedef GAS unsigned long long gu64;
#define RLX_AGENT __ATOMIC_RELAXED, __HIP_MEMORY_SCOPE_AGENT
#define LDS_WAIT() asm volatile("s_waitcnt lgkmcnt(0)" ::: "memory")
#define VM_WAIT() asm volatile("s_waitcnt vmcnt(0)" ::: "memory")
__device__ __forceinline__ unsigned long long rt() { return __builtin_amdgcn_s_memrealtime(); }
__device__ __forceinline__ unsigned f2bf(float f) { unsigned u = __builtin_bit_cast(unsigned, f); return (u + 0x7fffu + ((u >> 16) & 1u)) >> 16; }
__device__ __forceinline__ unsigned pk2(float lo, float hi) { return f2bf(lo) | (f2bf(hi) << 16); }

#define XB_TMO      128
#define XB_XCNT(j)  (256  + 64 * (j))
#define XB_XSUB(j)  (1280 + 64 * (j))
#define XB_XGEN(j)  (2304 + 64 * (j))
#define XB_TOP      3328
#define XB_TOPGEN   3392
#define XCD_BAR_WORDS 3456
#define XB_SPIN_CAP (1u << 18)

__device__ __forceinline__ unsigned xb_ld(unsigned* p)              { return __hip_atomic_load(p, __ATOMIC_RELAXED, __HIP_MEMORY_SCOPE_AGENT); }
__device__ __forceinline__ unsigned xb_add(unsigned* p, unsigned v) { return __hip_atomic_fetch_add(p, v, __ATOMIC_RELAXED, __HIP_MEMORY_SCOPE_AGENT); }
__device__ __forceinline__ unsigned xb_xcc_id() { return (unsigned)__builtin_amdgcn_s_getreg((3 << 11) | 20) & 0xFu; }
#define XB_SPIN(cond, bar) do { unsigned _sp = 0; while (cond) { __builtin_amdgcn_s_sleep(1); \
    if ((++_sp & 255u) == 0u) { if (xb_ld(&(bar)[XB_TMO])) break; if (_sp > XB_SPIN_CAP) { atomicAdd(&(bar)[XB_TMO], 1u); break; } } } } while (0)

struct XcdBarrier {
    unsigned* bar; unsigned x;
    volatile LAS unsigned* st;
};

__device__ __forceinline__ XcdBarrier xcd_barrier_post(unsigned* bar, volatile LAS unsigned* st) {
    XcdBarrier b; b.bar = bar; b.x = xb_xcc_id(); b.st = st;
    if (threadIdx.x == 0) (void)xb_add(&bar[XB_XCNT(b.x)], 1u);
    return b;
}
__device__ __forceinline__ void xcd_barrier_complete(unsigned* bar, unsigned x, unsigned& nloc, unsigned& nx) {
    const unsigned G = gridDim.x * gridDim.y * gridDim.z;
    unsigned sum, cnt, mine, sp = 0u;
    for (;;) {
        sum = 0u; cnt = 0u; mine = 0u;
#pragma unroll
        for (unsigned j = 0; j < 16; ++j) { const unsigned c = xb_ld(&bar[XB_XCNT(j)]); sum += c; cnt += (c > 0u) ? 1u : 0u; mine = (j == x) ? c : mine; }
        if (sum == G) break;
        __builtin_amdgcn_s_sleep(1);
        if ((++sp & 255u) == 0u) { if (xb_ld(&bar[XB_TMO])) break; if (sp > XB_SPIN_CAP) { atomicAdd(&bar[XB_TMO], 1u); break; } }
    }
    nloc = mine > 0u ? mine : 1u; nx = cnt > 0u ? cnt : 1u;
}

__device__ __forceinline__ void xcd_barrier(const XcdBarrier& b) {
    asm volatile("s_waitcnt vmcnt(0)" ::: "memory");
    __syncthreads();
    if (threadIdx.x == 0) {
        unsigned* bar = b.bar;
        __builtin_amdgcn_s_waitcnt(0);
        unsigned nloc = b.st[0], nx = b.st[1];
        if (nloc == 0u) { xcd_barrier_complete(bar, b.x, nloc, nx); b.st[0] = nloc; b.st[1] = nx; }
        const unsigned old = xb_add(&bar[XB_XSUB(b.x)], 1u);
        const unsigned gen = old / nloc;
        if (old + 1u == (gen + 1u) * nloc) {
            __builtin_amdgcn_fence(__ATOMIC_RELEASE, "agent");
            asm volatile("s_waitcnt vmcnt(0)" ::: "memory");
            const unsigned og = xb_add(&bar[XB_TOP], 1u);
            const unsigned tg = og / nx;
            if (og + 1u == (tg + 1u) * nx) xb_add(&bar[XB_TOPGEN], 1u);
            else XB_SPIN(xb_ld(&bar[XB_TOPGEN]) == tg, bar);
            __builtin_amdgcn_fence(__ATOMIC_ACQUIRE, "agent");
            xb_add(&bar[XB_XGEN(b.x)], 1u);
            asm volatile("s_waitcnt vmcnt(0)" ::: "memory");
        } else {
            XB_SPIN(xb_ld(&bar[XB_XGEN(b.x)]) == gen, bar);
            __builtin_amdgcn_fence(__ATOMIC_ACQUIRE, "agent");
            asm volatile("s_waitcnt vmcnt(0)" ::: "memory");
        }
    }
    __syncthreads();
}
struct Frame {
    LAS unsigned char* lds;
    volatile LAS unsigned* MISC;
    gu32* ctl;
    int tid, lane, wave;
    int vcu, G;
};
__device__ __forceinline__ int fresh_lane() { int l; asm volatile("v_mbcnt_lo_u32_b32 %0, -1, 0\n\tv_mbcnt_hi_u32_b32 %0, -1, %0" : "=v"(l)); return l; }
__device__ __forceinline__ float wave_sum(float v) {
#pragma unroll
    for (int o = 1; o < 64; o <<= 1) v += __shfl_xor(v, o);
    return v;
}
__device__ __forceinline__ float wave_max(float v) {
#pragma unroll
    for (int o = 1; o < 64; o <<= 1) v = fmaxf(v, __shfl_xor(v, o));
    return v;
}
__device__ __forceinline__ float bf2f(bf16 h) { return __uint_as_float((unsigned)h << 16); }
__device__ __forceinline__ float bf_lo2(unsigned w) { return __uint_as_float(w << 16); }
__device__ __forceinline__ float bf_hi2(unsigned w) { return __uint_as_float(w & 0xffff0000u); }

__device__ __forceinline__ void tr_store(bf16* WT, int K, int k0, int n0dst, LAS float* scr, int lane) {
    LDS_WAIT(); asm volatile("" ::: "memory");
    const int c = lane & 7;
#pragma unroll
    for (int j = 0; j < 4; ++j) { const int n = (lane >> 3) + 8 * j; const LAS float* s = scr + (8 * c) * 33 + n;
        v4u o; o.x = pk2(s[0 * 33], s[1 * 33]); o.y = pk2(s[2 * 33], s[3 * 33]); o.z = pk2(s[4 * 33], s[5 * 33]); o.w = pk2(s[6 * 33], s[7 * 33]);
        *(GAS v4u*)(WT + (size_t)(n0dst + n) * K + k0 + 8 * c) = o; }
    LDS_WAIT(); asm volatile("" ::: "memory");
}
__device__ __forceinline__ void tr_item(const float* W, int K, int N, const float* gain, bf16* WT, int k0, int n0dst, int c0src, LAS float* scr, int lane) {
#pragma unroll 8
    for (int i = 0; i < 32; ++i) { const int kk = 2 * i + (lane >> 5); const float g = gain ? gain[k0 + kk] : 1.0f;
        scr[kk * 33 + (lane & 31)] = W[(size_t)(k0 + kk) * N + c0src + (lane & 31)] * g; }
    tr_store(WT, K, k0, n0dst, scr, lane);
}
__device__ __forceinline__ void tr_item_gk(const float* Win, const float* Wup, const float* gain, bf16* WT, int k0, int j0, LAS float* scr, int lane) {
    for (int i = 0; i < 32; ++i) { const int kk = 2 * i + (lane >> 5), k = k0 + kk, j = j0 + (lane & 31); float a = 0.f;
#pragma unroll
        for (int r = 0; r < 16; ++r) a += Win[(size_t)k * 3088 + 1536 + r] * Wup[r * 256 + j];
        scr[kk * 33 + (lane & 31)] = a * gain[k]; }
    tr_store(WT, 1024, k0, 1536 + j0, scr, lane);
}
struct Args { const float* in[19]; float* out; unsigned char* ws; int ph_lo, ph_hi, li, pad; };

__device__ __forceinline__ void p0_prologue(Frame& F, const Args& A) {
    LAS float* scr = (LAS float*)(F.lds + RING_OFF + F.wave * 16384);
    unsigned char* ws = A.ws;
    const int gw = F.vcu * NWAVES + F.wave, NGW = F.G * NWAVES, lane = fresh_lane();
    constexpr int I_GU = 16 * 176, I_D = 44 * 32, I_IN = 16 * 104, I_O = 16 * 32, I_PP = 4 * 32;
    constexpr int NITEMS = 2 * I_GU + 2 * I_D + I_IN + 2 * I_O + I_PP;
    for (int it = gw; it < NITEMS; it += NGW) {
        int r = it;
        if (r < 2 * I_GU) { const int which = r / I_GU; r -= which * I_GU; const int kb = r / 176, nb = r % 176, t = nb >> 3, g = nb & 7;
            const int src = (g < 4) ? (128 * t + 32 * g) : (FF + 128 * t + 32 * (g - 4));
            tr_item(A.in[which ? 12 : 3], D, NGU, A.in[which ? 11 : 2], (bf16*)(ws + (which ? WS_WGU2 : WS_WGU1)), 64 * kb, 32 * nb, src, scr, lane); continue; } r -= 2 * I_GU;
        if (r < 2 * I_D) { const int which = r / I_D; r -= which * I_D; const int kb = r / 32, nb = r % 32;
            tr_item(A.in[which ? 13 : 4], FF, D, nullptr, (bf16*)(ws + (which ? WS_WD2 : WS_WD1)), 64 * kb, 32 * nb, 32 * nb, scr, lane); continue; } r -= 2 * I_D;
        if (r < I_IN) { const int kb = r / 104, nb = r % 104;
            if (nb >= 48 && nb < 56) tr_item_gk(A.in[6], A.in[7], A.in[5], (bf16*)(ws + WS_WIN), 64 * kb, 32 * (nb - 48), scr, lane);
            else tr_item(A.in[6], D, 3088, A.in[5], (bf16*)(ws + WS_WIN), 64 * kb, 32 * nb, nb < 48 ? 32 * nb : 32 * nb - 240, scr, lane);
            continue; } r -= I_IN;
        if (r < 2 * I_O) { const int which = r / I_O; r -= which * I_O; const int kb = r / 32, nb = r % 32;
            tr_item(A.in[which ? 15 : 10], D, D, which ? A.in[14] : nullptr, (bf16*)(ws + (which ? WS_WPG : WS_WOUT)), 64 * kb, 32 * nb, 32 * nb, scr, lane); continue; } r -= 2 * I_O;
        { const int kb = r / 32, nb = r % 32; tr_item(A.in[16], DPLE, D, nullptr, (bf16*)(ws + WS_WPP), 64 * kb, 32 * nb, 32 * nb, scr, lane); }
    }
    const float* x = A.in[0]; const float* p = A.in[1];
    bf16* xb = (bf16*)(ws + WS_MIX); bf16* pb = (bf16*)(ws + WS_PB); float* ssq1 = (float*)(ws + WS_SSQ1);
    for (int m = gw; m < M; m += NGW) {
        const GAS f32x4* xr = (const GAS f32x4*)(x + (size_t)m * D) + lane; f32x4 v[4]; float s = 0.f;
#pragma unroll
        for (int j = 0; j < 4; ++j) { v[j] = xr[64 * j]; s += (v[j].x * v[j].x + v[j].y * v[j].y) + (v[j].z * v[j].z + v[j].w * v[j].w); }
        s = wave_sum(s);
        GAS unsigned long long* o8 = (GAS unsigned long long*)(xb + (size_t)m * D) + lane;
#pragma unroll
        for (int j = 0; j < 4; ++j) o8[64 * j] = (unsigned long long)pk2(v[j].x, v[j].y) | ((unsigned long long)pk2(v[j].z, v[j].w) << 32);
        if (lane < 16) ssq1[(size_t)m * 16 + lane] = (lane == 0) ? s : 0.f;
        const f32x4 pv = ((const GAS f32x4*)(p + (size_t)m * DPLE))[lane];
        ((GAS unsigned long long*)(pb + (size_t)m * DPLE))[lane] = (unsigned long long)pk2(pv.x, pv.y) | ((unsigned long long)pk2(pv.z, pv.w) << 32);
    }
}

__device__ __forceinline__ void moba_kmean(Frame& F, const bf16* U, float* kmean) {
    const int gw = F.vcu * NWAVES + F.wave, NGW = F.G * NWAVES, lane = fresh_lane();
    for (int u = gw; u < MH * NBLK; u += NGW) { const int h = u / NBLK, n = u % NBLK; float s = 0.f;
        const bf16* kp = U + (size_t)(n * MBLK) * UWID + U_KM + h * MHD + lane;
#pragma unroll 8
        for (int r = 0; r < MBLK; ++r) s += bf2f(kp[(size_t)r * UWID]);
        kmean[(size_t)u * 64 + lane] = s * (1.0f / MBLK); }
}
__device__ __forceinline__ void gla_seq(Frame& F, const bf16* U, const float* loga, float* oraw) {
    if (F.vcu >= 64) return;
    const int h = F.vcu >> 4, e = (F.vcu & 15) * 8 + F.wave, lane = fresh_lane();
    LAS float* scr = (LAS float*)(F.lds + RING_OFF) + F.wave * (32 * 65);
    float S = 0.f;
    for (int t0 = 0; t0 < M; t0 += 32) {
#pragma unroll 8
        for (int tt = 0; tt < 32; ++tt) { const size_t t = t0 + tt;
            const float a = __expf(loga[t * 256 + h * 64 + lane]);
            const float kk = bf2f(U[t * UWID + U_KG + h * 64 + lane]), qq = bf2f(U[t * UWID + U_QG + h * 64 + lane]), vv = bf2f(U[t * UWID + U_VG + h * 128 + e]);
            S = a * S + kk * vv;
            scr[tt * 65 + lane] = qq * S; }
        LDS_WAIT(); asm volatile("" ::: "memory");
        float o = 0.f; const int row = lane & 31, hf = lane >> 5;
#pragma unroll 16
        for (int j = 0; j < 32; ++j) o += scr[row * 65 + hf * 32 + j];
        o += __shfl_xor(o, 32);
        if (lane < 32) oraw[(size_t)(t0 + lane) * 512 + h * 128 + e] = o;
        LDS_WAIT(); asm volatile("" ::: "memory");
    }
}
__device__ __forceinline__ void gla_final(Frame& F, const bf16* U, const float* oraw, const float* gain, bf16* mix) {
    const int gw = F.vcu * NWAVES + F.wave, NGW = F.G * NWAVES, lane = fresh_lane();
    for (int u = gw; u < M * GH; u += NGW) { const int t = u >> 2, h = u & 3;
        const float o0 = oraw[(size_t)t * 512 + h * 128 + lane], o1 = oraw[(size_t)t * 512 + h * 128 + 64 + lane];
        const float ss = wave_sum(o0 * o0 + o1 * o1), rs = 1.0f / sqrtf(ss * (1.0f / 128.0f) + EPS);
        const float g0 = bf2f(U[(size_t)t * UWID + U_GG + h * 128 + lane]), g1 = bf2f(U[(size_t)t * UWID + U_GG + h * 128 + 64 + lane]);
        const float y0 = o0 * rs * gain[lane] * (g0 / (1.0f + __expf(-g0))), y1 = o1 * rs * gain[64 + lane] * (g1 / (1.0f + __expf(-g1)));
        mix[(size_t)t * D + h * 128 + lane] = (bf16)f2bf(y0); mix[(size_t)t * D + h * 128 + 64 + lane] = (bf16)f2bf(y1); }
}
__device__ __forceinline__ int rel_bucket(int n) { return n < 16 ? n : min(31, 16 + (31 - __clz(n * n)) - 8); }
__device__ __forceinline__ void moba_simple(Frame& F, const bf16* U, const float* kmean, const float* relb, bf16* mix) {
    const int gw = F.vcu * NWAVES + F.wave, NGW = F.G * NWAVES, lane = fresh_lane();
    LAS float* qs = (LAS float*)(F.lds + RING_OFF) + F.wave * 1088; LAS float* ps = qs + 64;
    for (int u = gw; u < M * MH; u += NGW) { const int t = u >> 3, h = u & 7, own = t >> 8;
        qs[lane] = bf2f(U[(size_t)t * UWID + U_QM + h * 64 + lane]);
        LDS_WAIT(); asm volatile("" ::: "memory");
        float g = -INFINITY;
        if (lane < own) { const float* km = kmean + (size_t)(h * NBLK + lane) * 64; float a = 0.f;
#pragma unroll 16
            for (int d = 0; d < 64; ++d) a += qs[d] * km[d];
            g = a; }
        int sel0 = -1, sel1 = -1, sel2 = -1;
#pragma unroll
        for (int j = 0; j < 3; ++j) { const float mx = wave_max(g); int s = -1;
            if (mx > -INFINITY) { const unsigned long long b = __ballot(g == mx); s = __ffsll((long long)b) - 1; if (lane == s) g = -INFINITY; }
            if (j == 0) sel0 = s; else if (j == 1) sel1 = s; else sel2 = s; }
        float sc[16]; float mloc = -1e30f;
#pragma unroll
        for (int b = 0; b < 4; ++b) { const int blk = b == 0 ? sel0 : b == 1 ? sel1 : b == 2 ? sel2 : own;
#pragma unroll
            for (int sb = 0; sb < 4; ++sb) { float s = -1e30f;
                if (blk >= 0) { const int key = blk * MBLK + sb * 64 + lane, dist = t - key;
                    const v4u* kp = (const v4u*)(U + (size_t)key * UWID + U_KM + h * 64); float a = 0.f;
#pragma unroll
                    for (int c = 0; c < 8; ++c) { const v4u w = kp[c];
                        a += qs[8 * c + 0] * bf_lo2(w.x) + qs[8 * c + 1] * bf_hi2(w.x) + qs[8 * c + 2] * bf_lo2(w.y) + qs[8 * c + 3] * bf_hi2(w.y)
                           + qs[8 * c + 4] * bf_lo2(w.z) + qs[8 * c + 5] * bf_hi2(w.z) + qs[8 * c + 6] * bf_lo2(w.w) + qs[8 * c + 7] * bf_hi2(w.w); }
                    if (dist >= 0) s = a * 0.125f + relb[rel_bucket(dist) * 8 + h]; }
                sc[b * 4 + sb] = s; mloc = fmaxf(mloc, s); } }
        const float mx = wave_max(mloc); float l = 0.f;
#pragma unroll
        for (int i = 0; i < 16; ++i) { const float pe = __expf(sc[i] - mx); ps[i * 64 + lane] = pe; l += pe; }
        l = wave_sum(l);
        LDS_WAIT(); asm volatile("" ::: "memory");
        float o = 0.f;
#pragma unroll
        for (int b = 0; b < 4; ++b) { const int blk = b == 0 ? sel0 : b == 1 ? sel1 : b == 2 ? sel2 : own;
            if (blk >= 0) { const bf16* vp = U + (size_t)(blk * MBLK) * UWID + U_VM + h * 64 + lane;
#pragma unroll 8
                for (int s = 0; s < MBLK; ++s) o += ps[b * 256 + s] * bf2f(vp[(size_t)s * UWID]); } }
        mix[(size_t)t * D + 512 + h * 64 + lane] = (bf16)f2bf(o / l);
        LDS_WAIT(); asm volatile("" ::: "memory");
    }
}
__device__ __forceinline__ void final_norm(Frame& F, float* out, const float* ssqp, const float* gain) {
    const int gw = F.vcu * NWAVES + F.wave, NGW = F.G * NWAVES, lane = fresh_lane();
    for (int m = gw; m < M; m += NGW) {
        float s = (lane < 16) ? ssqp[(size_t)m * 16 + lane] : 0.f; s = wave_sum(s);
        const float rs = 1.0f / sqrtf(s * (1.0f / 1024.0f) + EPS);
        GAS f32x4* xr = (GAS f32x4*)(out + (size_t)m * D) + lane;
#pragma unroll
        for (int j = 0; j < 4; ++j) { f32x4 v = xr[64 * j]; const f32x4 g = ((const GAS f32x4*)gain)[lane + 64 * j]; v = v * rs * g; xr[64 * j] = v; }
    }
}
__global__ void __launch_bounds__(NWAVES * 64, 2) mega_fwd(Args args) {
    extern __shared__ __attribute__((aligned(16))) unsigned char lds[];
    Frame F;
    F.lds = (LAS unsigned char*)lds;
    F.MISC = (volatile LAS unsigned*)(F.lds + MISC_OFF);
    F.tid = threadIdx.x; F.lane = F.tid & 63; F.wave = __builtin_amdgcn_readfirstlane(F.tid >> 6);
    F.G = gridDim.x; { const int bx = blockIdx.x; F.vcu = (F.G % 8 == 0) ? (bx % 8) * (F.G / 8) + bx / 8 : bx; }
    unsigned char* ws = args.ws;
    F.ctl = (gu32*)(ws + WS_CTL);
    for (int u = F.tid; u < (LDS_BYTES - LDSCTL_OFF) / 4; u += NWAVES * 64) ((LAS unsigned*)(F.lds + LDSCTL_OFF))[u] = 0u;
    __syncthreads();
    XcdBarrier bar; bar.bar = (unsigned*)(F.ctl + CW_BAR); bar.x = 0; bar.st = nullptr;
    if (N_LAUNCHES != N_PHASES) bar = xcd_barrier_post((unsigned*)(F.ctl + CW_BAR), F.MISC + 8);
#define GRID_BAR() do { if (N_LAUNCHES == N_PHASES) { if (F.tid == 0) __hip_atomic_store(F.ctl + CW_TMO, 0xBADBA0u, RLX_AGENT); } else { xcd_barrier(bar); } } while (0)
    const int lo = args.ph_lo, hi = args.ph_hi;
#define IN(k) (lo <= (k) && (k) < hi)
#define BOTH(k) (IN(k) && IN((k) + 1))
    float* out = args.out;
    bf16* Wgu1 = (bf16*)(ws + WS_WGU1); bf16* Wd1 = (bf16*)(ws + WS_WD1); bf16* Win = (bf16*)(ws + WS_WIN); bf16* Wout = (bf16*)(ws + WS_WOUT);
    bf16* Wgu2 = (bf16*)(ws + WS_WGU2); bf16* Wd2 = (bf16*)(ws + WS_WD2); bf16* Wpg = (bf16*)(ws + WS_WPG); bf16* Wpp = (bf16*)(ws + WS_WPP);
    float* ssq1 = (float*)(ws + WS_SSQ1); float* ssq2 = (float*)(ws + WS_SSQ2); float* ssq3 = (float*)(ws + WS_SSQ3); float* ssq4 = (float*)(ws + WS_SSQ4); float* ssq5 = (float*)(ws + WS_SSQ5);
    float* kmean = (float*)(ws + WS_KMEAN);
    bf16* hb = (bf16*)(ws + WS_HB); float* oraw = (float*)(ws + WS_HB); bf16* pb = (bf16*)(ws + WS_PB); bf16* mix = (bf16*)(ws + WS_MIX); bf16* xb = (bf16*)(ws + WS_MIX);
    bf16* U = (bf16*)(ws + WS_U); bf16* hmid = (bf16*)(ws + WS_U); float* loga = (float*)(ws + WS_LOGA); bf16* pp = (bf16*)(ws + WS_PP);
    using pg8::Gemm; using pg8::StaticOrder;
#define RUN_GEMM(EPI, A_, B_, N_, K_, ...) do { Gemm g{A_, B_, M, N_, K_}; StaticOrder S; S.init(M, N_, F.G, (int)blockIdx.x); pg8::EPI E{__VA_ARGS__}; \
        pg8::gemm_phase<pg8::EPI, StaticOrder, PG8_ALIGN, PG8_SP2>(F.lds + RING_OFF, g, S, E); } while (0)

    if (IN(0)) { p0_prologue(F, args); if (BOTH(0)) GRID_BAR(); }
    if (IN(1)) { RUN_GEMM(EpiSwiGLU, xb, Wgu1, NGU, D, hmid, FF, ssq1); if (BOTH(1)) GRID_BAR(); }
    if (IN(2)) { RUN_GEMM(EpiResid<1>, hmid, Wd1, D, FF, args.in[0], out, hb, ssq2); if (BOTH(2)) GRID_BAR(); }
    if (IN(3)) { RUN_GEMM(EpiWin, hb, Win, UWID, D, U, loga, ssq2, args.in[8]); if (BOTH(3)) GRID_BAR(); }
    if (IN(4)) { moba_kmean(F, U, kmean); gla_seq(F, U, loga, oraw); if (BOTH(4)) GRID_BAR(); }
    if (IN(5)) { gla_final(F, U, oraw, args.in[9], mix); moba_simple(F, U, kmean, args.in[17], mix); if (BOTH(5)) GRID_BAR(); }
    if (IN(6)) { RUN_GEMM(EpiResid<0>, mix, Wout, D, D, out, out, hb, ssq3); if (BOTH(6)) GRID_BAR(); }
    if (IN(7)) { RUN_GEMM(EpiPlain, pb, Wpp, D, DPLE, pp); if (BOTH(7)) GRID_BAR(); }
    if (IN(8)) { RUN_GEMM(EpiSwiGLU, hb, Wgu2, NGU, D, hmid, FF, ssq3); if (BOTH(8)) GRID_BAR(); }
    if (IN(9)) { RUN_GEMM(EpiResid<1>, hmid, Wd2, D, FF, out, out, hb, ssq4); if (BOTH(9)) GRID_BAR(); }
    if (IN(10)) { RUN_GEMM(EpiPle, hb, Wpg, D, D, out, out, pp, ssq4, ssq5); if (BOTH(10)) GRID_BAR(); }
    if (IN(11)) { final_norm(F, out, ssq5, args.in[18]); }
#undef IN
#undef BOTH
}

extern "C" void kernel_launch(void* const* d_in, const int* in_sizes, int n_in, void* d_out, int out_size, void* d_ws, size_t ws_size, hipStream_t stream) {
    static int grid = 0;
    if (grid == 0) {
        if (n_in != 19 || in_sizes[0] != M * D || out_size != M * D || ws_size < WS_END) { fprintf(stderr, "kernel_launch: unexpected shapes (n_in %d, in0 %d, out %d, ws %zu); nothing launched\n", n_in, n_in > 0 ? in_sizes[0] : -1, out_size, ws_size); grid = -1; return; }
        int dev = 0, cus = 0, per_cu = 0;
        if (hipGetDevice(&dev) != hipSuccess || hipDeviceGetAttribute(&cus, hipDeviceAttributeMultiprocessorCount, dev) != hipSuccess) { grid = -1; return; }
        if (hipFuncSetAttribute((const void*)mega_fwd, hipFuncAttributeMaxDynamicSharedMemorySize, LDS_BYTES) != hipSuccess) { fprintf(stderr, "kernel_launch: hipFuncSetAttribute failed\n"); grid = -1; return; }
        if (hipOccupancyMaxActiveBlocksPerMultiprocessor(&per_cu, (const void*)mega_fwd, NWAVES * 64, LDS_BYTES) != hipSuccess || per_cu < 1) { fprintf(stderr, "kernel_launch: occupancy query reports %d workgroups per CU\n", per_cu); }
        (void)hipGetLastError();
        grid = cus;
    }
    if (grid < 0) return;
    if (hipMemsetAsync((char*)d_ws + WS_CTL, 0, CTL_ZERO_BYTES, stream) != hipSuccess) { fprintf(stderr, "kernel_launch: hipMemsetAsync failed\n"); return; }
    Args a{};
    for (int i = 0; i < 19; ++i) a.in[i] = (const float*)d_in[i];
    a.out = (float*)d_out; a.ws = (unsigned char*)d_ws;
    for (int li = 0; li < N_LAUNCHES; ++li) {
        if (N_LAUNCHES == 1) { a.ph_lo = 0; a.ph_hi = N_PHASES; } else { a.ph_lo = li; a.ph_hi = li + 1; }
        a.li = li;
        hipLaunchKernelGGL(mega_fwd, dim3(grid), dim3(NWAVES * 64), LDS_BYTES, stream, a);
        const hipError_t le = hipPeekAtLastError();
        if (le != hipSuccess) { fprintf(stderr, "kernel_launch: launch %d failed: %s\n", li, hipGetErrorName(le)); break; }
    }
}
```

```cpp
#include <hip/hip_runtime.h>
#include <cstdio>
#include <cstdint>
namespace pg8 {
#define PG8_LAS __attribute__((address_space(3)))
typedef unsigned short bf16_t;
typedef short bf16x8 __attribute__((ext_vector_type(8)));
typedef float f32x4 __attribute__((ext_vector_type(4)));
typedef unsigned u32x4 __attribute__((ext_vector_type(4)));
constexpr int BM = 256, BK = 64, HALF = 128, HTB = HALF * BK * 2  , STAGE_BYTES = 8 * HTB, NXCD = 8, WGM = 8;

__host__ __device__ __forceinline__ int lds_byte(int r, int c) { const int st = (r >> 4) * 2 + (c >> 5), rr = r & 15, cc = c & 31, ob = rr * 64 + cc * 2; return st * 1024 + (ob ^ (((ob >> 9) & 1) << 5)); }
__host__ __device__ __forceinline__ void stage_rc(int b, int& R, int& C) { const int st = b / 1024, sb = b % 1024, swz = sb ^ (((sb >> 9) & 1) << 5); R = (st >> 1) * 16 + swz / 64; C = (st & 1) * 32 + (swz % 64) / 2; }
__host__ __device__ __forceinline__ int perm32(int rho) { const int n = rho >> 4, i = rho & 15; return 8 * (i >> 2) + 4 * n + (i & 3); }

struct Unit { int pm, pn; };
struct Gemm { const bf16_t* A; const bf16_t* Bt; int M, N, K; };

struct StaticOrder {
    int nM, nN, nwg, G, c;
    __host__ __device__ void init(int M, int N, int G_, int c_) { nM = M / BM; nN = N / BM; nwg = nM * nN; G = G_; c = c_; }
    __host__ __device__ bool next(int i, Unit& u) const {
        const long L = (long)i * G + c; if (L >= nwg) return false;
        int wgid = (int)L; { const int q = nwg / NXCD, r = nwg % NXCD, xcd = wgid % NXCD, off = wgid / NXCD; wgid = (xcd < r ? xcd * (q + 1) : r * (q + 1) + (xcd - r) * q) + off; }
        const int nig = WGM * nN, gid = wgid / nig, fm = gid * WGM, gsz = (nM - fm) < WGM ? (nM - fm) : WGM;
        u.pm = fm + ((wgid % nig) % gsz); u.pn = (wgid % nig) / gsz; return true;
    }
    __device__ __forceinline__ void a_ready(const Unit&) const {}
    __device__ __forceinline__ void done(const Unit&) const {}
};

__device__ __forceinline__ unsigned cvt_pk_bf16(float lo, float hi) { unsigned r; asm volatile("v_cvt_pk_bf16_f32 %0, %1, %2" : "=v"(r) : "v"(lo), "v"(hi)); return r; }
__device__ __forceinline__ float bf_lo(unsigned w) { return __uint_as_float(w << 16); }
__device__ __forceinline__ float bf_hi(unsigned w) { return __uint_as_float(w & 0xffff0000u); }
constexpr float RMS_EPS = 1e-6f;
__device__ __forceinline__ float row_rstd(const float* ssqp, int r, int fq) {
    const f32x4 p = *(const f32x4*)(ssqp + (size_t)r * 16 + 4 * fq);
    float s = (p[0] + p[1]) + (p[2] + p[3]);
    s += __shfl_xor(s, 16); s += __shfl_xor(s, 32);
    return __builtin_amdgcn_rsqf(s * (1.0f / 1024.0f) + RMS_EPS);
}
__device__ __forceinline__ float fast_sigmoid(float x) { return __builtin_amdgcn_rcpf(1.0f + __builtin_amdgcn_exp2f(-1.4426950408889634f * x)); }
struct EpiSwiGLU {
    static constexpr bool PERM = true, AFTER_DRAIN = false;
    bf16_t* O; int ldc; const float* ssqp;
    __device__ __forceinline__ void operator()(const f32x4 (&acc)[2][2][4][2], const Unit& u, int wr, int wc, int fr, int fq) const {
        const int row0 = u.pm * BM + wr * 64 + fr, col0 = u.pn * HALF + wc * 32 + 8 * fq;
#pragma unroll
        for (int ai = 0; ai < 2; ++ai)
#pragma unroll
            for (int m = 0; m < 4; ++m) { const int r = row0 + ai * HALF + m * 16; const float rs = row_rstd(ssqp, r, fq);
                float h[8];
#pragma unroll
                for (int n = 0; n < 2; ++n)
#pragma unroll
                    for (int j = 0; j < 4; ++j) { const float g = acc[ai][0][m][n][j] * rs, up = acc[ai][1][m][n][j] * rs; h[n * 4 + j] = g * fast_sigmoid(g) * up; }
                u32x4 w; w.x = cvt_pk_bf16(h[0], h[1]); w.y = cvt_pk_bf16(h[2], h[3]); w.z = cvt_pk_bf16(h[4], h[5]); w.w = cvt_pk_bf16(h[6], h[7]);
                *(u32x4*)(O + (size_t)r * ldc + col0) = w; }
    }
};
template <int HALF_ALPHA> struct EpiResid {
    static constexpr bool PERM = true, AFTER_DRAIN = false; static constexpr float alpha = HALF_ALPHA ? 0.5f : 1.0f;
    const float* base; float* out; bf16_t* ob; float* ssq_out;
    __device__ __forceinline__ void operator()(const f32x4 (&acc)[2][2][4][2], const Unit& u, int wr, int wc, int fr, int fq) const {
        const int row0 = u.pm * BM + wr * 64 + fr, col0 = u.pn * BM + wc * 32 + 8 * fq;
#pragma unroll
        for (int ai = 0; ai < 2; ++ai)
#pragma unroll
            for (int m = 0; m < 4; ++m) { const int r = row0 + ai * HALF + m * 16; float ss = 0.f;
#pragma unroll
                for (int bj = 0; bj < 2; ++bj) { const size_t off = (size_t)r * 1024 + col0 + bj * HALF;
                    const f32x4 b0 = *(const f32x4*)(base + off), b1 = *(const f32x4*)(base + off + 4);
                    const f32x4 v0 = b0 + acc[ai][bj][m][0] * alpha, v1 = b1 + acc[ai][bj][m][1] * alpha;
                    *(f32x4*)(out + off) = v0; *(f32x4*)(out + off + 4) = v1;
                    u32x4 w; w.x = cvt_pk_bf16(v0[0], v0[1]); w.y = cvt_pk_bf16(v0[2], v0[3]); w.z = cvt_pk_bf16(v1[0], v1[1]); w.w = cvt_pk_bf16(v1[2], v1[3]);
                    *(u32x4*)(ob + off) = w;
                    ss += (v0[0] * v0[0] + v0[1] * v0[1]) + (v0[2] * v0[2] + v0[3] * v0[3]) + (v1[0] * v1[0] + v1[1] * v1[1]) + (v1[2] * v1[2] + v1[3] * v1[3]); }
                ss += __shfl_xor(ss, 16); ss += __shfl_xor(ss, 32);
                if (fq == 0) ssq_out[(size_t)r * 16 + 4 * u.pn + wc] = ss; }
    }
};
constexpr int UW = 3328;
struct EpiWin {
    static constexpr bool PERM = true, AFTER_DRAIN = false;
    bf16_t* U; float* loga; const float* ssqp; const float* bgk;
    __device__ __forceinline__ void operator()(const f32x4 (&acc)[2][2][4][2], const Unit& u, int wr, int wc, int fr, int fq) const {
        const int row0 = u.pm * BM + wr * 64 + fr, cl0 = wc * 32 + 8 * fq;
        const float sc = (u.pn == 0) ? 0.125f : 1.0f;
#pragma unroll
        for (int ai = 0; ai < 2; ++ai)
#pragma unroll
            for (int m = 0; m < 4; ++m) { const int r = row0 + ai * HALF + m * 16; const float rs = row_rstd(ssqp, r, fq);
#pragma unroll
                for (int bj = 0; bj < 2; ++bj) { const int cl = cl0 + bj * HALF;
                    const f32x4 v0 = acc[ai][bj][m][0] * rs, v1 = acc[ai][bj][m][1] * rs;
                    if (u.pn == 6) {
                        const f32x4 c0 = *(const f32x4*)(bgk + cl), c1 = *(const f32x4*)(bgk + cl + 4); f32x4 o0, o1;
#pragma unroll
                        for (int j = 0; j < 4; ++j) { const float x0 = v0[j] + c0[j], x1 = v1[j] + c1[j];
                            o0[j] = (fminf(x0, 0.f) - log1pf(__expf(-fabsf(x0)))) * (1.0f / 16.0f); o1[j] = (fminf(x1, 0.f) - log1pf(__expf(-fabsf(x1)))) * (1.0f / 16.0f); }
                        *(f32x4*)(loga + (size_t)r * 256 + cl) = o0; *(f32x4*)(loga + (size_t)r * 256 + cl + 4) = o1;
                    } else {
                        u32x4 w; w.x = cvt_pk_bf16(v0[0] * sc, v0[1] * sc); w.y = cvt_pk_bf16(v0[2] * sc, v0[3] * sc); w.z = cvt_pk_bf16(v1[0] * sc, v1[1] * sc); w.w = cvt_pk_bf16(v1[2] * sc, v1[3] * sc);
                        *(u32x4*)(U + (size_t)r * UW + u.pn * BM + cl) = w; } } }
    }
};
struct EpiPlain {
    static constexpr bool PERM = true, AFTER_DRAIN = false;
    bf16_t* O;
    __device__ __forceinline__ void operator()(const f32x4 (&acc)[2][2][4][2], const Unit& u, int wr, int wc, int fr, int fq) const {
        const int row0 = u.pm * BM + wr * 64 + fr, col0 = u.pn * BM + wc * 32 + 8 * fq;
#pragma unroll
        for (int ai = 0; ai < 2; ++ai)
#pragma unroll
            for (int m = 0; m < 4; ++m) { const int r = row0 + ai * HALF + m * 16;
#pragma unroll
                for (int bj = 0; bj < 2; ++bj) { const f32x4 v0 = acc[ai][bj][m][0], v1 = acc[ai][bj][m][1];
                    u32x4 w; w.x = cvt_pk_bf16(v0[0], v0[1]); w.y = cvt_pk_bf16(v0[2], v0[3]); w.z = cvt_pk_bf16(v1[0], v1[1]); w.w = cvt_pk_bf16(v1[2], v1[3]);
                    *(u32x4*)(O + (size_t)r * 1024 + col0 + bj * HALF) = w; } }
    }
};
struct EpiPle {
    static constexpr bool PERM = true, AFTER_DRAIN = false;
    const float* base; float* out; const bf16_t* pp; const float* ssqp; float* ssq_out;
    __device__ __forceinline__ void operator()(const f32x4 (&acc)[2][2][4][2], const Unit& u, int wr, int wc, int fr, int fq) const {
        const int row0 = u.pm * BM + wr * 64 + fr, col0 = u.pn * BM + wc * 32 + 8 * fq;
#pragma unroll
        for (int ai = 0; ai < 2; ++ai)
#pragma unroll
            for (int m = 0; m < 4; ++m) { const int r = row0 + ai * HALF + m * 16; const float rs = row_rstd(ssqp, r, fq); float ss = 0.f;
#pragma unroll
                for (int bj = 0; bj < 2; ++bj) { const size_t off = (size_t)r * 1024 + col0 + bj * HALF;
                    const f32x4 b0 = *(const f32x4*)(base + off), b1 = *(const f32x4*)(base + off + 4);
                    const u32x4 pw = *(const u32x4*)(pp + off);
                    f32x4 v0, v1;
                    v0[0] = b0[0] + fast_sigmoid(acc[ai][bj][m][0][0] * rs) * bf_lo(pw.x); v0[1] = b0[1] + fast_sigmoid(acc[ai][bj][m][0][1] * rs) * bf_hi(pw.x);
                    v0[2] = b0[2] + fast_sigmoid(acc[ai][bj][m][0][2] * rs) * bf_lo(pw.y); v0[3] = b0[3] + fast_sigmoid(acc[ai][bj][m][0][3] * rs) * bf_hi(pw.y);
                    v1[0] = b1[0] + fast_sigmoid(acc[ai][bj][m][1][0] * rs) * bf_lo(pw.z); v1[1] = b1[1] + fast_sigmoid(acc[ai][bj][m][1][1] * rs) * bf_hi(pw.z);
                    v1[2] = b1[2] + fast_sigmoid(acc[ai][bj][m][1][2] * rs) * bf_lo(pw.w); v1[3] = b1[3] + fast_sigmoid(acc[ai][bj][m][1][3] * rs) * bf_hi(pw.w);
                    *(f32x4*)(out + off) = v0; *(f32x4*)(out + off + 4) = v1;
                    ss += (v0[0] * v0[0] + v0[1] * v0[1]) + (v0[2] * v0[2] + v0[3] * v0[3]) + (v1[0] * v1[0] + v1[1] * v1[1]) + (v1[2] * v1[2] + v1[3] * v1[3]); }
                ss += __shfl_xor(ss, 16); ss += __shfl_xor(ss, 32);
                if (fq == 0) ssq_out[(size_t)r * 16 + 4 * u.pn + wc] = ss; }
    }
};
template <class Epi, class Sched, bool ALIGN_EPI = false, bool SP2 = false>
__device__ __forceinline__ void gemm_phase(PG8_LAS unsigned char* lds, const Gemm g, const Sched& S, const Epi& E) {
    const int tid = threadIdx.x, wid = __builtin_amdgcn_readfirstlane(tid >> 6), lane = tid & 63, wr = wid >> 2, wc = wid & 3, fr = lane & 15, fq = lane >> 4;
    const int K = g.K, nt = K / BK;
    unsigned voffA[2], voffB[2];
#pragma unroll
    for (int i = 0; i < 2; ++i) { int R, C; stage_rc(tid * 16 + i * 8192, R, C); const int Rb = Epi::PERM ? ((R & ~31) + perm32(R & 31)) : R;
        voffA[i] = (unsigned)(R * K + C) * 2u; voffB[i] = (unsigned)(Rb * K + C) * 2u; }
    const size_t kstep = (size_t)(BK * 2);
    const size_t hstep = (size_t)HALF * K * 2;
    const size_t tstep = 2 * hstep;
    const unsigned ldsw = (unsigned)wid * 1024u;
    const int aoff = lds_byte(wr * 64 + fr, fq * 8), boff = lds_byte(wc * 32 + fr, fq * 8);
#define PG8_SA(b, h) (((b) * 2 + (h)) * HTB)
#define PG8_SB(b, h) ((4 + (b) * 2 + (h)) * HTB)
#define PG8_STAGE(bufoff, gbase, voff) do { _Pragma("unroll") for (int _i = 0; _i < 2; ++_i) \
        __builtin_amdgcn_global_load_lds((const unsigned*)((const char*)(gbase) + (voff)[_i]), (PG8_LAS unsigned*)(lds + (bufoff) + ldsw + _i * 8192), 16, 0, 0); } while (0)
#define PG8_LDA(dst, b, h) do { _Pragma("unroll") for (int m = 0; m < 4; ++m) _Pragma("unroll") for (int k = 0; k < 2; ++k) dst[m][k] = *(const PG8_LAS bf16x8*)(lds + PG8_SA(b, h) + aoff + m * 2048 + k * 1024); } while (0)
#define PG8_LDB(dst, b, h) do { _Pragma("unroll") for (int n = 0; n < 2; ++n) _Pragma("unroll") for (int k = 0; k < 2; ++k) dst[n][k] = *(const PG8_LAS bf16x8*)(lds + PG8_SB(b, h) + boff + n * 2048 + k * 1024); } while (0)
#define PG8_MMA(ai, bj, At, Bt) do { __builtin_amdgcn_s_setprio(1); _Pragma("unroll") for (int m = 0; m < 4; ++m) _Pragma("unroll") for (int n = 0; n < 2; ++n) _Pragma("unroll") for (int k = 0; k < 2; ++k) \
        acc[ai][bj][m][n] = __builtin_amdgcn_mfma_f32_16x16x32_bf16(Bt[n][k], At[m][k], acc[ai][bj][m][n], 0, 0, 0); __builtin_amdgcn_s_setprio(0); } while (0)
#define PG8_WAIT_V(n) asm volatile("s_waitcnt vmcnt(" #n ")" ::: "memory")
#define PG8_WAIT_L(n) asm volatile("s_waitcnt lgkmcnt(" #n ")" ::: "memory")
#define PG8_BAR __builtin_amdgcn_s_barrier()
#define PG8_SCHED __builtin_amdgcn_sched_barrier(0)
    Unit cur, nxt; int ui = 0;
    if (!S.next(0, cur)) return;
    f32x4 acc[2][2][4][2];
#pragma unroll
    for (int a = 0; a < 2; ++a)
#pragma unroll
        for (int b = 0; b < 2; ++b)
#pragma unroll
            for (int m = 0; m < 4; ++m)
#pragma unroll
                for (int n = 0; n < 2; ++n) acc[a][b][m][n] = (f32x4){0.f, 0.f, 0.f, 0.f};
    bf16x8 At[4][2], B0[2][2], B1[2][2];
    const char* cA = (const char*)g.A + (size_t)cur.pm * tstep; const char* cB = (const char*)g.Bt + (size_t)cur.pn * tstep;
    S.a_ready(cur);
    if constexpr (SP2) {
        PG8_STAGE(PG8_SB(0, 0), cB, voffB); PG8_STAGE(PG8_SB(0, 1), cB + hstep, voffB); PG8_STAGE(PG8_SA(0, 0), cA, voffA); PG8_STAGE(PG8_SA(0, 1), cA + hstep, voffA);
        if (wr == 1) PG8_BAR;
        PG8_WAIT_V(2); PG8_BAR;
        PG8_STAGE(PG8_SB(1, 0), cB + kstep, voffB); PG8_STAGE(PG8_SA(1, 0), cA + kstep, voffA); PG8_STAGE(PG8_SB(1, 1), cB + hstep + kstep, voffB);
        PG8_WAIT_V(6); PG8_BAR;
    } else {
        PG8_STAGE(PG8_SB(0, 0), cB, voffB); PG8_STAGE(PG8_SA(0, 0), cA, voffA); PG8_STAGE(PG8_SB(0, 1), cB + hstep, voffB); PG8_STAGE(PG8_SA(0, 1), cA + hstep, voffA);
        if (wr == 1) PG8_BAR;
        PG8_WAIT_V(4); PG8_BAR;
        PG8_STAGE(PG8_SB(1, 0), cB + kstep, voffB); PG8_STAGE(PG8_SA(1, 0), cA + kstep, voffA); PG8_STAGE(PG8_SB(1, 1), cB + hstep + kstep, voffB);
        PG8_WAIT_V(6); PG8_BAR;
    }
    for (;;) {
        const bool has_next = S.next(ui + 1, nxt);
        const char* nA = has_next ? (const char*)g.A + (size_t)nxt.pm * tstep : cA; const char* nB = has_next ? (const char*)g.Bt + (size_t)nxt.pn * tstep : cB;
        for (int t = 0; t < nt; t += 2) {
            const bool last = (t == nt - 2);
            const char* a1 = cA + (size_t)(t + 1) * kstep;
            const char* a2 = last ? nA : cA + (size_t)(t + 2) * kstep; const char* b2 = last ? nB : cB + (size_t)(t + 2) * kstep;
            const char* a3 = a2 + kstep; const char* b3 = b2 + kstep;
            if (last && has_next) S.a_ready(nxt);
            if constexpr (SP2) {
            PG8_LDB(B0, 0, 0); PG8_LDB(B1, 0, 1); PG8_SCHED; PG8_LDA(At, 0, 0); PG8_STAGE(PG8_SA(1, 1), a1 + hstep, voffA);
            PG8_WAIT_V(8); PG8_WAIT_L(0); PG8_BAR; PG8_MMA(0, 0, At, B0); PG8_MMA(0, 1, At, B1); PG8_BAR; PG8_SCHED;
            PG8_LDA(At, 0, 1); PG8_STAGE(PG8_SB(0, 0), b2, voffB); PG8_STAGE(PG8_SB(0, 1), b2 + hstep, voffB); PG8_STAGE(PG8_SA(0, 0), a2, voffA);
            PG8_WAIT_V(8); PG8_WAIT_L(0); PG8_BAR; PG8_MMA(1, 0, At, B0); PG8_MMA(1, 1, At, B1); PG8_BAR; PG8_SCHED;
            PG8_LDB(B0, 1, 0); PG8_LDB(B1, 1, 1); PG8_SCHED; PG8_LDA(At, 1, 0); PG8_STAGE(PG8_SA(0, 1), a2 + hstep, voffA);
            PG8_WAIT_V(8); PG8_WAIT_L(0); PG8_BAR; PG8_MMA(0, 0, At, B0); PG8_MMA(0, 1, At, B1); PG8_BAR; PG8_SCHED;
            PG8_LDA(At, 1, 1); PG8_STAGE(PG8_SB(1, 0), b3, voffB); PG8_STAGE(PG8_SB(1, 1), b3 + hstep, voffB); PG8_STAGE(PG8_SA(1, 0), a3, voffA);
            PG8_WAIT_V(8); PG8_WAIT_L(0); PG8_BAR; PG8_MMA(1, 0, At, B0); PG8_MMA(1, 1, At, B1); PG8_BAR; PG8_SCHED;
            } else {
            PG8_LDB(B0, 0, 0); PG8_SCHED; PG8_LDA(At, 0, 0); PG8_STAGE(PG8_SA(1, 1), a1 + hstep, voffA);
            PG8_WAIT_L(8); PG8_BAR; PG8_WAIT_L(0); PG8_MMA(0, 0, At, B0); PG8_BAR; PG8_SCHED;
            PG8_LDB(B1, 0, 1); PG8_STAGE(PG8_SB(0, 0), b2, voffB);
            PG8_BAR; PG8_WAIT_L(0); PG8_MMA(0, 1, At, B1); PG8_BAR;
            PG8_LDA(At, 0, 1); PG8_STAGE(PG8_SA(0, 0), a2, voffA);
            PG8_BAR; PG8_WAIT_L(0); PG8_MMA(1, 0, At, B0); PG8_BAR; PG8_SCHED;
            PG8_STAGE(PG8_SB(0, 1), b2 + hstep, voffB);
            PG8_WAIT_V(6); PG8_BAR; PG8_MMA(1, 1, At, B1); PG8_BAR;
            PG8_LDB(B0, 1, 0); PG8_SCHED; PG8_LDA(At, 1, 0); PG8_STAGE(PG8_SA(0, 1), a2 + hstep, voffA);
            PG8_WAIT_L(8); PG8_BAR; PG8_WAIT_L(0); PG8_MMA(0, 0, At, B0); PG8_BAR; PG8_SCHED;
            PG8_LDB(B1, 1, 1); PG8_STAGE(PG8_SB(1, 0), b3, voffB);
            PG8_BAR; PG8_WAIT_L(0); PG8_MMA(0, 1, At, B1); PG8_BAR;
            PG8_LDA(At, 1, 1); PG8_STAGE(PG8_SA(1, 0), a3, voffA);
            PG8_BAR; PG8_WAIT_L(0); PG8_MMA(1, 0, At, B0); PG8_BAR; PG8_SCHED;
            PG8_STAGE(PG8_SB(1, 1), b3 + hstep, voffB);
            PG8_WAIT_V(6); PG8_BAR; PG8_MMA(1, 1, At, B1); PG8_BAR;
            }
        }
        if constexpr (ALIGN_EPI) { if (wr == 0) PG8_BAR; }
        if constexpr (!Epi::AFTER_DRAIN) { E(acc, cur, wr, wc, fr, fq); S.done(cur); }
        if (!has_next) break;
#pragma unroll
        for (int a = 0; a < 2; ++a)
#pragma unroll
            for (int b = 0; b < 2; ++b)
#pragma unroll
                for (int m = 0; m < 4; ++m)
#pragma unroll
                    for (int n = 0; n < 2; ++n) acc[a][b][m][n] = (f32x4){0.f, 0.f, 0.f, 0.f};
        cur = nxt; cA = nA; cB = nB; ++ui;
        if constexpr (ALIGN_EPI) { if (wr == 1) PG8_BAR; }
    }
    PG8_WAIT_V(0);
    if constexpr (!ALIGN_EPI) { if (wr == 0) PG8_BAR; }
    PG8_BAR;
    if constexpr (Epi::AFTER_DRAIN) { E.fused(acc, cur, wr, wc, fr, fq, lds, wid, lane); S.done(cur); }
#undef PG8_SA
#undef PG8_SB
#undef PG8_STAGE
#undef PG8_LDA
#undef PG8_LDB
#undef PG8_MMA
#undef PG8_WAIT_V
#undef PG8_WAIT_L
#undef PG8_BAR
#undef PG8_SCHED
}
}
#ifndef PG8_SP2
#define PG8_SP2 true
#endif
#ifndef PG8_ALIGN
#define PG8_ALIGN true
#endif
constexpr int NWAVES = 8;
constexpr int N_PHASES = 12;
#ifndef MK_N_LAUNCHES
#define MK_N_LAUNCHES 1
#endif
constexpr int N_LAUNCHES = MK_N_LAUNCHES;

constexpr int M = 16384, D = 1024, FF = 2816, NGU = 2 * FF, DPLE = 256;
constexpr int GH = 4, GDK = 64, GDV = 128, MH = 8, MHD = 64, MBLK = 256, NBLK = M / MBLK;
constexpr int UWID = 3328;
constexpr int U_QG = 0, U_KG = 256, U_VG = 512, U_GG = 1024, U_QM = 1792, U_KM = 2304, U_VM = 2816;
constexpr float EPS = 1e-6f;

constexpr size_t MiB = 1u << 20;
constexpr size_t WS_CTL = 0, CTL_ZERO_BYTES = 1 * MiB;
constexpr size_t WS_WGU1 = 1 * MiB, WS_WD1 = 12 * MiB, WS_WIN = 18 * MiB, WS_WOUT = 25 * MiB, WS_WGU2 = 27 * MiB, WS_WD2 = 38 * MiB, WS_WPG = 44 * MiB, WS_WPP = 46 * MiB;
constexpr size_t WS_SSQ1 = 47 * MiB, WS_SSQ2 = 48 * MiB, WS_SSQ3 = 49 * MiB, WS_SSQ4 = 50 * MiB, WS_SSQ5 = 51 * MiB, WS_KMEAN = 52 * MiB;
constexpr size_t WS_HB = 54 * MiB;
constexpr size_t WS_PB = 86 * MiB;
constexpr size_t WS_MIX = 94 * MiB;
constexpr size_t WS_U = 126 * MiB;
constexpr size_t WS_LOGA = 230 * MiB;
constexpr size_t WS_PP = 214 * MiB;
constexpr size_t WS_END = 256 * MiB;
static_assert(WS_U + (size_t)M * UWID * 2 <= WS_LOGA && WS_LOGA + (size_t)M * 256 * 4 <= WS_END && WS_U + (size_t)M * FF * 2 <= WS_PP && WS_PP + (size_t)M * D * 2 <= WS_END, "d_ws map");
constexpr int CW_TMO = 0, CW_CODE = 1;
constexpr int CW_BAR = 4096;

constexpr int RING_OFF = 0, RING_BYTES = 131072;
constexpr int LDSCTL_OFF = RING_BYTES, MISC_OFF = LDSCTL_OFF + 320;
constexpr int LDS_BYTES = 147456;
#define GAS __attribute__((address_space(1)))
#define LAS __attribute__((address_space(3)))
typedef unsigned short bf16;
typedef unsigned v4u __attribute__((ext_vector_type(4)));
typedef float f32x4 __attribute__((ext_vector_type(4)));
typedef short bf16x8 __attribute__((ext_vector_type(8)));
typedef GAS unsigned gu32;
typedef GAS unsigned long long gu64;
#define RLX_AGENT __ATOMIC_RELAXED, __HIP_MEMORY_SCOPE_AGENT
#define LDS_WAIT() asm volatile("s_waitcnt lgkmcnt(0)" ::: "memory")
#define VM_WAIT() asm volatile("s_waitcnt vmcnt(0)" ::: "memory")
__device__ __forceinline__ unsigned long long rt() { return __builtin_amdgcn_s_memrealtime(); }
__device__ __forceinline__ unsigned f2bf(float f) { unsigned u = __builtin_bit_cast(unsigned, f); return (u + 0x7fffu + ((u >> 16) & 1u)) >> 16; }
__device__ __forceinline__ unsigned pk2(float lo, float hi) { return f2bf(lo) | (f2bf(hi) << 16); }

#define XB_TMO      128
#define XB_XCNT(j)  (256  + 64 * (j))
#define XB_XSUB(j)  (1280 + 64 * (j))
#define XB_XGEN(j)  (2304 + 64 * (j))
#define XB_TOP      3328
#define XB_TOPGEN   3392
#define XCD_BAR_WORDS 3456
#define XB_SPIN_CAP (1u << 18)

__device__ __forceinline__ unsigned xb_ld(unsigned* p)              { return __hip_atomic_load(p, __ATOMIC_RELAXED, __HIP_MEMORY_SCOPE_AGENT); }
__device__ __forceinline__ unsigned xb_add(unsigned* p, unsigned v) { return __hip_atomic_fetch_add(p, v, __ATOMIC_RELAXED, __HIP_MEMORY_SCOPE_AGENT); }
__device__ __forceinline__ unsigned xb_xcc_id() { return (unsigned)__builtin_amdgcn_s_getreg((3 << 11) | 20) & 0xFu; }
#define XB_SPIN(cond, bar) do { unsigned _sp = 0; while (cond) { __builtin_amdgcn_s_sleep(1); \
    if ((++_sp & 255u) == 0u) { if (xb_ld(&(bar)[XB_TMO])) break; if (_sp > XB_SPIN_CAP) { atomicAdd(&(bar)[XB_TMO], 1u); break; } } } } while (0)

struct XcdBarrier {
    unsigned* bar; unsigned x;
    volatile LAS unsigned* st;
};

__device__ __forceinline__ XcdBarrier xcd_barrier_post(unsigned* bar, volatile LAS unsigned* st) {
    XcdBarrier b; b.bar = bar; b.x = xb_xcc_id(); b.st = st;
    if (threadIdx.x == 0) (void)xb_add(&bar[XB_XCNT(b.x)], 1u);
    return b;
}
__device__ __forceinline__ void xcd_barrier_complete(unsigned* bar, unsigned x, unsigned& nloc, unsigned& nx) {
    const unsigned G = gridDim.x * gridDim.y * gridDim.z;
    unsigned sum, cnt, mine, sp = 0u;
    for (;;) {
        sum = 0u; cnt = 0u; mine = 0u;
#pragma unroll
        for (unsigned j = 0; j < 16; ++j) { const unsigned c = xb_ld(&bar[XB_XCNT(j)]); sum += c; cnt += (c > 0u) ? 1u : 0u; mine = (j == x) ? c : mine; }
        if (sum == G) break;
        __builtin_amdgcn_s_sleep(1);
        if ((++sp & 255u) == 0u) { if (xb_ld(&bar[XB_TMO])) break; if (sp > XB_SPIN_CAP) { atomicAdd(&bar[XB_TMO], 1u); break; } }
    }
    nloc = mine > 0u ? mine : 1u; nx = cnt > 0u ? cnt : 1u;
}

__device__ __forceinline__ void xcd_barrier(const XcdBarrier& b) {
    asm volatile("s_waitcnt vmcnt(0)" ::: "memory");
    __syncthreads();
    if (threadIdx.x == 0) {
        unsigned* bar = b.bar;
        __builtin_amdgcn_s_waitcnt(0);
        unsigned nloc = b.st[0], nx = b.st[1];
        if (nloc == 0u) { xcd_barrier_complete(bar, b.x, nloc, nx); b.st[0] = nloc; b.st[1] = nx; }
        const unsigned old = xb_add(&bar[XB_XSUB(b.x)], 1u);
        const unsigned gen = old / nloc;
        if (old + 1u == (gen + 1u) * nloc) {
            __builtin_amdgcn_fence(__ATOMIC_RELEASE, "agent");
            asm volatile("s_waitcnt vmcnt(0)" ::: "memory");
            const unsigned og = xb_add(&bar[XB_TOP], 1u);
            const unsigned tg = og / nx;
            if (og + 1u == (tg + 1u) * nx) xb_add(&bar[XB_TOPGEN], 1u);
            else XB_SPIN(xb_ld(&bar[XB_TOPGEN]) == tg, bar);
            __builtin_amdgcn_fence(__ATOMIC_ACQUIRE, "agent");
            xb_add(&bar[XB_XGEN(b.x)], 1u);
            asm volatile("s_waitcnt vmcnt(0)" ::: "memory");
        } else {
            XB_SPIN(xb_ld(&bar[XB_XGEN(b.x)]) == gen, bar);
            __builtin_amdgcn_fence(__ATOMIC_ACQUIRE, "agent");
            asm volatile("s_waitcnt vmcnt(0)" ::: "memory");
        }
    }
    __syncthreads();
}
struct Frame {
    LAS unsigned char* lds;
    volatile LAS unsigned* MISC;
    gu32* ctl;
    int tid, lane, wave;
    int vcu, G;
};
__device__ __forceinline__ int fresh_lane() { int l; asm volatile("v_mbcnt_lo_u32_b32 %0, -1, 0\n\tv_mbcnt_hi_u32_b32 %0, -1, %0" : "=v"(l)); return l; }
__device__ __forceinline__ float wave_sum(float v) {
#pragma unroll
    for (int o = 1; o < 64; o <<= 1) v += __shfl_xor(v, o);
    return v;
}
__device__ __forceinline__ float wave_max(float v) {
#pragma unroll
    for (int o = 1; o < 64; o <<= 1) v = fmaxf(v, __shfl_xor(v, o));
    return v;
}
__device__ __forceinline__ float bf2f(bf16 h) { return __uint_as_float((unsigned)h << 16); }
__device__ __forceinline__ float bf_lo2(unsigned w) { return __uint_as_float(w << 16); }
__device__ __forceinline__ float bf_hi2(unsigned w) { return __uint_as_float(w & 0xffff0000u); }

__device__ __forceinline__ void tr_store(bf16* WT, int K, int k0, int n0dst, LAS float* scr, int lane) {
    LDS_WAIT(); asm volatile("" ::: "memory");
    const int c = lane & 7;
#pragma unroll
    for (int j = 0; j < 4; ++j) { const int n = (lane >> 3) + 8 * j; const LAS float* s = scr + (8 * c) * 33 + n;
        v4u o; o.x = pk2(s[0 * 33], s[1 * 33]); o.y = pk2(s[2 * 33], s[3 * 33]); o.z = pk2(s[4 * 33], s[5 * 33]); o.w = pk2(s[6 * 33], s[7 * 33]);
        *(GAS v4u*)(WT + (size_t)(n0dst + n) * K + k0 + 8 * c) = o; }
    LDS_WAIT(); asm volatile("" ::: "memory");
}
__device__ __forceinline__ void tr_item(const float* W, int K, int N, const float* gain, bf16* WT, int k0, int n0dst, int c0src, LAS float* scr, int lane) {
#pragma unroll 8
    for (int i = 0; i < 32; ++i) { const int kk = 2 * i + (lane >> 5); const float g = gain ? gain[k0 + kk] : 1.0f;
        scr[kk * 33 + (lane & 31)] = W[(size_t)(k0 + kk) * N + c0src + (lane & 31)] * g; }
    tr_store(WT, K, k0, n0dst, scr, lane);
}
__device__ __forceinline__ void tr_item_gk(const float* Win, const float* Wup, const float* gain, bf16* WT, int k0, int j0, LAS float* scr, int lane) {
    for (int i = 0; i < 32; ++i) { const int kk = 2 * i + (lane >> 5), k = k0 + kk, j = j0 + (lane & 31); float a = 0.f;
#pragma unroll
        for (int r = 0; r < 16; ++r) a += Win[(size_t)k * 3088 + 1536 + r] * Wup[r * 256 + j];
        scr[kk * 33 + (lane & 31)] = a * gain[k]; }
    tr_store(WT, 1024, k0, 1536 + j0, scr, lane);
}
struct Args { const float* in[19]; float* out; unsigned char* ws; int ph_lo, ph_hi, li, pad; };

__device__ __forceinline__ void p0_prologue(Frame& F, const Args& A) {
    LAS float* scr = (LAS float*)(F.lds + RING_OFF + F.wave * 16384);
    unsigned char* ws = A.ws;
    const int gw = F.vcu * NWAVES + F.wave, NGW = F.G * NWAVES, lane = fresh_lane();
    constexpr int I_GU = 16 * 176, I_D = 44 * 32, I_IN = 16 * 104, I_O = 16 * 32, I_PP = 4 * 32;
    constexpr int NITEMS = 2 * I_GU + 2 * I_D + I_IN + 2 * I_O + I_PP;
    for (int it = gw; it < NITEMS; it += NGW) {
        int r = it;
        if (r < 2 * I_GU) { const int which = r / I_GU; r -= which * I_GU; const int kb = r / 176, nb = r % 176, t = nb >> 3, g = nb & 7;
            const int src = (g < 4) ? (128 * t + 32 * g) : (FF + 128 * t + 32 * (g - 4));
            tr_item(A.in[which ? 12 : 3], D, NGU, A.in[which ? 11 : 2], (bf16*)(ws + (which ? WS_WGU2 : WS_WGU1)), 64 * kb, 32 * nb, src, scr, lane); continue; } r -= 2 * I_GU;
        if (r < 2 * I_D) { const int which = r / I_D; r -= which * I_D; const int kb = r / 32, nb = r % 32;
            tr_item(A.in[which ? 13 : 4], FF, D, nullptr, (bf16*)(ws + (which ? WS_WD2 : WS_WD1)), 64 * kb, 32 * nb, 32 * nb, scr, lane); continue; } r -= 2 * I_D;
        if (r < I_IN) { const int kb = r / 104, nb = r % 104;
            if (nb >= 48 && nb < 56) tr_item_gk(A.in[6], A.in[7], A.in[5], (bf16*)(ws + WS_WIN), 64 * kb, 32 * (nb - 48), scr, lane);
            else tr_item(A.in[6], D, 3088, A.in[5], (bf16*)(ws + WS_WIN), 64 * kb, 32 * nb, nb < 48 ? 32 * nb : 32 * nb - 240, scr, lane);
            continue; } r -= I_IN;
        if (r < 2 * I_O) { const int which = r / I_O; r -= which * I_O; const int kb = r / 32, nb = r % 32;
            tr_item(A.in[which ? 15 : 10], D, D, which ? A.in[14] : nullptr, (bf16*)(ws + (which ? WS_WPG : WS_WOUT)), 64 * kb, 32 * nb, 32 * nb, scr, lane); continue; } r -= 2 * I_O;
        { const int kb = r / 32, nb = r % 32; tr_item(A.in[16], DPLE, D, nullptr, (bf16*)(ws + WS_WPP), 64 * kb, 32 * nb, 32 * nb, scr, lane); }
    }
    const float* x = A.in[0]; const float* p = A.in[1];
    bf16* xb = (bf16*)(ws + WS_MIX); bf16* pb = (bf16*)(ws + WS_PB); float* ssq1 = (float*)(ws + WS_SSQ1);
    for (int m = gw; m < M; m += NGW) {
        const GAS f32x4* xr = (const GAS f32x4*)(x + (size_t)m * D) + lane; f32x4 v[4]; float s = 0.f;
#pragma unroll
        for (int j = 0; j < 4; ++j) { v[j] = xr[64 * j]; s += (v[j].x * v[j].x + v[j].y * v[j].y) + (v[j].z * v[j].z + v[j].w * v[j].w); }
        s = wave_sum(s);
        GAS unsigned long long* o8 = (GAS unsigned long long*)(xb + (size_t)m * D) + lane;
#pragma unroll
        for (int j = 0; j < 4; ++j) o8[64 * j] = (unsigned long long)pk2(v[j].x, v[j].y) | ((unsigned long long)pk2(v[j].z, v[j].w) << 32);
        if (lane < 16) ssq1[(size_t)m * 16 + lane] = (lane == 0) ? s : 0.f;
        const f32x4 pv = ((const GAS f32x4*)(p + (size_t)m * DPLE))[lane];
        ((GAS unsigned long long*)(pb + (size_t)m * DPLE))[lane] = (unsigned long long)pk2(pv.x, pv.y) | ((unsigned long long)pk2(pv.z, pv.w) << 32);
    }
}

__device__ __forceinline__ void moba_kmean(Frame& F, const bf16* U, float* kmean) {
    const int gw = F.vcu * NWAVES + F.wave, NGW = F.G * NWAVES, lane = fresh_lane();
    for (int u = gw; u < MH * NBLK; u += NGW) { const int h = u / NBLK, n = u % NBLK; float s = 0.f;
        const bf16* kp = U + (size_t)(n * MBLK) * UWID + U_KM + h * MHD + lane;
#pragma unroll 8
        for (int r = 0; r < MBLK; ++r) s += bf2f(kp[(size_t)r * UWID]);
        kmean[(size_t)u * 64 + lane] = s * (1.0f / MBLK); }
}
__device__ __forceinline__ void gla_seq(Frame& F, const bf16* U, const float* loga, float* oraw) {
    if (F.vcu >= 64) return;
    const int h = F.vcu >> 4, e = (F.vcu & 15) * 8 + F.wave, lane = fresh_lane();
    LAS float* scr = (LAS float*)(F.lds + RING_OFF) + F.wave * (32 * 65);
    float S = 0.f;
    for (int t0 = 0; t0 < M; t0 += 32) {
#pragma unroll 8
        for (int tt = 0; tt < 32; ++tt) { const size_t t = t0 + tt;
            const float a = __expf(loga[t * 256 + h * 64 + lane]);
            const float kk = bf2f(U[t * UWID + U_KG + h * 64 + lane]), qq = bf2f(U[t * UWID + U_QG + h * 64 + lane]), vv = bf2f(U[t * UWID + U_VG + h * 128 + e]);
            S = a * S + kk * vv;
            scr[tt * 65 + lane] = qq * S; }
        LDS_WAIT(); asm volatile("" ::: "memory");
        float o = 0.f; const int row = lane & 31, hf = lane >> 5;
#pragma unroll 16
        for (int j = 0; j < 32; ++j) o += scr[row * 65 + hf * 32 + j];
        o += __shfl_xor(o, 32);
        if (lane < 32) oraw[(size_t)(t0 + lane) * 512 + h * 128 + e] = o;
        LDS_WAIT(); asm volatile("" ::: "memory");
    }
}
__device__ __forceinline__ void gla_final(Frame& F, const bf16* U, const float* oraw, const float* gain, bf16* mix) {
    const int gw = F.vcu * NWAVES + F.wave, NGW = F.G * NWAVES, lane = fresh_lane();
    for (int u = gw; u < M * GH; u += NGW) { const int t = u >> 2, h = u & 3;
        const float o0 = oraw[(size_t)t * 512 + h * 128 + lane], o1 = oraw[(size_t)t * 512 + h * 128 + 64 + lane];
        const float ss = wave_sum(o0 * o0 + o1 * o1), rs = 1.0f / sqrtf(ss * (1.0f / 128.0f) + EPS);
        const float g0 = bf2f(U[(size_t)t * UWID + U_GG + h * 128 + lane]), g1 = bf2f(U[(size_t)t * UWID + U_GG + h * 128 + 64 + lane]);
        const float y0 = o0 * rs * gain[lane] * (g0 / (1.0f + __expf(-g0))), y1 = o1 * rs * gain[64 + lane] * (g1 / (1.0f + __expf(-g1)));
        mix[(size_t)t * D + h * 128 + lane] = (bf16)f2bf(y0); mix[(size_t)t * D + h * 128 + 64 + lane] = (bf16)f2bf(y1); }
}
__device__ __forceinline__ int rel_bucket(int n) { return n < 16 ? n : min(31, 16 + (31 - __clz(n * n)) - 8); }
__device__ __forceinline__ void moba_simple(Frame& F, const bf16* U, const float* kmean, const float* relb, bf16* mix) {
    const int gw = F.vcu * NWAVES + F.wave, NGW = F.G * NWAVES, lane = fresh_lane();
    LAS float* qs = (LAS float*)(F.lds + RING_OFF) + F.wave * 1088; LAS float* ps = qs + 64;
    for (int u = gw; u < M * MH; u += NGW) { const int t = u >> 3, h = u & 7, own = t >> 8;
        qs[lane] = bf2f(U[(size_t)t * UWID + U_QM + h * 64 + lane]);
        LDS_WAIT(); asm volatile("" ::: "memory");
        float g = -INFINITY;
        if (lane < own) { const float* km = kmean + (size_t)(h * NBLK + lane) * 64; float a = 0.f;
#pragma unroll 16
            for (int d = 0; d < 64; ++d) a += qs[d] * km[d];
            g = a; }
        int sel0 = -1, sel1 = -1, sel2 = -1;
#pragma unroll
        for (int j = 0; j < 3; ++j) { const float mx = wave_max(g); int s = -1;
            if (mx > -INFINITY) { const unsigned long long b = __ballot(g == mx); s = __ffsll((long long)b) - 1; if (lane == s) g = -INFINITY; }
            if (j == 0) sel0 = s; else if (j == 1) sel1 = s; else sel2 = s; }
        float sc[16]; float mloc = -1e30f;
#pragma unroll
        for (int b = 0; b < 4; ++b) { const int blk = b == 0 ? sel0 : b == 1 ? sel1 : b == 2 ? sel2 : own;
#pragma unroll
            for (int sb = 0; sb < 4; ++sb) { float s = -1e30f;
                if (blk >= 0) { const int key = blk * MBLK + sb * 64 + lane, dist = t - key;
                    const v4u* kp = (const v4u*)(U + (size_t)key * UWID + U_KM + h * 64); float a = 0.f;
#pragma unroll
                    for (int c = 0; c < 8; ++c) { const v4u w = kp[c];
                        a += qs[8 * c + 0] * bf_lo2(w.x) + qs[8 * c + 1] * bf_hi2(w.x) + qs[8 * c + 2] * bf_lo2(w.y) + qs[8 * c + 3] * bf_hi2(w.y)
                           + qs[8 * c + 4] * bf_lo2(w.z) + qs[8 * c + 5] * bf_hi2(w.z) + qs[8 * c + 6] * bf_lo2(w.w) + qs[8 * c + 7] * bf_hi2(w.w); }
                    if (dist >= 0) s = a * 0.125f + relb[rel_bucket(dist) * 8 + h]; }
                sc[b * 4 + sb] = s; mloc = fmaxf(mloc, s); } }
        const float mx = wave_max(mloc); float l = 0.f;
#pragma unroll
        for (int i = 0; i < 16; ++i) { const float pe = __expf(sc[i] - mx); ps[i * 64 + lane] = pe; l += pe; }
        l = wave_sum(l);
        LDS_WAIT(); asm volatile("" ::: "memory");
        float o = 0.f;
#pragma unroll
        for (int b = 0; b < 4; ++b) { const int blk = b == 0 ? sel0 : b == 1 ? sel1 : b == 2 ? sel2 : own;
            if (blk >= 0) { const bf16* vp = U + (size_t)(blk * MBLK) * UWID + U_VM + h * 64 + lane;
#pragma unroll 8
                for (int s = 0; s < MBLK; ++s) o += ps[b * 256 + s] * bf2f(vp[(size_t)s * UWID]); } }
        mix[(size_t)t * D + 512 + h * 64 + lane] = (bf16)f2bf(o / l);
        LDS_WAIT(); asm volatile("" ::: "memory");
    }
}
__device__ __forceinline__ void final_norm(Frame& F, float* out, const float* ssqp, const float* gain) {
    const int gw = F.vcu * NWAVES + F.wave, NGW = F.G * NWAVES, lane = fresh_lane();
    for (int m = gw; m < M; m += NGW) {
        float s = (lane < 16) ? ssqp[(size_t)m * 16 + lane] : 0.f; s = wave_sum(s);
        const float rs = 1.0f / sqrtf(s * (1.0f / 1024.0f) + EPS);
        GAS f32x4* xr = (GAS f32x4*)(out + (size_t)m * D) + lane;
#pragma unroll
        for (int j = 0; j < 4; ++j) { f32x4 v = xr[64 * j]; const f32x4 g = ((const GAS f32x4*)gain)[lane + 64 * j]; v = v * rs * g; xr[64 * j] = v; }
    }
}
__global__ void __launch_bounds__(NWAVES * 64, 2) mega_fwd(Args args) {
    extern __shared__ __attribute__((aligned(16))) unsigned char lds[];
    Frame F;
    F.lds = (LAS unsigned char*)lds;
    F.MISC = (volatile LAS unsigned*)(F.lds + MISC_OFF);
    F.tid = threadIdx.x; F.lane = F.tid & 63; F.wave = __builtin_amdgcn_readfirstlane(F.tid >> 6);
    F.G = gridDim.x; { const int bx = blockIdx.x; F.vcu = (F.G % 8 == 0) ? (bx % 8) * (F.G / 8) + bx / 8 : bx; }
    unsigned char* ws = args.ws;
    F.ctl = (gu32*)(ws + WS_CTL);
    for (int u = F.tid; u < (LDS_BYTES - LDSCTL_OFF) / 4; u += NWAVES * 64) ((LAS unsigned*)(F.lds + LDSCTL_OFF))[u] = 0u;
    __syncthreads();
    XcdBarrier bar; bar.bar = (unsigned*)(F.ctl + CW_BAR); bar.x = 0; bar.st = nullptr;
    if (N_LAUNCHES != N_PHASES) bar = xcd_barrier_post((unsigned*)(F.ctl + CW_BAR), F.MISC + 8);
#define GRID_BAR() do { if (N_LAUNCHES == N_PHASES) { if (F.tid == 0) __hip_atomic_store(F.ctl + CW_TMO, 0xBADBA0u, RLX_AGENT); } else { xcd_barrier(bar); } } while (0)
    const int lo = args.ph_lo, hi = args.ph_hi;
#define IN(k) (lo <= (k) && (k) < hi)
#define BOTH(k) (IN(k) && IN((k) + 1))
    float* out = args.out;
    bf16* Wgu1 = (bf16*)(ws + WS_WGU1); bf16* Wd1 = (bf16*)(ws + WS_WD1); bf16* Win = (bf16*)(ws + WS_WIN); bf16* Wout = (bf16*)(ws + WS_WOUT);
    bf16* Wgu2 = (bf16*)(ws + WS_WGU2); bf16* Wd2 = (bf16*)(ws + WS_WD2); bf16* Wpg = (bf16*)(ws + WS_WPG); bf16* Wpp = (bf16*)(ws + WS_WPP);
    float* ssq1 = (float*)(ws + WS_SSQ1); float* ssq2 = (float*)(ws + WS_SSQ2); float* ssq3 = (float*)(ws + WS_SSQ3); float* ssq4 = (float*)(ws + WS_SSQ4); float* ssq5 = (float*)(ws + WS_SSQ5);
    float* kmean = (float*)(ws + WS_KMEAN);
    bf16* hb = (bf16*)(ws + WS_HB); float* oraw = (float*)(ws + WS_HB); bf16* pb = (bf16*)(ws + WS_PB); bf16* mix = (bf16*)(ws + WS_MIX); bf16* xb = (bf16*)(ws + WS_MIX);
    bf16* U = (bf16*)(ws + WS_U); bf16* hmid = (bf16*)(ws + WS_U); float* loga = (float*)(ws + WS_LOGA); bf16* pp = (bf16*)(ws + WS_PP);
    using pg8::Gemm; using pg8::StaticOrder;
#define RUN_GEMM(EPI, A_, B_, N_, K_, ...) do { Gemm g{A_, B_, M, N_, K_}; StaticOrder S; S.init(M, N_, F.G, (int)blockIdx.x); pg8::EPI E{__VA_ARGS__}; \
        pg8::gemm_phase<pg8::EPI, StaticOrder, PG8_ALIGN, PG8_SP2>(F.lds + RING_OFF, g, S, E); } while (0)

    if (IN(0)) { p0_prologue(F, args); if (BOTH(0)) GRID_BAR(); }
    if (IN(1)) { RUN_GEMM(EpiSwiGLU, xb, Wgu1, NGU, D, hmid, FF, ssq1); if (BOTH(1)) GRID_BAR(); }
    if (IN(2)) { RUN_GEMM(EpiResid<1>, hmid, Wd1, D, FF, args.in[0], out, hb, ssq2); if (BOTH(2)) GRID_BAR(); }
    if (IN(3)) { RUN_GEMM(EpiWin, hb, Win, UWID, D, U, loga, ssq2, args.in[8]); if (BOTH(3)) GRID_BAR(); }
    if (IN(4)) { moba_kmean(F, U, kmean); gla_seq(F, U, loga, oraw); if (BOTH(4)) GRID_BAR(); }
    if (IN(5)) { gla_final(F, U, oraw, args.in[9], mix); moba_simple(F, U, kmean, args.in[17], mix); if (BOTH(5)) GRID_BAR(); }
    if (IN(6)) { RUN_GEMM(EpiResid<0>, mix, Wout, D, D, out, out, hb, ssq3); if (BOTH(6)) GRID_BAR(); }
    if (IN(7)) { RUN_GEMM(EpiPlain, pb, Wpp, D, DPLE, pp); if (BOTH(7)) GRID_BAR(); }
    if (IN(8)) { RUN_GEMM(EpiSwiGLU, hb, Wgu2, NGU, D, hmid, FF, ssq3); if (BOTH(8)) GRID_BAR(); }
    if (IN(9)) { RUN_GEMM(EpiResid<1>, hmid, Wd2, D, FF, out, out, hb, ssq4); if (BOTH(9)) GRID_BAR(); }
    if (IN(10)) { RUN_GEMM(EpiPle, hb, Wpg, D, D, out, out, pp, ssq4, ssq5); if (BOTH(10)) GRID_BAR(); }
    if (IN(11)) { final_norm(F, out, ssq5, args.in[18]); }
#undef IN
#undef BOTH
}

extern "C" void kernel_launch(void* const* d_in, const int* in_sizes, int n_in, void* d_out, int out_size, void* d_ws, size_t ws_size, hipStream_t stream) {
    static int grid = 0;
    if (grid == 0) {
        if (n_in != 19 || in_sizes[0] != M * D || out_size != M * D || ws_size < WS_END) { fprintf(stderr, "kernel_launch: unexpected shapes (n_in %d, in0 %d, out %d, ws %zu); nothing launched\n", n_in, n_in > 0 ? in_sizes[0] : -1, out_size, ws_size); grid = -1; return; }
        int dev = 0, cus = 0, per_cu = 0;
        if (hipGetDevice(&dev) != hipSuccess || hipDeviceGetAttribute(&cus, hipDeviceAttributeMultiprocessorCount, dev) != hipSuccess) { grid = -1; return; }
        if (hipFuncSetAttribute((const void*)mega_fwd, hipFuncAttributeMaxDynamicSharedMemorySize, LDS_BYTES) != hipSuccess) { fprintf(stderr, "kernel_launch: hipFuncSetAttribute failed\n"); grid = -1; return; }
        if (hipOccupancyMaxActiveBlocksPerMultiprocessor(&per_cu, (const void*)mega_fwd, NWAVES * 64, LDS_BYTES) != hipSuccess || per_cu < 1) { fprintf(stderr, "kernel_launch: occupancy query reports %d workgroups per CU\n", per_cu); }
        (void)hipGetLastError();
        grid = cus;
    }
    if (grid < 0) return;
    if (hipMemsetAsync((char*)d_ws + WS_CTL, 0, CTL_ZERO_BYTES, stream) != hipSuccess) { fprintf(stderr, "kernel_launch: hipMemsetAsync failed\n"); return; }
    Args a{};
    for (int i = 0; i < 19; ++i) a.in[i] = (const float*)d_in[i];
    a.out = (float*)d_out; a.ws = (unsigned char*)d_ws;
    for (int li = 0; li < N_LAUNCHES; ++li) {
        if (N_LAUNCHES == 1) { a.ph_lo = 0; a.ph_hi = N_PHASES; } else { a.ph_lo = li; a.ph_hi = li + 1; }
        a.li = li;
        hipLaunchKernelGGL(mega_fwd, dim3(grid), dim3(NWAVES * 64), LDS_BYTES, stream, a);
        const hipError_t le = hipPeekAtLastError();
        if (le != hipSuccess) { fprintf(stderr, "kernel_launch: launch %d failed: %s\n", li, hipGetErrorName(le)); break; }
    }
}
```

```cpp
#include <hip/hip_runtime.h>
#include <cstdio>
#include <cstdint>
namespace pg8 {
#define PG8_LAS __attribute__((address_space(3)))
typedef unsigned short bf16_t;
typedef short bf16x8 __attribute__((ext_vector_type(8)));
typedef float f32x4 __attribute__((ext_vector_type(4)));
typedef unsigned u32x4 __attribute__((ext_vector_type(4)));
constexpr int BM = 256, BK = 64, HALF = 128, HTB = HALF * BK * 2  , STAGE_BYTES = 8 * HTB, NXCD = 8, WGM = 8;

__host__ __device__ __forceinline__ int lds_byte(int r, int c) { const int st = (r >> 4) * 2 + (c >> 5), rr = r & 15, cc = c & 31, ob = rr * 64 + cc * 2; return st * 1024 + (ob ^ (((ob >> 9) & 1) << 5)); }
__host__ __device__ __forceinline__ void stage_rc(int b, int& R, int& C) { const int st = b / 1024, sb = b % 1024, swz = sb ^ (((sb >> 9) & 1) << 5); R = (st >> 1) * 16 + swz / 64; C = (st & 1) * 32 + (swz % 64) / 2; }
__host__ __device__ __forceinline__ int perm32(int rho) { const int n = rho >> 4, i = rho & 15; return 8 * (i >> 2) + 4 * n + (i & 3); }

struct Unit { int pm, pn; };
struct Gemm { const bf16_t* A; const bf16_t* Bt; int M, N, K; };

struct StaticOrder {
    int nM, nN, nwg, G, c;
    __host__ __device__ void init(int M, int N, int G_, int c_) { nM = M / BM; nN = N / BM; nwg = nM * nN; G = G_; c = c_; }
    __host__ __device__ bool next(int i, Unit& u) const {
        const long L = (long)i * G + c; if (L >= nwg) return false;
        int wgid = (int)L; { const int q = nwg / NXCD, r = nwg % NXCD, xcd = wgid % NXCD, off = wgid / NXCD; wgid = (xcd < r ? xcd * (q + 1) : r * (q + 1) + (xcd - r) * q) + off; }
        const int nig = WGM * nN, gid = wgid / nig, fm = gid * WGM, gsz = (nM - fm) < WGM ? (nM - fm) : WGM;
        u.pm = fm + ((wgid % nig) % gsz); u.pn = (wgid % nig) / gsz; return true;
    }
    __device__ __forceinline__ void a_ready(const Unit&) const {}
    __device__ __forceinline__ void done(const Unit&) const {}
};

__device__ __forceinline__ unsigned cvt_pk_bf16(float lo, float hi) { unsigned r; asm volatile("v_cvt_pk_bf16_f32 %0, %1, %2" : "=v"(r) : "v"(lo), "v"(hi)); return r; }
__device__ __forceinline__ float bf_lo(unsigned w) { return __uint_as_float(w << 16); }
__device__ __forceinline__ float bf_hi(unsigned w) { return __uint_as_float(w & 0xffff0000u); }
constexpr float RMS_EPS = 1e-6f;
__device__ __forceinline__ float row_rstd(const float* ssqp, int r, int fq) {
    const f32x4 p = *(const f32x4*)(ssqp + (size_t)r * 16 + 4 * fq);
    float s = (p[0] + p[1]) + (p[2] + p[3]);
    s += __shfl_xor(s, 16); s += __shfl_xor(s, 32);
    return __builtin_amdgcn_rsqf(s * (1.0f / 1024.0f) + RMS_EPS);
}
__device__ __forceinline__ float fast_sigmoid(float x) { return __builtin_amdgcn_rcpf(1.0f + __builtin_amdgcn_exp2f(-1.4426950408889634f * x)); }
struct EpiSwiGLU {
    static constexpr bool PERM = true, AFTER_DRAIN = false;
    bf16_t* O; int ldc; const float* ssqp;
    __device__ __forceinline__ void operator()(const f32x4 (&acc)[2][2][4][2], const Unit& u, int wr, int wc, int fr, int fq) const {
        const int row0 = u.pm * BM + wr * 64 + fr, col0 = u.pn * HALF + wc * 32 + 8 * fq;
#pragma unroll
        for (int ai = 0; ai < 2; ++ai)
#pragma unroll
            for (int m = 0; m < 4; ++m) { const int r = row0 + ai * HALF + m * 16; const float rs = row_rstd(ssqp, r, fq);
                float h[8];
#pragma unroll
                for (int n = 0; n < 2; ++n)
#pragma unroll
                    for (int j = 0; j < 4; ++j) { const float g = acc[ai][0][m][n][j] * rs, up = acc[ai][1][m][n][j] * rs; h[n * 4 + j] = g * fast_sigmoid(g) * up; }
                u32x4 w; w.x = cvt_pk_bf16(h[0], h[1]); w.y = cvt_pk_bf16(h[2], h[3]); w.z = cvt_pk_bf16(h[4], h[5]); w.w = cvt_pk_bf16(h[6], h[7]);
                *(u32x4*)(O + (size_t)r * ldc + col0) = w; }
    }
};
template <int HALF_ALPHA> struct EpiResid {
    static constexpr bool PERM = true, AFTER_DRAIN = false; static constexpr float alpha = HALF_ALPHA ? 0.5f : 1.0f;
    const float* base; float* out; bf16_t* ob; float* ssq_out;
    __device__ __forceinline__ void operator()(const f32x4 (&acc)[2][2][4][2], const Unit& u, int wr, int wc, int fr, int fq) const {
        const int row0 = u.pm * BM + wr * 64 + fr, col0 = u.pn * BM + wc * 32 + 8 * fq;
#pragma unroll
        for (int ai = 0; ai < 2; ++ai)
#pragma unroll
            for (int m = 0; m < 4; ++m) { const int r = row0 + ai * HALF + m * 16; float ss = 0.f;
#pragma unroll
                for (int bj = 0; bj < 2; ++bj) { const size_t off = (size_t)r * 1024 + col0 + bj * HALF;
                    const f32x4 b0 = *(const f32x4*)(base + off), b1 = *(const f32x4*)(base + off + 4);
                    const f32x4 v0 = b0 + acc[ai][bj][m][0] * alpha, v1 = b1 + acc[ai][bj][m][1] * alpha;
                    *(f32x4*)(out + off) = v0; *(f32x4*)(out + off + 4) = v1;
                    u32x4 w; w.x = cvt_pk_bf16(v0[0], v0[1]); w.y = cvt_pk_bf16(v0[2], v0[3]); w.z = cvt_pk_bf16(v1[0], v1[1]); w.w = cvt_pk_bf16(v1[2], v1[3]);
                    *(u32x4*)(ob + off) = w;
                    ss += (v0[0] * v0[0] + v0[1] * v0[1]) + (v0[2] * v0[2] + v0[3] * v0[3]) + (v1[0] * v1[0] + v1[1] * v1[1]) + (v1[2] * v1[2] + v1[3] * v1[3]); }
                ss += __shfl_xor(ss, 16); ss += __shfl_xor(ss, 32);
                if (fq == 0) ssq_out[(size_t)r * 16 + 4 * u.pn + wc] = ss; }
    }
};
constexpr int UW = 3328;
struct EpiWin {
    static constexpr bool PERM = true, AFTER_DRAIN = false;
    bf16_t* U; float* loga; const float* ssqp; const float* bgk;
    __device__ __forceinline__ void operator()(const f32x4 (&acc)[2][2][4][2], const Unit& u, int wr, int wc, int fr, int fq) const {
        const int row0 = u.pm * BM + wr * 64 + fr, cl0 = wc * 32 + 8 * fq;
        const float sc = (u.pn == 0) ? 0.125f : 1.0f;
#pragma unroll
        for (int ai = 0; ai < 2; ++ai)
#pragma unroll
            for (int m = 0; m < 4; ++m) { const int r = row0 + ai * HALF + m * 16; const float rs = row_rstd(ssqp, r, fq);
#pragma unroll
                for (int bj = 0; bj < 2; ++bj) { const int cl = cl0 + bj * HALF;
                    const f32x4 v0 = acc[ai][bj][m][0] * rs, v1 = acc[ai][bj][m][1] * rs;
                    if (u.pn == 6) {
                        const f32x4 c0 = *(const f32x4*)(bgk + cl), c1 = *(const f32x4*)(bgk + cl + 4); f32x4 o0, o1;
#pragma unroll
                        for (int j = 0; j < 4; ++j) { const float x0 = v0[j] + c0[j], x1 = v1[j] + c1[j];
                            o0[j] = (fminf(x0, 0.f) - log1pf(__expf(-fabsf(x0)))) * (1.0f / 16.0f); o1[j] = (fminf(x1, 0.f) - log1pf(__expf(-fabsf(x1)))) * (1.0f / 16.0f); }
                        *(f32x4*)(loga + (size_t)r * 256 + cl) = o0; *(f32x4*)(loga + (size_t)r * 256 + cl + 4) = o1;
                    } else {
                        u32x4 w; w.x = cvt_pk_bf16(v0[0] * sc, v0[1] * sc); w.y = cvt_pk_bf16(v0[2] * sc, v0[3] * sc); w.z = cvt_pk_bf16(v1[0] * sc, v1[1] * sc); w.w = cvt_pk_bf16(v1[2] * sc, v1[3] * sc);
                        *(u32x4*)(U + (size_t)r * UW + u.pn * BM + cl) = w; } } }
    }
};
struct EpiPlain {
    static constexpr bool PERM = true, AFTER_DRAIN = false;
    bf16_t* O;
    __device__ __forceinline__ void operator()(const f32x4 (&acc)[2][2][4][2], const Unit& u, int wr, int wc, int fr, int fq) const {
        const int row0 = u.pm * BM + wr * 64 + fr, col0 = u.pn * BM + wc * 32 + 8 * fq;
#pragma unroll
        for (int ai = 0; ai < 2; ++ai)
#pragma unroll
            for (int m = 0; m < 4; ++m) { const int r = row0 + ai * HALF + m * 16;
#pragma unroll
                for (int bj = 0; bj < 2; ++bj) { const f32x4 v0 = acc[ai][bj][m][0], v1 = acc[ai][bj][m][1];
                    u32x4 w; w.x = cvt_pk_bf16(v0[0], v0[1]); w.y = cvt_pk_bf16(v0[2], v0[3]); w.z = cvt_pk_bf16(v1[0], v1[1]); w.w = cvt_pk_bf16(v1[2], v1[3]);
                    *(u32x4*)(O + (size_t)r * 1024 + col0 + bj * HALF) = w; } }
    }
};
struct EpiPle {
    static constexpr bool PERM = true, AFTER_DRAIN = false;
    const float* base; float* out; const bf16_t* pp; const float* ssqp; float* ssq_out;
    __device__ __forceinline__ void operator()(const f32x4 (&acc)[2][2][4][2], const Unit& u, int wr, int wc, int fr, int fq) const {
        const int row0 = u.pm * BM + wr * 64 + fr, col0 = u.pn * BM + wc * 32 + 8 * fq;
#pragma unroll
        for (int ai = 0; ai < 2; ++ai)
#pragma unroll
            for (int m = 0; m < 4; ++m) { const int r = row0 + ai * HALF + m * 16; const float rs = row_rstd(ssqp, r, fq); float ss = 0.f;
#pragma unroll
                for (int bj = 0; bj < 2; ++bj) { const size_t off = (size_t)r * 1024 + col0 + bj * HALF;
                    const f32x4 b0 = *(const f32x4*)(base + off), b1 = *(const f32x4*)(base + off + 4);
                    const u32x4 pw = *(const u32x4*)(pp + off);
                    f32x4 v0, v1;
                    v0[0] = b0[0] + fast_sigmoid(acc[ai][bj][m][0][0] * rs) * bf_lo(pw.x); v0[1] = b0[1] + fast_sigmoid(acc[ai][bj][m][0][1] * rs) * bf_hi(pw.x);
                    v0[2] = b0[2] + fast_sigmoid(acc[ai][bj][m][0][2] * rs) * bf_lo(pw.y); v0[3] = b0[3] + fast_sigmoid(acc[ai][bj][m][0][3] * rs) * bf_hi(pw.y);
                    v1[0] = b1[0] + fast_sigmoid(acc[ai][bj][m][1][0] * rs) * bf_lo(pw.z); v1[1] = b1[1] + fast_sigmoid(acc[ai][bj][m][1][1] * rs) * bf_hi(pw.z);
                    v1[2] = b1[2] + fast_sigmoid(acc[ai][bj][m][1][2] * rs) * bf_lo(pw.w); v1[3] = b1[3] + fast_sigmoid(acc[ai][bj][m][1][3] * rs) * bf_hi(pw.w);
                    *(f32x4*)(out + off) = v0; *(f32x4*)(out + off + 4) = v1;
                    ss += (v0[0] * v0[0] + v0[1] * v0[1]) + (v0[2] * v0[2] + v0[3] * v0[3]) + (v1[0] * v1[0] + v1[1] * v1[1]) + (v1[2] * v1[2] + v1[3] * v1[3]); }
                ss += __shfl_xor(ss, 16); ss += __shfl_xor(ss, 32);
                if (fq == 0) ssq_out[(size_t)r * 16 + 4 * u.pn + wc] = ss; }
    }
};
template <class Epi, class Sched, bool ALIGN_EPI = false, bool SP2 = false>
__device__ __forceinline__ void gemm_phase(PG8_LAS unsigned char* lds, const Gemm g, const Sched& S, const Epi& E) {
    const int tid = threadIdx.x, wid = __builtin_amdgcn_readfirstlane(tid >> 6), lane = tid & 63, wr = wid >> 2, wc = wid & 3, fr = lane & 15, fq = lane >> 4;
    const int K = g.K, nt = K / BK;
    unsigned voffA[2], voffB[2];
#pragma unroll
    for (int i = 0; i < 2; ++i) { int R, C; stage_rc(tid * 16 + i * 8192, R, C); const int Rb = Epi::PERM ? ((R & ~31) + perm32(R & 31)) : R;
        voffA[i] = (unsigned)(R * K + C) * 2u; voffB[i] = (unsigned)(Rb * K + C) * 2u; }
    const size_t kstep = (size_t)(BK * 2);
    const size_t hstep = (size_t)HALF * K * 2;
    const size_t tstep = 2 * hstep;
    const unsigned ldsw = (unsigned)wid * 1024u;
    const int aoff = lds_byte(wr * 64 + fr, fq * 8), boff = lds_byte(wc * 32 + fr, fq * 8);
#define PG8_SA(b, h) (((b) * 2 + (h)) * HTB)
#define PG8_SB(b, h) ((4 + (b) * 2 + (h)) * HTB)
#define PG8_STAGE(bufoff, gbase, voff) do { _Pragma("unroll") for (int _i = 0; _i < 2; ++_i) \
        __builtin_amdgcn_global_load_lds((const unsigned*)((const char*)(gbase) + (voff)[_i]), (PG8_LAS unsigned*)(lds + (bufoff) + ldsw + _i * 8192), 16, 0, 0); } while (0)
#define PG8_LDA(dst, b, h) do { _Pragma("unroll") for (int m = 0; m < 4; ++m) _Pragma("unroll") for (int k = 0; k < 2; ++k) dst[m][k] = *(const PG8_LAS bf16x8*)(lds + PG8_SA(b, h) + aoff + m * 2048 + k * 1024); } while (0)
#define PG8_LDB(dst, b, h) do { _Pragma("unroll") for (int n = 0; n < 2; ++n) _Pragma("unroll") for (int k = 0; k < 2; ++k) dst[n][k] = *(const PG8_LAS bf16x8*)(lds + PG8_SB(b, h) + boff + n * 2048 + k * 1024); } while (0)
#define PG8_MMA(ai, bj, At, Bt) do { __builtin_amdgcn_s_setprio(1); _Pragma("unroll") for (int m = 0; m < 4; ++m) _Pragma("unroll") for (int n = 0; n < 2; ++n) _Pragma("unroll") for (int k = 0; k < 2; ++k) \
        acc[ai][bj][m][n] = __builtin_amdgcn_mfma_f32_16x16x32_bf16(Bt[n][k], At[m][k], acc[ai][bj][m][n], 0, 0, 0); __builtin_amdgcn_s_setprio(0); } while (0)
#define PG8_WAIT_V(n) asm volatile("s_waitcnt vmcnt(" #n ")" ::: "memory")
#define PG8_WAIT_L(n) asm volatile("s_waitcnt lgkmcnt(" #n ")" ::: "memory")
#define PG8_BAR __builtin_amdgcn_s_barrier()
#define PG8_SCHED __builtin_amdgcn_sched_barrier(0)
    Unit cur, nxt; int ui = 0;
    if (!S.next(0, cur)) return;
    f32x4 acc[2][2][4][2];
#pragma unroll
    for (int a = 0; a < 2; ++a)
#pragma unroll
        for (int b = 0; b < 2; ++b)
#pragma unroll
            for (int m = 0; m < 4; ++m)
#pragma unroll
                for (int n = 0; n < 2; ++n) acc[a][b][m][n] = (f32x4){0.f, 0.f, 0.f, 0.f};
    bf16x8 At[4][2], B0[2][2], B1[2][2];
    const char* cA = (const char*)g.A + (size_t)cur.pm * tstep; const char* cB = (const char*)g.Bt + (size_t)cur.pn * tstep;
    S.a_ready(cur);
    if constexpr (SP2) {
        PG8_STAGE(PG8_SB(0, 0), cB, voffB); PG8_STAGE(PG8_SB(0, 1), cB + hstep, voffB); PG8_STAGE(PG8_SA(0, 0), cA, voffA); PG8_STAGE(PG8_SA(0, 1), cA + hstep, voffA);
        if (wr == 1) PG8_BAR;
        PG8_WAIT_V(2); PG8_BAR;
        PG8_STAGE(PG8_SB(1, 0), cB + kstep, voffB); PG8_STAGE(PG8_SA(1, 0), cA + kstep, voffA); PG8_STAGE(PG8_SB(1, 1), cB + hstep + kstep, voffB);
        PG8_WAIT_V(6); PG8_BAR;
    } else {
        PG8_STAGE(PG8_SB(0, 0), cB, voffB); PG8_STAGE(PG8_SA(0, 0), cA, voffA); PG8_STAGE(PG8_SB(0, 1), cB + hstep, voffB); PG8_STAGE(PG8_SA(0, 1), cA + hstep, voffA);
        if (wr == 1) PG8_BAR;
        PG8_WAIT_V(4); PG8_BAR;
        PG8_STAGE(PG8_SB(1, 0), cB + kstep, voffB); PG8_STAGE(PG8_SA(1, 0), cA + kstep, voffA); PG8_STAGE(PG8_SB(1, 1), cB + hstep + kstep, voffB);
        PG8_WAIT_V(6); PG8_BAR;
    }
    for (;;) {
        const bool has_next = S.next(ui + 1, nxt);
        const char* nA = has_next ? (const char*)g.A + (size_t)nxt.pm * tstep : cA; const char* nB = has_next ? (const char*)g.Bt + (size_t)nxt.pn * tstep : cB;
        for (int t = 0; t < nt; t += 2) {
            const bool last = (t == nt - 2);
            const char* a1 = cA + (size_t)(t + 1) * kstep;
            const char* a2 = last ? nA : cA + (size_t)(t + 2) * kstep; const char* b2 = last ? nB : cB + (size_t)(t + 2) * kstep;
            const char* a3 = a2 + kstep; const char* b3 = b2 + kstep;
            if (last && has_next) S.a_ready(nxt);
            if constexpr (SP2) {
            PG8_LDB(B0, 0, 0); PG8_LDB(B1, 0, 1); PG8_SCHED; PG8_LDA(At, 0, 0); PG8_STAGE(PG8_SA(1, 1), a1 + hstep, voffA);
            PG8_WAIT_V(8); PG8_WAIT_L(0); PG8_BAR; PG8_MMA(0, 0, At, B0); PG8_MMA(0, 1, At, B1); PG8_BAR; PG8_SCHED;
            PG8_LDA(At, 0, 1); PG8_STAGE(PG8_SB(0, 0), b2, voffB); PG8_STAGE(PG8_SB(0, 1), b2 + hstep, voffB); PG8_STAGE(PG8_SA(0, 0), a2, voffA);
            PG8_WAIT_V(8); PG8_WAIT_L(0); PG8_BAR; PG8_MMA(1, 0, At, B0); PG8_MMA(1, 1, At, B1); PG8_BAR; PG8_SCHED;
            PG8_LDB(B0, 1, 0); PG8_LDB(B1, 1, 1); PG8_SCHED; PG8_LDA(At, 1, 0); PG8_STAGE(PG8_SA(0, 1), a2 + hstep, voffA);
            PG8_WAIT_V(8); PG8_WAIT_L(0); PG8_BAR; PG8_MMA(0, 0, At, B0); PG8_MMA(0, 1, At, B1); PG8_BAR; PG8_SCHED;
            PG8_LDA(At, 1, 1); PG8_STAGE(PG8_SB(1, 0), b3, voffB); PG8_STAGE(PG8_SB(1, 1), b3 + hstep, voffB); PG8_STAGE(PG8_SA(1, 0), a3, voffA);
            PG8_WAIT_V(8); PG8_WAIT_L(0); PG8_BAR; PG8_MMA(1, 0, At, B0); PG8_MMA(1, 1, At, B1); PG8_BAR; PG8_SCHED;
            } else {
            PG8_LDB(B0, 0, 0); PG8_SCHED; PG8_LDA(At, 0, 0); PG8_STAGE(PG8_SA(1, 1), a1 + hstep, voffA);
            PG8_WAIT_L(8); PG8_BAR; PG8_WAIT_L(0); PG8_MMA(0, 0, At, B0); PG8_BAR; PG8_SCHED;
            PG8_LDB(B1, 0, 1); PG8_STAGE(PG8_SB(0, 0), b2, voffB);
            PG8_BAR; PG8_WAIT_L(0); PG8_MMA(0, 1, At, B1); PG8_BAR;
            PG8_LDA(At, 0, 1); PG8_STAGE(PG8_SA(0, 0), a2, voffA);
            PG8_BAR; PG8_WAIT_L(0); PG8_MMA(1, 0, At, B0); PG8_BAR; PG8_SCHED;
            PG8_STAGE(PG8_SB(0, 1), b2 + hstep, voffB);
            PG8_WAIT_V(6); PG8_BAR; PG8_MMA(1, 1, At, B1); PG8_BAR;
            PG8_LDB(B0, 1, 0); PG8_SCHED; PG8_LDA(At, 1, 0); PG8_STAGE(PG8_SA(0, 1), a2 + hstep, voffA);
            PG8_WAIT_L(8); PG8_BAR; PG8_WAIT_L(0); PG8_MMA(0, 0, At, B0); PG8_BAR; PG8_SCHED;
            PG8_LDB(B1, 1, 1); PG8_STAGE(PG8_SB(1, 0), b3, voffB);
            PG8_BAR; PG8_WAIT_L(0); PG8_MMA(0, 1, At, B1); PG8_BAR;
            PG8_LDA(At, 1, 1); PG8_STAGE(PG8_SA(1, 0), a3, voffA);
            PG8_BAR; PG8_WAIT_L(0); PG8_MMA(1, 0, At, B0); PG8_BAR; PG8_SCHED;
            PG8_STAGE(PG8_SB(1, 1), b3 + hstep, voffB);
            PG8_WAIT_V(6); PG8_BAR; PG8_MMA(1, 1, At, B1); PG8_BAR;
            }
        }
        if constexpr (ALIGN_EPI) { if (wr == 0) PG8_BAR; }
        if constexpr (!Epi::AFTER_DRAIN) { E(acc, cur, wr, wc, fr, fq); S.done(cur); }
        if (!has_next) break;
#pragma unroll
        for (int a = 0; a < 2; ++a)
#pragma unroll
            for (int b = 0; b < 2; ++b)
#pragma unroll
                for (int m = 0; m < 4; ++m)
#pragma unroll
                    for (int n = 0; n < 2; ++n) acc[a][b][m][n] = (f32x4){0.f, 0.f, 0.f, 0.f};
        cur = nxt; cA = nA; cB = nB; ++ui;
        if constexpr (ALIGN_EPI) { if (wr == 1) PG8_BAR; }
    }
    PG8_WAIT_V(0);
    if constexpr (!ALIGN_EPI) { if (wr == 0) PG8_BAR; }
    PG8_BAR;
    if constexpr (Epi::AFTER_DRAIN) { E.fused(acc, cur, wr, wc, fr, fq, lds, wid, lane); S.done(cur); }
#undef PG8_SA
#undef PG8_SB
#undef PG8_STAGE
#undef PG8_LDA
#undef PG8_LDB
#undef PG8_MMA
#undef PG8_WAIT_V
#undef PG8_WAIT_L
#undef PG8_BAR
#undef PG8_SCHED
}
}
#ifndef PG8_SP2
#define PG8_SP2 true
#endif
#ifndef PG8_ALIGN
#define PG8_ALIGN true
#endif
constexpr int NWAVES = 8;
constexpr int N_PHASES = 12;
#ifndef MK_N_LAUNCHES
#define MK_N_LAUNCHES 1
#endif
constexpr int N_LAUNCHES = MK_N_LAUNCHES;

constexpr int M = 16384, D = 1024, FF = 2816, NGU = 2 * FF, DPLE = 256;
constexpr int GH = 4, GDK = 64, GDV = 128, MH = 8, MHD = 64, MBLK = 256, NBLK = M / MBLK;
constexpr int UWID = 3328;
constexpr int U_QG = 0, U_KG = 256, U_VG = 512, U_GG = 1024, U_QM = 1792, U_KM = 2304, U_VM = 2816;
constexpr float EPS = 1e-6f;

constexpr size_t MiB = 1u << 20;
constexpr size_t WS_CTL = 0, CTL_ZERO_BYTES = 1 * MiB;
constexpr size_t WS_WGU1 = 1 * MiB, WS_WD1 = 12 * MiB, WS_WIN = 18 * MiB, WS_WOUT = 25 * MiB, WS_WGU2 = 27 * MiB, WS_WD2 = 38 * MiB, WS_WPG = 44 * MiB, WS_WPP = 46 * MiB;
constexpr size_t WS_SSQ1 = 47 * MiB, WS_SSQ2 = 48 * MiB, WS_SSQ3 = 49 * MiB, WS_SSQ4 = 50 * MiB, WS_SSQ5 = 51 * MiB, WS_KMEAN = 52 * MiB;
constexpr size_t WS_HB = 54 * MiB;
constexpr size_t WS_PB = 86 * MiB;
constexpr size_t WS_MIX = 94 * MiB;
constexpr size_t WS_U = 126 * MiB;
constexpr size_t WS_LOGA = 230 * MiB;
constexpr size_t WS_PP = 214 * MiB;
constexpr size_t WS_END = 256 * MiB;
static_assert(WS_U + (size_t)M * UWID * 2 <= WS_LOGA && WS_LOGA + (size_t)M * 256 * 4 <= WS_END && WS_U + (size_t)M * FF * 2 <= WS_PP && WS_PP + (size_t)M * D * 2 <= WS_END, "d_ws map");
constexpr int CW_TMO = 0, CW_CODE = 1;
constexpr int CW_BAR = 4096;

constexpr int RING_OFF = 0, RING_BYTES = 131072;
constexpr int LDSCTL_OFF = RING_BYTES, MISC_OFF = LDSCTL_OFF + 320;
constexpr int LDS_BYTES = 147456;
#define GAS __attribute__((address_space(1)))
#define LAS __attribute__((address_space(3)))
typedef unsigned short bf16;
typedef unsigned v4u __attribute__((ext_vector_type(4)));
typedef float f32x4 __attribute__((ext_vector_type(4)));
typedef short bf16x8 __attribute__((ext_vector_type(8)));
typedef GAS unsigned gu32;
typedef GAS unsigned long long gu64;
#define RLX_AGENT __ATOMIC_RELAXED, __HIP_MEMORY_SCOPE_AGENT
#define LDS_WAIT() asm volatile("s_waitcnt lgkmcnt(0)" ::: "memory")
#define VM_WAIT() asm volatile("s_waitcnt vmcnt(0)" ::: "memory")
__device__ __forceinline__ unsigned long long rt() { return __builtin_amdgcn_s_memrealtime(); }
__device__ __forceinline__ unsigned f2bf(float f) { unsigned u = __builtin_bit_cast(unsigned, f); return (u + 0x7fffu + ((u >> 16) & 1u)) >> 16; }
__device__ __forceinline__ unsigned pk2(float lo, float hi) { return f2bf(lo) | (f2bf(hi) << 16); }

#define XB_TMO      128
#define XB_XCNT(j)  (256  + 64 * (j))
#define XB_XSUB(j)  (1280 + 64 * (j))
#define XB_XGEN(j)  (2304 + 64 * (j))
#define XB_TOP      3328
#define XB_TOPGEN   3392
#define XCD_BAR_WORDS 3456
#define XB_SPIN_CAP (1u << 18)

__device__ __forceinline__ unsigned xb_ld(unsigned* p)              { return __hip_atomic_load(p, __ATOMIC_RELAXED, __HIP_MEMORY_SCOPE_AGENT); }
__device__ __forceinline__ unsigned xb_add(unsigned* p, unsigned v) { return __hip_atomic_fetch_add(p, v, __ATOMIC_RELAXED, __HIP_MEMORY_SCOPE_AGENT); }
__device__ __forceinline__ unsigned xb_xcc_id() { return (unsigned)__builtin_amdgcn_s_getreg((3 << 11) | 20) & 0xFu; }
#define XB_SPIN(cond, bar) do { unsigned _sp = 0; while (cond) { __builtin_amdgcn_s_sleep(1); \
    if ((++_sp & 255u) == 0u) { if (xb_ld(&(bar)[XB_TMO])) break; if (_sp > XB_SPIN_CAP) { atomicAdd(&(bar)[XB_TMO], 1u); break; } } } } while (0)

struct XcdBarrier {
    unsigned* bar; unsigned x;
    volatile LAS unsigned* st;
};

__device__ __forceinline__ XcdBarrier xcd_barrier_post(unsigned* bar, volatile LAS unsigned* st) {
    XcdBarrier b; b.bar = bar; b.x = xb_xcc_id(); b.st = st;
    if (threadIdx.x == 0) (void)xb_add(&bar[XB_XCNT(b.x)], 1u);
    return b;
}
__device__ __forceinline__ void xcd_barrier_complete(unsigned* bar, unsigned x, unsigned& nloc, unsigned& nx) {
    const unsigned G = gridDim.x * gridDim.y * gridDim.z;
    unsigned sum, cnt, mine, sp = 0u;
    for (;;) {
        sum = 0u; cnt = 0u; mine = 0u;
#pragma unroll
        for (unsigned j = 0; j < 16; ++j) { const unsigned c = xb_ld(&bar[XB_XCNT(j)]); sum += c; cnt += (c > 0u) ? 1u : 0u; mine = (j == x) ? c : mine; }
        if (sum == G) break;
        __builtin_amdgcn_s_sleep(1);
        if ((++sp & 255u) == 0u) { if (xb_ld(&bar[XB_TMO])) break; if (sp > XB_SPIN_CAP) { atomicAdd(&bar[XB_TMO], 1u); break; } }
    }
    nloc = mine > 0u ? mine : 1u; nx = cnt > 0u ? cnt : 1u;
}

__device__ __forceinline__ void xcd_barrier(const XcdBarrier& b) {
    asm volatile("s_waitcnt vmcnt(0)" ::: "memory");
    __syncthreads();
    if (threadIdx.x == 0) {
        unsigned* bar = b.bar;
        __builtin_amdgcn_s_waitcnt(0);
        unsigned nloc = b.st[0], nx = b.st[1];
        if (nloc == 0u) { xcd_barrier_complete(bar, b.x, nloc, nx); b.st[0] = nloc; b.st[1] = nx; }
        const unsigned old = xb_add(&bar[XB_XSUB(b.x)], 1u);
        const unsigned gen = old / nloc;
        if (old + 1u == (gen + 1u) * nloc) {
            __builtin_amdgcn_fence(__ATOMIC_RELEASE, "agent");
            asm volatile("s_waitcnt vmcnt(0)" ::: "memory");
            const unsigned og = xb_add(&bar[XB_TOP], 1u);
            const unsigned tg = og / nx;
            if (og + 1u == (tg + 1u) * nx) xb_add(&bar[XB_TOPGEN], 1u);
            else XB_SPIN(xb_ld(&bar[XB_TOPGEN]) == tg, bar);
            __builtin_amdgcn_fence(__ATOMIC_ACQUIRE, "agent");
            xb_add(&bar[XB_XGEN(b.x)], 1u);
            asm volatile("s_waitcnt vmcnt(0)" ::: "memory");
        } else {
            XB_SPIN(xb_ld(&bar[XB_XGEN(b.x)]) == gen, bar);
            __builtin_amdgcn_fence(__ATOMIC_ACQUIRE, "agent");
            asm volatile("s_waitcnt vmcnt(0)" ::: "memory");
        }
    }
    __syncthreads();
}
struct Frame {
    LAS unsigned char* lds;
    volatile LAS unsigned* MISC;
    gu32* ctl;
    int tid, lane, wave;
    int vcu, G;
};
__device__ __forceinline__ int fresh_lane() { int l; asm volatile("v_mbcnt_lo_u32_b32 %0, -1, 0\n\tv_mbcnt_hi_u32_b32 %0, -1, %0" : "=v"(l)); return l; }
__device__ __forceinline__ float wave_sum(float v) {
#pragma unroll
    for (int o = 1; o < 64; o <<= 1) v += __shfl_xor(v, o);
    return v;
}
__device__ __forceinline__ float wave_max(float v) {
#pragma unroll
    for (int o = 1; o < 64; o <<= 1) v = fmaxf(v, __shfl_xor(v, o));
    return v;
}
__device__ __forceinline__ float bf2f(bf16 h) { return __uint_as_float((unsigned)h << 16); }
__device__ __forceinline__ float bf_lo2(unsigned w) { return __uint_as_float(w << 16); }
__device__ __forceinline__ float bf_hi2(unsigned w) { return __uint_as_float(w & 0xffff0000u); }

__device__ __forceinline__ void tr_store(bf16* WT, int K, int k0, int n0dst, LAS float* scr, int lane) {
    LDS_WAIT(); asm volatile("" ::: "memory");
    const int c = lane & 7;
#pragma unroll
    for (int j = 0; j < 4; ++j) { const int n = (lane >> 3) + 8 * j; const LAS float* s = scr + (8 * c) * 33 + n;
        v4u o; o.x = pk2(s[0 * 33], s[1 * 33]); o.y = pk2(s[2 * 33], s[3 * 33]); o.z = pk2(s[4 * 33], s[5 * 33]); o.w = pk2(s[6 * 33], s[7 * 33]);
        *(GAS v4u*)(WT + (size_t)(n0dst + n) * K + k0 + 8 * c) = o; }
    LDS_WAIT(); asm volatile("" ::: "memory");
}
__device__ __forceinline__ void tr_item(const float* W, int K, int N, const float* gain, bf16* WT, int k0, int n0dst, int c0src, LAS float* scr, int lane) {
#pragma unroll 8
    for (int i = 0; i < 32; ++i) { const int kk = 2 * i + (lane >> 5); const float g = gain ? gain[k0 + kk] : 1.0f;
        scr[kk * 33 + (lane & 31)] = W[(size_t)(k0 + kk) * N + c0src + (lane & 31)] * g; }
    tr_store(WT, K, k0, n0dst, scr, lane);
}
__device__ __forceinline__ void tr_item_gk(const float* Win, const float* Wup, const float* gain, bf16* WT, int k0, int j0, LAS float* scr, int lane) {
    for (int i = 0; i < 32; ++i) { const int kk = 2 * i + (lane >> 5), k = k0 + kk, j = j0 + (lane & 31); float a = 0.f;
#pragma unroll
        for (int r = 0; r < 16; ++r) a += Win[(size_t)k * 3088 + 1536 + r] * Wup[r * 256 + j];
        scr[kk * 33 + (lane & 31)] = a * gain[k]; }
    tr_store(WT, 1024, k0, 1536 + j0, scr, lane);
}
struct Args { const float* in[19]; float* out; unsigned char* ws; int ph_lo, ph_hi, li, pad; };

__device__ __forceinline__ void p0_prologue(Frame& F, const Args& A) {
    LAS float* scr = (LAS float*)(F.lds + RING_OFF + F.wave * 16384);
    unsigned char* ws = A.ws;
    const int gw = F.vcu * NWAVES + F.wave, NGW = F.G * NWAVES, lane = fresh_lane();
    constexpr int I_GU = 16 * 176, I_D = 44 * 32, I_IN = 16 * 104, I_O = 16 * 32, I_PP = 4 * 32;
    constexpr int NITEMS = 2 * I_GU + 2 * I_D + I_IN + 2 * I_O + I_PP;
    for (int it = gw; it < NITEMS; it += NGW) {
        int r = it;
        if (r < 2 * I_GU) { const int which = r / I_GU; r -= which * I_GU; const int kb = r / 176, nb = r % 176, t = nb >> 3, g = nb & 7;
            const int src = (g < 4) ? (128 * t + 32 * g) : (FF + 128 * t + 32 * (g - 4));
            tr_item(A.in[which ? 12 : 3], D, NGU, A.in[which ? 11 : 2], (bf16*)(ws + (which ? WS_WGU2 : WS_WGU1)), 64 * kb, 32 * nb, src, scr, lane); continue; } r -= 2 * I_GU;
        if (r < 2 * I_D) { const int which = r / I_D; r -= which * I_D; const int kb = r / 32, nb = r % 32;
            tr_item(A.in[which ? 13 : 4], FF, D, nullptr, (bf16*)(ws + (which ? WS_WD2 : WS_WD1)), 64 * kb, 32 * nb, 32 * nb, scr, lane); continue; } r -= 2 * I_D;
        if (r < I_IN) { const int kb = r / 104, nb = r % 104;
            if (nb >= 48 && nb < 56) tr_item_gk(A.in[6], A.in[7], A.in[5], (bf16*)(ws + WS_WIN), 64 * kb, 32 * (nb - 48), scr, lane);
            else tr_item(A.in[6], D, 3088, A.in[5], (bf16*)(ws + WS_WIN), 64 * kb, 32 * nb, nb < 48 ? 32 * nb : 32 * nb - 240, scr, lane);
            continue; } r -= I_IN;
        if (r < 2 * I_O) { const int which = r / I_O; r -= which * I_O; const int kb = r / 32, nb = r % 32;
            tr_item(A.in[which ? 15 : 10], D, D, which ? A.in[14] : nullptr, (bf16*)(ws + (which ? WS_WPG : WS_WOUT)), 64 * kb, 32 * nb, 32 * nb, scr, lane); continue; } r -= 2 * I_O;
        { const int kb = r / 32, nb = r % 32; tr_item(A.in[16], DPLE, D, nullptr, (bf16*)(ws + WS_WPP), 64 * kb, 32 * nb, 32 * nb, scr, lane); }
    }
    const float* x = A.in[0]; const float* p = A.in[1];
    bf16* xb = (bf16*)(ws + WS_MIX); bf16* pb = (bf16*)(ws + WS_PB); float* ssq1 = (float*)(ws + WS_SSQ1);
    for (int m = gw; m < M; m += NGW) {
        const GAS f32x4* xr = (const GAS f32x4*)(x + (size_t)m * D) + lane; f32x4 v[4]; float s = 0.f;
#pragma unroll
        for (int j = 0; j < 4; ++j) { v[j] = xr[64 * j]; s += (v[j].x * v[j].x + v[j].y * v[j].y) + (v[j].z * v[j].z + v[j].w * v[j].w); }
        s = wave_sum(s);
        GAS unsigned long long* o8 = (GAS unsigned long long*)(xb + (size_t)m * D) + lane;
#pragma unroll
        for (int j = 0; j < 4; ++j) o8[64 * j] = (unsigned long long)pk2(v[j].x, v[j].y) | ((unsigned long long)pk2(v[j].z, v[j].w) << 32);
        if (lane < 16) ssq1[(size_t)m * 16 + lane] = (lane == 0) ? s : 0.f;
        const f32x4 pv = ((const GAS f32x4*)(p + (size_t)m * DPLE))[lane];
        ((GAS unsigned long long*)(pb + (size_t)m * DPLE))[lane] = (unsigned long long)pk2(pv.x, pv.y) | ((unsigned long long)pk2(pv.z, pv.w) << 32);
    }
}

__device__ __forceinline__ void moba_kmean(Frame& F, const bf16* U, bf16* kmean) {
    const int gw = F.vcu * NWAVES + F.wave, NGW = F.G * NWAVES, lane = fresh_lane();
    for (int u = gw; u < MH * NBLK; u += NGW) { const int h = u / NBLK, n = u % NBLK; float s = 0.f;
        const bf16* kp = U + (size_t)(n * MBLK) * UWID + U_KM + h * MHD + lane;
#pragma unroll 8
        for (int r = 0; r < MBLK; ++r) s += bf2f(kp[(size_t)r * UWID]);
        kmean[(size_t)u * 64 + lane] = (bf16)f2bf(s * (1.0f / MBLK)); }
}
__device__ __forceinline__ void gla_seq(Frame& F, const bf16* U, const float* loga, float* oraw) {
    if (F.vcu >= 64) return;
    const int h = F.vcu >> 4, e = (F.vcu & 15) * 8 + F.wave, lane = fresh_lane();
    LAS float* scr = (LAS float*)(F.lds + RING_OFF) + F.wave * (32 * 65);
    float S = 0.f;
    for (int t0 = 0; t0 < M; t0 += 32) {
#pragma unroll 8
        for (int tt = 0; tt < 32; ++tt) { const size_t t = t0 + tt;
            const float a = __expf(loga[t * 256 + h * 64 + lane]);
            const float kk = bf2f(U[t * UWID + U_KG + h * 64 + lane]), qq = bf2f(U[t * UWID + U_QG + h * 64 + lane]), vv = bf2f(U[t * UWID + U_VG + h * 128 + e]);
            S = a * S + kk * vv;
            scr[tt * 65 + lane] = qq * S; }
        LDS_WAIT(); asm volatile("" ::: "memory");
        float o = 0.f; const int row = lane & 31, hf = lane >> 5;
#pragma unroll 16
        for (int j = 0; j < 32; ++j) o += scr[row * 65 + hf * 32 + j];
        o += __shfl_xor(o, 32);
        if (lane < 32) oraw[(size_t)(t0 + lane) * 512 + h * 128 + e] = o;
        LDS_WAIT(); asm volatile("" ::: "memory");
    }
}
__device__ __forceinline__ void gla_final(Frame& F, const bf16* U, const float* oraw, const float* gain, bf16* mix) {
    const int gw = F.vcu * NWAVES + F.wave, NGW = F.G * NWAVES, lane = fresh_lane();
    for (int u = gw; u < M * GH; u += NGW) { const int t = u >> 2, h = u & 3;
        const float o0 = oraw[(size_t)t * 512 + h * 128 + lane], o1 = oraw[(size_t)t * 512 + h * 128 + 64 + lane];
        const float ss = wave_sum(o0 * o0 + o1 * o1), rs = 1.0f / sqrtf(ss * (1.0f / 128.0f) + EPS);
        const float g0 = bf2f(U[(size_t)t * UWID + U_GG + h * 128 + lane]), g1 = bf2f(U[(size_t)t * UWID + U_GG + h * 128 + 64 + lane]);
        const float y0 = o0 * rs * gain[lane] * (g0 / (1.0f + __expf(-g0))), y1 = o1 * rs * gain[64 + lane] * (g1 / (1.0f + __expf(-g1)));
        mix[(size_t)t * D + h * 128 + lane] = (bf16)f2bf(y0); mix[(size_t)t * D + h * 128 + 64 + lane] = (bf16)f2bf(y1); }
}
__device__ __forceinline__ int rel_bucket(int n) { return n < 16 ? n : min(31, 16 + (31 - __clz(n * n)) - 8); }
typedef float f32x16 __attribute__((ext_vector_type(16)));
typedef short v4i16_t __attribute__((ext_vector_type(4)));
__device__ __forceinline__ f32x16 mfma32(bf16x8 a, bf16x8 b, f32x16 c) { return __builtin_amdgcn_mfma_f32_32x32x16_bf16(a, b, c, 0, 0, 0); }
__device__ __forceinline__ v4i16_t lds_tr(LAS unsigned char* p) { return __builtin_amdgcn_ds_read_tr16_b64_v4i16((LAS v4i16_t*)p); }
__device__ __forceinline__ unsigned cvtpk(float lo, float hi) { unsigned r; asm volatile("v_cvt_pk_bf16_f32 %0, %1, %2" : "=v"(r) : "v"(lo), "v"(hi)); return r; }
constexpr int MB_OACC = 0, MB_OP = 65, MB_LACC = 66560, MB_MREF = 67584, MB_CNT = 68608, MB_OFFS = 68864, MB_LIST = 69184, MB_VST = 71680, MB_VP = 144, MB_VSTW = 32 * MB_VP, MB_BTAB = MB_VST + 8 * MB_VSTW, MB_NTAB = 3584;
static_assert(MB_BTAB + MB_NTAB * 4 <= RING_BYTES, "MoBA LDS map");
constexpr float LOG2E = 1.4426950408889634f, MB_SC = 0.125f * LOG2E;

template <int MODE>
__device__ __forceinline__ void moba_tile(const bf16* U, int h, int n, int nchunks, int qpos, float& mref, LAS unsigned char* vst, LAS const float* rtab, bool nearblk, float cbias,
                                          f32x16& O0, f32x16& O1, float& lsum, int lane) {
    const int half = lane >> 5, l31 = lane & 31;
    bf16x8 qf[4];
    { const bf16* qp = U + (size_t)qpos * UWID + U_QM + h * 64 + 8 * half;
#pragma unroll
      for (int s = 0; s < 4; ++s) qf[s] = *(const bf16x8*)(qp + 16 * s); }
    const bf16* kp = U + (size_t)(n * MBLK + l31) * UWID + U_KM + h * 64 + 8 * half;
    const bf16* vp = U + (size_t)(n * MBLK + (lane >> 1)) * UWID + U_VM + h * 64 + (lane & 1) * 32;
    LAS unsigned char* vdst = vst + (lane >> 1) * MB_VP + (lane & 1) * 64;
    LAS unsigned char* trb = vst + (4 * half + ((lane & 15) >> 2)) * MB_VP + (16 * ((lane >> 4) & 1) + 4 * (lane & 3)) * 2;
    const int jb = 3327 - qpos + n * MBLK + 4 * half;
    float m = -INFINITY;
    for (int ck = 0; ck < nchunks; ++ck) {
        bf16x8 kf[4];
#pragma unroll
        for (int s = 0; s < 4; ++s) kf[s] = *(const bf16x8*)(kp + (size_t)ck * 32 * UWID + 16 * s);
        if (MODE != 0) {
            v4u vr[4];
#pragma unroll
            for (int i = 0; i < 4; ++i) vr[i] = *(const v4u*)(vp + (size_t)ck * 32 * UWID + 8 * i);
#pragma unroll
            for (int i = 0; i < 4; ++i) *(LAS v4u*)(vdst + 16 * i) = vr[i];
        }
        f32x16 S;
#pragma unroll
        for (int r = 0; r < 16; ++r) S[r] = 0.f;
#pragma unroll
        for (int s = 0; s < 4; ++s) S = mfma32(kf[s], qf[s], S);
        float bvv[16];
        if (nearblk) {
#pragma unroll
            for (int r = 0; r < 16; ++r) bvv[r] = rtab[jb + 32 * ck + (r & 3) + 8 * (r >> 2)];
        } else {
#pragma unroll
            for (int r = 0; r < 16; ++r) bvv[r] = cbias;
        }
#pragma unroll
        for (int r = 0; r < 16; ++r) { const int cr = (r & 3) + 8 * (r >> 2);
            float y = S[r] * MB_SC + bvv[r];
            if (MODE != 2) { const int dist = qpos - (n * MBLK + 32 * ck + 4 * half + cr); if (dist < 0) y = -INFINITY; }
            if (MODE == 0) m = fmaxf(m, y);
            else { const float p = __builtin_amdgcn_exp2f(y - mref); lsum += p; S[r] = p; } }
        if (MODE != 0) {
            bf16x8 pf0, pf1;
            { v4u w0, w1; w0.x = cvtpk(S[0], S[1]); w0.y = cvtpk(S[2], S[3]); w0.z = cvtpk(S[4], S[5]); w0.w = cvtpk(S[6], S[7]);
              w1.x = cvtpk(S[8], S[9]); w1.y = cvtpk(S[10], S[11]); w1.z = cvtpk(S[12], S[13]); w1.w = cvtpk(S[14], S[15]);
              pf0 = __builtin_bit_cast(bf16x8, w0); pf1 = __builtin_bit_cast(bf16x8, w1); }
#pragma unroll
            for (int sp = 0; sp < 2; ++sp)
#pragma unroll
                for (int dt = 0; dt < 2; ++dt) {
                    const v4i16_t lo = lds_tr(trb + sp * 16 * MB_VP + dt * 64), hi = lds_tr(trb + sp * 16 * MB_VP + dt * 64 + 8 * MB_VP);
                    const bf16x8 a = (bf16x8){lo[0], lo[1], lo[2], lo[3], hi[0], hi[1], hi[2], hi[3]};
                    if (dt == 0) O0 = mfma32(a, sp ? pf1 : pf0, O0); else O1 = mfma32(a, sp ? pf1 : pf0, O1); }
        }
    }
    if (MODE == 0) mref = fmaxf(m, __shfl_xor(m, 32));
}

__device__ __forceinline__ void moba_unit(Frame& F, const bf16* U, const bf16* kmb, const float* relb, bf16* mix, int h, int b) {
    const int lane = fresh_lane(), wave = F.wave, half = lane >> 5, l31 = lane & 31, tid = wave * 64 + lane;
    LAS unsigned char* L = F.lds + RING_OFF;
    LAS float* oacc = (LAS float*)(L + MB_OACC); LAS float* lacc = (LAS float*)(L + MB_LACC); LAS float* mrefs = (LAS float*)(L + MB_MREF);
    LAS int* cnt = (LAS int*)(L + MB_CNT); LAS int* offs = (LAS int*)(L + MB_OFFS); LAS unsigned short* list = (LAS unsigned short*)(L + MB_LIST);
    LAS unsigned char* vst = L + MB_VST + wave * MB_VSTW; LAS const float* rtab = (LAS const float*)(L + MB_BTAB);
    const float cbias = relb[31 * 8 + h] * LOG2E;
    if (tid < 64) cnt[tid] = 0;
    for (int j = tid; j < MB_NTAB; j += NWAVES * 64) { const int dist = 3327 - j; ((LAS float*)(L + MB_BTAB))[j] = relb[rel_bucket(dist < 0 ? 0 : dist) * 8 + h] * LOG2E; }
    __syncthreads();
    const int qi = wave * 32 + l31, qpos = b * MBLK + qi;
    float g0 = -INFINITY, g1 = -INFINITY, g2 = -INFINITY; int i0 = -1, i1 = -1, i2 = -1;
    if (b > 0) {
        bf16x8 qf[4];
        { const bf16* qp = U + (size_t)qpos * UWID + U_QM + h * 64 + 8 * half;
#pragma unroll
          for (int s = 0; s < 4; ++s) qf[s] = *(const bf16x8*)(qp + 16 * s); }
#pragma unroll
        for (int nt = 0; nt < 2; ++nt) if (32 * nt < b) {
            const bf16* ap = kmb + (size_t)(h * NBLK + 32 * nt + l31) * 64 + 8 * half;
            f32x16 G;
#pragma unroll
            for (int r = 0; r < 16; ++r) G[r] = 0.f;
#pragma unroll
            for (int s = 0; s < 4; ++s) G = mfma32(*(const bf16x8*)(ap + 16 * s), qf[s], G);
#pragma unroll
            for (int r = 0; r < 16; ++r) { const int nn = 32 * nt + (r & 3) + 8 * (r >> 2) + 4 * half; const float v = (nn < b) ? G[r] : -INFINITY;
                if (v > g0) { g2 = g1; i2 = i1; g1 = g0; i1 = i0; g0 = v; i0 = nn; }
                else if (v > g1) { g2 = g1; i2 = i1; g1 = v; i1 = nn; }
                else if (v > g2) { g2 = v; i2 = nn; } }
        }
        float pg[3]; int pi[3];
        pg[0] = __shfl_xor(g0, 32); pg[1] = __shfl_xor(g1, 32); pg[2] = __shfl_xor(g2, 32); pi[0] = __shfl_xor(i0, 32); pi[1] = __shfl_xor(i1, 32); pi[2] = __shfl_xor(i2, 32);
#pragma unroll
        for (int k = 0; k < 3; ++k) { const float v = pg[k]; const int nn = pi[k];
            if (nn >= 0) {
                if (v > g0 || (v == g0 && nn < i0)) { g2 = g1; i2 = i1; g1 = g0; i1 = i0; g0 = v; i0 = nn; }
                else if (v > g1 || (v == g1 && nn < i1)) { g2 = g1; i2 = i1; g1 = v; i1 = nn; }
                else if (v > g2 || (v == g2 && nn < i2)) { g2 = v; i2 = nn; } } }
    }
    int r0 = 0, r1 = 0, r2 = 0;
    if (half == 0) { if (i0 >= 0) r0 = __hip_atomic_fetch_add(cnt + i0, 1, __ATOMIC_RELAXED, __HIP_MEMORY_SCOPE_WORKGROUP); if (i1 >= 0) r1 = __hip_atomic_fetch_add(cnt + i1, 1, __ATOMIC_RELAXED, __HIP_MEMORY_SCOPE_WORKGROUP); if (i2 >= 0) r2 = __hip_atomic_fetch_add(cnt + i2, 1, __ATOMIC_RELAXED, __HIP_MEMORY_SCOPE_WORKGROUP); }
    __syncthreads();
    if (wave == 0) { const int c = cnt[lane]; int inc = c;
#pragma unroll
        for (int o = 1; o < 64; o <<= 1) { const int t = __shfl_up(inc, o); if (lane >= o) inc += t; }
        offs[lane] = inc - c; }
    __syncthreads();
    if (half == 0) { if (i0 >= 0) list[offs[i0] + r0] = (unsigned short)qi; if (i1 >= 0) list[offs[i1] + r1] = (unsigned short)qi; if (i2 >= 0) list[offs[i2] + r2] = (unsigned short)qi; }
    {
        float mref = 0.f, lsum = 0.f; f32x16 O0, O1;
#pragma unroll
        for (int r = 0; r < 16; ++r) { O0[r] = 0.f; O1[r] = 0.f; }
        moba_tile<0>(U, h, b, wave + 1, qpos, mref, vst, rtab, true, cbias, O0, O1, lsum, lane);
        moba_tile<1>(U, h, b, wave + 1, qpos, mref, vst, rtab, true, cbias, O0, O1, lsum, lane);
#pragma unroll
        for (int r = 0; r < 16; ++r) { const int d = (r & 3) + 8 * (r >> 2) + 4 * half; oacc[qi * MB_OP + d] = O0[r]; oacc[qi * MB_OP + 32 + d] = O1[r]; }
        lsum += __shfl_xor(lsum, 32);
        if (half == 0) { lacc[qi] = lsum; mrefs[qi] = mref; }
    }
    __syncthreads();
    { int tcount = 0;
      for (int n = 0; n < b; ++n) { const int c = __builtin_amdgcn_readfirstlane(cnt[n]), o = __builtin_amdgcn_readfirstlane(offs[n]);
        for (int t0 = 0; t0 < c; t0 += 32, ++tcount) { if ((tcount & 7) != wave) continue;
            const bool qv = (t0 + l31) < c; const int gq = list[o + (qv ? t0 + l31 : 0)]; const int gpos = b * MBLK + gq;
            float mref = mrefs[gq], lsum = 0.f; f32x16 O0, O1;
#pragma unroll
            for (int r = 0; r < 16; ++r) { O0[r] = 0.f; O1[r] = 0.f; }
            moba_tile<2>(U, h, n, 8, gpos, mref, vst, rtab, (b - n) <= 12, cbias, O0, O1, lsum, lane);
            if (qv) {
#pragma unroll
                for (int r = 0; r < 16; ++r) { const int d = (r & 3) + 8 * (r >> 2) + 4 * half;
                    __hip_atomic_fetch_add(oacc + gq * MB_OP + d, O0[r], __ATOMIC_RELAXED, __HIP_MEMORY_SCOPE_WORKGROUP);
                    __hip_atomic_fetch_add(oacc + gq * MB_OP + 32 + d, O1[r], __ATOMIC_RELAXED, __HIP_MEMORY_SCOPE_WORKGROUP); }
                __hip_atomic_fetch_add(lacc + gq, lsum, __ATOMIC_RELAXED, __HIP_MEMORY_SCOPE_WORKGROUP); }
        } } }
    __syncthreads();
    { const int q = tid >> 1, dh = tid & 1; const float inv = 1.0f / lacc[q]; LAS const float* op = oacc + q * MB_OP + 32 * dh;
      bf16* dst = mix + (size_t)(b * MBLK + q) * D + 512 + h * 64 + 32 * dh;
#pragma unroll
      for (int i = 0; i < 4; ++i) { v4u w; w.x = pk2(op[8 * i] * inv, op[8 * i + 1] * inv); w.y = pk2(op[8 * i + 2] * inv, op[8 * i + 3] * inv); w.z = pk2(op[8 * i + 4] * inv, op[8 * i + 5] * inv); w.w = pk2(op[8 * i + 6] * inv, op[8 * i + 7] * inv);
          *(GAS v4u*)(dst + 8 * i) = w; } }
    __syncthreads();
}
__device__ __forceinline__ void moba_phase(Frame& F, const bf16* U, const bf16* kmb, const float* relb, bf16* mix) {
    const int h = F.vcu >> 5, bb = F.vcu & 31;
    if (F.G != 256) return;
    moba_unit(F, U, kmb, relb, mix, h, bb);
    moba_unit(F, U, kmb, relb, mix, h, 63 - bb);
}
__device__ __forceinline__ void final_norm(Frame& F, float* out, const float* ssqp, const float* gain) {
    const int gw = F.vcu * NWAVES + F.wave, NGW = F.G * NWAVES, lane = fresh_lane();
    for (int m = gw; m < M; m += NGW) {
        float s = (lane < 16) ? ssqp[(size_t)m * 16 + lane] : 0.f; s = wave_sum(s);
        const float rs = 1.0f / sqrtf(s * (1.0f / 1024.0f) + EPS);
        GAS f32x4* xr = (GAS f32x4*)(out + (size_t)m * D) + lane;
#pragma unroll
        for (int j = 0; j < 4; ++j) { f32x4 v = xr[64 * j]; const f32x4 g = ((const GAS f32x4*)gain)[lane + 64 * j]; v = v * rs * g; xr[64 * j] = v; }
    }
}
__global__ void __launch_bounds__(NWAVES * 64, 2) mega_fwd(Args args) {
    extern __shared__ __attribute__((aligned(16))) unsigned char lds[];
    Frame F;
    F.lds = (LAS unsigned char*)lds;
    F.MISC = (volatile LAS unsigned*)(F.lds + MISC_OFF);
    F.tid = threadIdx.x; F.lane = F.tid & 63; F.wave = __builtin_amdgcn_readfirstlane(F.tid >> 6);
    F.G = gridDim.x; { const int bx = blockIdx.x; F.vcu = (F.G % 8 == 0) ? (bx % 8) * (F.G / 8) + bx / 8 : bx; }
    unsigned char* ws = args.ws;
    F.ctl = (gu32*)(ws + WS_CTL);
    for (int u = F.tid; u < (LDS_BYTES - LDSCTL_OFF) / 4; u += NWAVES * 64) ((LAS unsigned*)(F.lds + LDSCTL_OFF))[u] = 0u;
    __syncthreads();
    XcdBarrier bar; bar.bar = (unsigned*)(F.ctl + CW_BAR); bar.x = 0; bar.st = nullptr;
    if (N_LAUNCHES != N_PHASES) bar = xcd_barrier_post((unsigned*)(F.ctl + CW_BAR), F.MISC + 8);
#define GRID_BAR() do { if (N_LAUNCHES == N_PHASES) { if (F.tid == 0) __hip_atomic_store(F.ctl + CW_TMO, 0xBADBA0u, RLX_AGENT); } else { xcd_barrier(bar); } } while (0)
    const int lo = args.ph_lo, hi = args.ph_hi;
#define IN(k) (lo <= (k) && (k) < hi)
#define BOTH(k) (IN(k) && IN((k) + 1))
    float* out = args.out;
    bf16* Wgu1 = (bf16*)(ws + WS_WGU1); bf16* Wd1 = (bf16*)(ws + WS_WD1); bf16* Win = (bf16*)(ws + WS_WIN); bf16* Wout = (bf16*)(ws + WS_WOUT);
    bf16* Wgu2 = (bf16*)(ws + WS_WGU2); bf16* Wd2 = (bf16*)(ws + WS_WD2); bf16* Wpg = (bf16*)(ws + WS_WPG); bf16* Wpp = (bf16*)(ws + WS_WPP);
    float* ssq1 = (float*)(ws + WS_SSQ1); float* ssq2 = (float*)(ws + WS_SSQ2); float* ssq3 = (float*)(ws + WS_SSQ3); float* ssq4 = (float*)(ws + WS_SSQ4); float* ssq5 = (float*)(ws + WS_SSQ5);
    bf16* kmean = (bf16*)(ws + WS_KMEAN);
    bf16* hb = (bf16*)(ws + WS_HB); float* oraw = (float*)(ws + WS_HB); bf16* pb = (bf16*)(ws + WS_PB); bf16* mix = (bf16*)(ws + WS_MIX); bf16* xb = (bf16*)(ws + WS_MIX);
    bf16* U = (bf16*)(ws + WS_U); bf16* hmid = (bf16*)(ws + WS_U); float* loga = (float*)(ws + WS_LOGA); bf16* pp = (bf16*)(ws + WS_PP);
    using pg8::Gemm; using pg8::StaticOrder;
#define RUN_GEMM(EPI, A_, B_, N_, K_, ...) do { Gemm g{A_, B_, M, N_, K_}; StaticOrder S; S.init(M, N_, F.G, (int)blockIdx.x); pg8::EPI E{__VA_ARGS__}; \
        pg8::gemm_phase<pg8::EPI, StaticOrder, PG8_ALIGN, PG8_SP2>(F.lds + RING_OFF, g, S, E); } while (0)

    if (IN(0)) { p0_prologue(F, args); if (BOTH(0)) GRID_BAR(); }
    if (IN(1)) { RUN_GEMM(EpiSwiGLU, xb, Wgu1, NGU, D, hmid, FF, ssq1); if (BOTH(1)) GRID_BAR(); }
    if (IN(2)) { RUN_GEMM(EpiResid<1>, hmid, Wd1, D, FF, args.in[0], out, hb, ssq2); if (BOTH(2)) GRID_BAR(); }
    if (IN(3)) { RUN_GEMM(EpiWin, hb, Win, UWID, D, U, loga, ssq2, args.in[8]); if (BOTH(3)) GRID_BAR(); }
    if (IN(4)) { moba_kmean(F, U, kmean); gla_seq(F, U, loga, oraw); if (BOTH(4)) GRID_BAR(); }
    if (IN(5)) { gla_final(F, U, oraw, args.in[9], mix); moba_phase(F, U, kmean, args.in[17], mix); if (BOTH(5)) GRID_BAR(); }
    if (IN(6)) { RUN_GEMM(EpiResid<0>, mix, Wout, D, D, out, out, hb, ssq3); if (BOTH(6)) GRID_BAR(); }
    if (IN(7)) { RUN_GEMM(EpiPlain, pb, Wpp, D, DPLE, pp); if (BOTH(7)) GRID_BAR(); }
    if (IN(8)) { RUN_GEMM(EpiSwiGLU, hb, Wgu2, NGU, D, hmid, FF, ssq3); if (BOTH(8)) GRID_BAR(); }
    if (IN(9)) { RUN_GEMM(EpiResid<1>, hmid, Wd2, D, FF, out, out, hb, ssq4); if (BOTH(9)) GRID_BAR(); }
    if (IN(10)) { RUN_GEMM(EpiPle, hb, Wpg, D, D, out, out, pp, ssq4, ssq5); if (BOTH(10)) GRID_BAR(); }
    if (IN(11)) { final_norm(F, out, ssq5, args.in[18]); }
#undef IN
#undef BOTH
}

extern "C" void kernel_launch(void* const* d_in, const int* in_sizes, int n_in, void* d_out, int out_size, void* d_ws, size_t ws_size, hipStream_t stream) {
    static int grid = 0;
    if (grid == 0) {
        if (n_in != 19 || in_sizes[0] != M * D || out_size != M * D || ws_size < WS_END) { fprintf(stderr, "kernel_launch: unexpected shapes (n_in %d, in0 %d, out %d, ws %zu); nothing launched\n", n_in, n_in > 0 ? in_sizes[0] : -1, out_size, ws_size); grid = -1; return; }
        int dev = 0, cus = 0, per_cu = 0;
        if (hipGetDevice(&dev) != hipSuccess || hipDeviceGetAttribute(&cus, hipDeviceAttributeMultiprocessorCount, dev) != hipSuccess) { grid = -1; return; }
        if (hipFuncSetAttribute((const void*)mega_fwd, hipFuncAttributeMaxDynamicSharedMemorySize, LDS_BYTES) != hipSuccess) { fprintf(stderr, "kernel_launch: hipFuncSetAttribute failed\n"); grid = -1; return; }
        if (hipOccupancyMaxActiveBlocksPerMultiprocessor(&per_cu, (const void*)mega_fwd, NWAVES * 64, LDS_BYTES) != hipSuccess || per_cu < 1) { fprintf(stderr, "kernel_launch: occupancy query reports %d workgroups per CU\n", per_cu); }
        (void)hipGetLastError();
        grid = cus;
    }
    if (grid < 0) return;
    if (hipMemsetAsync((char*)d_ws + WS_CTL, 0, CTL_ZERO_BYTES, stream) != hipSuccess) { fprintf(stderr, "kernel_launch: hipMemsetAsync failed\n"); return; }
    Args a{};
    for (int i = 0; i < 19; ++i) a.in[i] = (const float*)d_in[i];
    a.out = (float*)d_out; a.ws = (unsigned char*)d_ws;
    for (int li = 0; li < N_LAUNCHES; ++li) {
        if (N_LAUNCHES == 1) { a.ph_lo = 0; a.ph_hi = N_PHASES; } else { a.ph_lo = li; a.ph_hi = li + 1; }
        a.li = li;
        hipLaunchKernelGGL(mega_fwd, dim3(grid), dim3(NWAVES * 64), LDS_BYTES, stream, a);
        const hipError_t le = hipPeekAtLastError();
        if (le != hipSuccess) { fprintf(stderr, "kernel_launch: launch %d failed: %s\n", li, hipGetErrorName(le)); break; }
    }
}
```

```cpp
#include <hip/hip_runtime.h>
#include <cstdio>
#include <cstdint>
namespace pg8 {
#define PG8_LAS __attribute__((address_space(3)))
typedef unsigned short bf16_t;
typedef short bf16x8 __attribute__((ext_vector_type(8)));
typedef float f32x4 __attribute__((ext_vector_type(4)));
typedef unsigned u32x4 __attribute__((ext_vector_type(4)));
constexpr int BM = 256, BK = 64, HALF = 128, HTB = HALF * BK * 2  , STAGE_BYTES = 8 * HTB, NXCD = 8, WGM = 8;

__host__ __device__ __forceinline__ int lds_byte(int r, int c) { const int st = (r >> 4) * 2 + (c >> 5), rr = r & 15, cc = c & 31, ob = rr * 64 + cc * 2; return st * 1024 + (ob ^ (((ob >> 9) & 1) << 5)); }
__host__ __device__ __forceinline__ void stage_rc(int b, int& R, int& C) { const int st = b / 1024, sb = b % 1024, swz = sb ^ (((sb >> 9) & 1) << 5); R = (st >> 1) * 16 + swz / 64; C = (st & 1) * 32 + (swz % 64) / 2; }
__host__ __device__ __forceinline__ int perm32(int rho) { const int n = rho >> 4, i = rho & 15; return 8 * (i >> 2) + 4 * n + (i & 3); }

struct Unit { int pm, pn; };
struct Gemm { const bf16_t* A; const bf16_t* Bt; int M, N, K; };

struct StaticOrder {
    int nM, nN, nwg, G, c;
    __host__ __device__ void init(int M, int N, int G_, int c_) { nM = M / BM; nN = N / BM; nwg = nM * nN; G = G_; c = c_; }
    __host__ __device__ bool next(int i, Unit& u) const {
        const long L = (long)i * G + c; if (L >= nwg) return false;
        int wgid = (int)L; { const int q = nwg / NXCD, r = nwg % NXCD, xcd = wgid % NXCD, off = wgid / NXCD; wgid = (xcd < r ? xcd * (q + 1) : r * (q + 1) + (xcd - r) * q) + off; }
        const int nig = WGM * nN, gid = wgid / nig, fm = gid * WGM, gsz = (nM - fm) < WGM ? (nM - fm) : WGM;
        u.pm = fm + ((wgid % nig) % gsz); u.pn = (wgid % nig) / gsz; return true;
    }
    __device__ __forceinline__ void a_ready(const Unit&) const {}
    __device__ __forceinline__ void done(const Unit&) const {}
};

__device__ __forceinline__ unsigned cvt_pk_bf16(float lo, float hi) { unsigned r; asm volatile("v_cvt_pk_bf16_f32 %0, %1, %2" : "=v"(r) : "v"(lo), "v"(hi)); return r; }
__device__ __forceinline__ float bf_lo(unsigned w) { return __uint_as_float(w << 16); }
__device__ __forceinline__ float bf_hi(unsigned w) { return __uint_as_float(w & 0xffff0000u); }
constexpr float RMS_EPS = 1e-6f;
__device__ __forceinline__ float row_rstd(const float* ssqp, int r, int fq) {
    const f32x4 p = *(const f32x4*)(ssqp + (size_t)r * 16 + 4 * fq);
    float s = (p[0] + p[1]) + (p[2] + p[3]);
    s += __shfl_xor(s, 16); s += __shfl_xor(s, 32);
    return __builtin_amdgcn_rsqf(s * (1.0f / 1024.0f) + RMS_EPS);
}
__device__ __forceinline__ float fast_sigmoid(float x) { return __builtin_amdgcn_rcpf(1.0f + __builtin_amdgcn_exp2f(-1.4426950408889634f * x)); }
struct EpiSwiGLU {
    static constexpr bool PERM = true, AFTER_DRAIN = false;
    bf16_t* O; int ldc; const float* ssqp;
    __device__ __forceinline__ void operator()(const f32x4 (&acc)[2][2][4][2], const Unit& u, int wr, int wc, int fr, int fq) const {
        const int row0 = u.pm * BM + wr * 64 + fr, col0 = u.pn * HALF + wc * 32 + 8 * fq;
#pragma unroll
        for (int ai = 0; ai < 2; ++ai)
#pragma unroll
            for (int m = 0; m < 4; ++m) { const int r = row0 + ai * HALF + m * 16; const float rs = row_rstd(ssqp, r, fq);
                float h[8];
#pragma unroll
                for (int n = 0; n < 2; ++n)
#pragma unroll
                    for (int j = 0; j < 4; ++j) { const float g = acc[ai][0][m][n][j] * rs, up = acc[ai][1][m][n][j] * rs; h[n * 4 + j] = g * fast_sigmoid(g) * up; }
                u32x4 w; w.x = cvt_pk_bf16(h[0], h[1]); w.y = cvt_pk_bf16(h[2], h[3]); w.z = cvt_pk_bf16(h[4], h[5]); w.w = cvt_pk_bf16(h[6], h[7]);
                *(u32x4*)(O + (size_t)r * ldc + col0) = w; }
    }
};
template <int HALF_ALPHA> struct EpiResid {
    static constexpr bool PERM = true, AFTER_DRAIN = false; static constexpr float alpha = HALF_ALPHA ? 0.5f : 1.0f;
    const float* base; float* out; bf16_t* ob; float* ssq_out;
    __device__ __forceinline__ void operator()(const f32x4 (&acc)[2][2][4][2], const Unit& u, int wr, int wc, int fr, int fq) const {
        const int row0 = u.pm * BM + wr * 64 + fr, col0 = u.pn * BM + wc * 32 + 8 * fq;
#pragma unroll
        for (int ai = 0; ai < 2; ++ai)
#pragma unroll
            for (int m = 0; m < 4; ++m) { const int r = row0 + ai * HALF + m * 16; float ss = 0.f;
#pragma unroll
                for (int bj = 0; bj < 2; ++bj) { const size_t off = (size_t)r * 1024 + col0 + bj * HALF;
                    const f32x4 b0 = *(const f32x4*)(base + off), b1 = *(const f32x4*)(base + off + 4);
                    const f32x4 v0 = b0 + acc[ai][bj][m][0] * alpha, v1 = b1 + acc[ai][bj][m][1] * alpha;
                    *(f32x4*)(out + off) = v0; *(f32x4*)(out + off + 4) = v1;
                    u32x4 w; w.x = cvt_pk_bf16(v0[0], v0[1]); w.y = cvt_pk_bf16(v0[2], v0[3]); w.z = cvt_pk_bf16(v1[0], v1[1]); w.w = cvt_pk_bf16(v1[2], v1[3]);
                    *(u32x4*)(ob + off) = w;
                    ss += (v0[0] * v0[0] + v0[1] * v0[1]) + (v0[2] * v0[2] + v0[3] * v0[3]) + (v1[0] * v1[0] + v1[1] * v1[1]) + (v1[2] * v1[2] + v1[3] * v1[3]); }
                ss += __shfl_xor(ss, 16); ss += __shfl_xor(ss, 32);
                if (fq == 0) ssq_out[(size_t)r * 16 + 4 * u.pn + wc] = ss; }
    }
};
constexpr int UW = 3328;
struct EpiWin {
    static constexpr bool PERM = true, AFTER_DRAIN = false;
    bf16_t* U; float* loga; const float* ssqp; const float* bgk;
    __device__ __forceinline__ void operator()(const f32x4 (&acc)[2][2][4][2], const Unit& u, int wr, int wc, int fr, int fq) const {
        const int row0 = u.pm * BM + wr * 64 + fr, cl0 = wc * 32 + 8 * fq;
        const float sc = (u.pn == 0) ? 0.125f : 1.0f;
#pragma unroll
        for (int ai = 0; ai < 2; ++ai)
#pragma unroll
            for (int m = 0; m < 4; ++m) { const int r = row0 + ai * HALF + m * 16; const float rs = row_rstd(ssqp, r, fq);
#pragma unroll
                for (int bj = 0; bj < 2; ++bj) { const int cl = cl0 + bj * HALF;
                    const f32x4 v0 = acc[ai][bj][m][0] * rs, v1 = acc[ai][bj][m][1] * rs;
                    if (u.pn == 6) {
                        const f32x4 c0 = *(const f32x4*)(bgk + cl), c1 = *(const f32x4*)(bgk + cl + 4); f32x4 o0, o1;
#pragma unroll
                        for (int j = 0; j < 4; ++j) { const float x0 = v0[j] + c0[j], x1 = v1[j] + c1[j];
                            o0[j] = (fminf(x0, 0.f) - log1pf(__expf(-fabsf(x0)))) * (1.0f / 16.0f); o1[j] = (fminf(x1, 0.f) - log1pf(__expf(-fabsf(x1)))) * (1.0f / 16.0f); }
                        *(f32x4*)(loga + (size_t)r * 256 + cl) = o0; *(f32x4*)(loga + (size_t)r * 256 + cl + 4) = o1;
                    } else {
                        u32x4 w; w.x = cvt_pk_bf16(v0[0] * sc, v0[1] * sc); w.y = cvt_pk_bf16(v0[2] * sc, v0[3] * sc); w.z = cvt_pk_bf16(v1[0] * sc, v1[1] * sc); w.w = cvt_pk_bf16(v1[2] * sc, v1[3] * sc);
                        *(u32x4*)(U + (size_t)r * UW + u.pn * BM + cl) = w; } } }
    }
};
struct EpiPlain {
    static constexpr bool PERM = true, AFTER_DRAIN = false;
    bf16_t* O;
    __device__ __forceinline__ void operator()(const f32x4 (&acc)[2][2][4][2], const Unit& u, int wr, int wc, int fr, int fq) const {
        const int row0 = u.pm * BM + wr * 64 + fr, col0 = u.pn * BM + wc * 32 + 8 * fq;
#pragma unroll
        for (int ai = 0; ai < 2; ++ai)
#pragma unroll
            for (int m = 0; m < 4; ++m) { const int r = row0 + ai * HALF + m * 16;
#pragma unroll
                for (int bj = 0; bj < 2; ++bj) { const f32x4 v0 = acc[ai][bj][m][0], v1 = acc[ai][bj][m][1];
                    u32x4 w; w.x = cvt_pk_bf16(v0[0], v0[1]); w.y = cvt_pk_bf16(v0[2], v0[3]); w.z = cvt_pk_bf16(v1[0], v1[1]); w.w = cvt_pk_bf16(v1[2], v1[3]);
                    *(u32x4*)(O + (size_t)r * 1024 + col0 + bj * HALF) = w; } }
    }
};
struct EpiPle {
    static constexpr bool PERM = true, AFTER_DRAIN = false;
    const float* base; float* out; const bf16_t* pp; const float* ssqp; float* ssq_out;
    __device__ __forceinline__ void operator()(const f32x4 (&acc)[2][2][4][2], const Unit& u, int wr, int wc, int fr, int fq) const {
        const int row0 = u.pm * BM + wr * 64 + fr, col0 = u.pn * BM + wc * 32 + 8 * fq;
#pragma unroll
        for (int ai = 0; ai < 2; ++ai)
#pragma unroll
            for (int m = 0; m < 4; ++m) { const int r = row0 + ai * HALF + m * 16; const float rs = row_rstd(ssqp, r, fq); float ss = 0.f;
#pragma unroll
                for (int bj = 0; bj < 2; ++bj) { const size_t off = (size_t)r * 1024 + col0 + bj * HALF;
                    const f32x4 b0 = *(const f32x4*)(base + off), b1 = *(const f32x4*)(base + off + 4);
                    const u32x4 pw = *(const u32x4*)(pp + off);
                    f32x4 v0, v1;
                    v0[0] = b0[0] + fast_sigmoid(acc[ai][bj][m][0][0] * rs) * bf_lo(pw.x); v0[1] = b0[1] + fast_sigmoid(acc[ai][bj][m][0][1] * rs) * bf_hi(pw.x);
                    v0[2] = b0[2] + fast_sigmoid(acc[ai][bj][m][0][2] * rs) * bf_lo(pw.y); v0[3] = b0[3] + fast_sigmoid(acc[ai][bj][m][0][3] * rs) * bf_hi(pw.y);
                    v1[0] = b1[0] + fast_sigmoid(acc[ai][bj][m][1][0] * rs) * bf_lo(pw.z); v1[1] = b1[1] + fast_sigmoid(acc[ai][bj][m][1][1] * rs) * bf_hi(pw.z);
                    v1[2] = b1[2] + fast_sigmoid(acc[ai][bj][m][1][2] * rs) * bf_lo(pw.w); v1[3] = b1[3] + fast_sigmoid(acc[ai][bj][m][1][3] * rs) * bf_hi(pw.w);
                    *(f32x4*)(out + off) = v0; *(f32x4*)(out + off + 4) = v1;
                    ss += (v0[0] * v0[0] + v0[1] * v0[1]) + (v0[2] * v0[2] + v0[3] * v0[3]) + (v1[0] * v1[0] + v1[1] * v1[1]) + (v1[2] * v1[2] + v1[3] * v1[3]); }
                ss += __shfl_xor(ss, 16); ss += __shfl_xor(ss, 32);
                if (fq == 0) ssq_out[(size_t)r * 16 + 4 * u.pn + wc] = ss; }
    }
};
template <class Epi, class Sched, bool ALIGN_EPI = false, bool SP2 = false>
__device__ __forceinline__ void gemm_phase(PG8_LAS unsigned char* lds, const Gemm g, const Sched& S, const Epi& E) {
    const int tid = threadIdx.x, wid = __builtin_amdgcn_readfirstlane(tid >> 6), lane = tid & 63, wr = wid >> 2, wc = wid & 3, fr = lane & 15, fq = lane >> 4;
    const int K = g.K, nt = K / BK;
    unsigned voffA[2], voffB[2];
#pragma unroll
    for (int i = 0; i < 2; ++i) { int R, C; stage_rc(tid * 16 + i * 8192, R, C); const int Rb = Epi::PERM ? ((R & ~31) + perm32(R & 31)) : R;
        voffA[i] = (unsigned)(R * K + C) * 2u; voffB[i] = (unsigned)(Rb * K + C) * 2u; }
    const size_t kstep = (size_t)(BK * 2);
    const size_t hstep = (size_t)HALF * K * 2;
    const size_t tstep = 2 * hstep;
    const unsigned ldsw = (unsigned)wid * 1024u;
    const int aoff = lds_byte(wr * 64 + fr, fq * 8), boff = lds_byte(wc * 32 + fr, fq * 8);
#define PG8_SA(b, h) (((b) * 2 + (h)) * HTB)
#define PG8_SB(b, h) ((4 + (b) * 2 + (h)) * HTB)
#define PG8_STAGE(bufoff, gbase, voff) do { _Pragma("unroll") for (int _i = 0; _i < 2; ++_i) \
        __builtin_amdgcn_global_load_lds((const unsigned*)((const char*)(gbase) + (voff)[_i]), (PG8_LAS unsigned*)(lds + (bufoff) + ldsw + _i * 8192), 16, 0, 0); } while (0)
#define PG8_LDA(dst, b, h) do { _Pragma("unroll") for (int m = 0; m < 4; ++m) _Pragma("unroll") for (int k = 0; k < 2; ++k) dst[m][k] = *(const PG8_LAS bf16x8*)(lds + PG8_SA(b, h) + aoff + m * 2048 + k * 1024); } while (0)
#define PG8_LDB(dst, b, h) do { _Pragma("unroll") for (int n = 0; n < 2; ++n) _Pragma("unroll") for (int k = 0; k < 2; ++k) dst[n][k] = *(const PG8_LAS bf16x8*)(lds + PG8_SB(b, h) + boff + n * 2048 + k * 1024); } while (0)
#define PG8_MMA(ai, bj, At, Bt) do { __builtin_amdgcn_s_setprio(1); _Pragma("unroll") for (int m = 0; m < 4; ++m) _Pragma("unroll") for (int n = 0; n < 2; ++n) _Pragma("unroll") for (int k = 0; k < 2; ++k) \
        acc[ai][bj][m][n] = __builtin_amdgcn_mfma_f32_16x16x32_bf16(Bt[n][k], At[m][k], acc[ai][bj][m][n], 0, 0, 0); __builtin_amdgcn_s_setprio(0); } while (0)
#define PG8_WAIT_V(n) asm volatile("s_waitcnt vmcnt(" #n ")" ::: "memory")
#define PG8_WAIT_L(n) asm volatile("s_waitcnt lgkmcnt(" #n ")" ::: "memory")
#define PG8_BAR __builtin_amdgcn_s_barrier()
#define PG8_SCHED __builtin_amdgcn_sched_barrier(0)
    Unit cur, nxt; int ui = 0;
    if (!S.next(0, cur)) return;
    f32x4 acc[2][2][4][2];
#pragma unroll
    for (int a = 0; a < 2; ++a)
#pragma unroll
        for (int b = 0; b < 2; ++b)
#pragma unroll
            for (int m = 0; m < 4; ++m)
#pragma unroll
                for (int n = 0; n < 2; ++n) acc[a][b][m][n] = (f32x4){0.f, 0.f, 0.f, 0.f};
    bf16x8 At[4][2], B0[2][2], B1[2][2];
    const char* cA = (const char*)g.A + (size_t)cur.pm * tstep; const char* cB = (const char*)g.Bt + (size_t)cur.pn * tstep;
    S.a_ready(cur);
    if constexpr (SP2) {
        PG8_STAGE(PG8_SB(0, 0), cB, voffB); PG8_STAGE(PG8_SB(0, 1), cB + hstep, voffB); PG8_STAGE(PG8_SA(0, 0), cA, voffA); PG8_STAGE(PG8_SA(0, 1), cA + hstep, voffA);
        if (wr == 1) PG8_BAR;
        PG8_WAIT_V(2); PG8_BAR;
        PG8_STAGE(PG8_SB(1, 0), cB + kstep, voffB); PG8_STAGE(PG8_SA(1, 0), cA + kstep, voffA); PG8_STAGE(PG8_SB(1, 1), cB + hstep + kstep, voffB);
        PG8_WAIT_V(6); PG8_BAR;
    } else {
        PG8_STAGE(PG8_SB(0, 0), cB, voffB); PG8_STAGE(PG8_SA(0, 0), cA, voffA); PG8_STAGE(PG8_SB(0, 1), cB + hstep, voffB); PG8_STAGE(PG8_SA(0, 1), cA + hstep, voffA);
        if (wr == 1) PG8_BAR;
        PG8_WAIT_V(4); PG8_BAR;
        PG8_STAGE(PG8_SB(1, 0), cB + kstep, voffB); PG8_STAGE(PG8_SA(1, 0), cA + kstep, voffA); PG8_STAGE(PG8_SB(1, 1), cB + hstep + kstep, voffB);
        PG8_WAIT_V(6); PG8_BAR;
    }
    for (;;) {
        const bool has_next = S.next(ui + 1, nxt);
        const char* nA = has_next ? (const char*)g.A + (size_t)nxt.pm * tstep : cA; const char* nB = has_next ? (const char*)g.Bt + (size_t)nxt.pn * tstep : cB;
        for (int t = 0; t < nt; t += 2) {
            const bool last = (t == nt - 2);
            const char* a1 = cA + (size_t)(t + 1) * kstep;
            const char* a2 = last ? nA : cA + (size_t)(t + 2) * kstep; const char* b2 = last ? nB : cB + (size_t)(t + 2) * kstep;
            const char* a3 = a2 + kstep; const char* b3 = b2 + kstep;
            if (last && has_next) S.a_ready(nxt);
            if constexpr (SP2) {
            PG8_LDB(B0, 0, 0); PG8_LDB(B1, 0, 1); PG8_SCHED; PG8_LDA(At, 0, 0); PG8_STAGE(PG8_SA(1, 1), a1 + hstep, voffA);
            PG8_WAIT_V(8); PG8_WAIT_L(0); PG8_BAR; PG8_MMA(0, 0, At, B0); PG8_MMA(0, 1, At, B1); PG8_BAR; PG8_SCHED;
            PG8_LDA(At, 0, 1); PG8_STAGE(PG8_SB(0, 0), b2, voffB); PG8_STAGE(PG8_SB(0, 1), b2 + hstep, voffB); PG8_STAGE(PG8_SA(0, 0), a2, voffA);
            PG8_WAIT_V(8); PG8_WAIT_L(0); PG8_BAR; PG8_MMA(1, 0, At, B0); PG8_MMA(1, 1, At, B1); PG8_BAR; PG8_SCHED;
            PG8_LDB(B0, 1, 0); PG8_LDB(B1, 1, 1); PG8_SCHED; PG8_LDA(At, 1, 0); PG8_STAGE(PG8_SA(0, 1), a2 + hstep, voffA);
            PG8_WAIT_V(8); PG8_WAIT_L(0); PG8_BAR; PG8_MMA(0, 0, At, B0); PG8_MMA(0, 1, At, B1); PG8_BAR; PG8_SCHED;
            PG8_LDA(At, 1, 1); PG8_STAGE(PG8_SB(1, 0), b3, voffB); PG8_STAGE(PG8_SB(1, 1), b3 + hstep, voffB); PG8_STAGE(PG8_SA(1, 0), a3, voffA);
            PG8_WAIT_V(8); PG8_WAIT_L(0); PG8_BAR; PG8_MMA(1, 0, At, B0); PG8_MMA(1, 1, At, B1); PG8_BAR; PG8_SCHED;
            } else {
            PG8_LDB(B0, 0, 0); PG8_SCHED; PG8_LDA(At, 0, 0); PG8_STAGE(PG8_SA(1, 1), a1 + hstep, voffA);
            PG8_WAIT_L(8); PG8_BAR; PG8_WAIT_L(0); PG8_MMA(0, 0, At, B0); PG8_BAR; PG8_SCHED;
            PG8_LDB(B1, 0, 1); PG8_STAGE(PG8_SB(0, 0), b2, voffB);
            PG8_BAR; PG8_WAIT_L(0); PG8_MMA(0, 1, At, B1); PG8_BAR;
            PG8_LDA(At, 0, 1); PG8_STAGE(PG8_SA(0, 0), a2, voffA);
            PG8_BAR; PG8_WAIT_L(0); PG8_MMA(1, 0, At, B0); PG8_BAR; PG8_SCHED;
            PG8_STAGE(PG8_SB(0, 1), b2 + hstep, voffB);
            PG8_WAIT_V(6); PG8_BAR; PG8_MMA(1, 1, At, B1); PG8_BAR;
            PG8_LDB(B0, 1, 0); PG8_SCHED; PG8_LDA(At, 1, 0); PG8_STAGE(PG8_SA(0, 1), a2 + hstep, voffA);
            PG8_WAIT_L(8); PG8_BAR; PG8_WAIT_L(0); PG8_MMA(0, 0, At, B0); PG8_BAR; PG8_SCHED;
            PG8_LDB(B1, 1, 1); PG8_STAGE(PG8_SB(1, 0), b3, voffB);
            PG8_BAR; PG8_WAIT_L(0); PG8_MMA(0, 1, At, B1); PG8_BAR;
            PG8_LDA(At, 1, 1); PG8_STAGE(PG8_SA(1, 0), a3, voffA);
            PG8_BAR; PG8_WAIT_L(0); PG8_MMA(1, 0, At, B0); PG8_BAR; PG8_SCHED;
            PG8_STAGE(PG8_SB(1, 1), b3 + hstep, voffB);
            PG8_WAIT_V(6); PG8_BAR; PG8_MMA(1, 1, At, B1); PG8_BAR;
            }
        }
        if constexpr (ALIGN_EPI) { if (wr == 0) PG8_BAR; }
        if constexpr (!Epi::AFTER_DRAIN) { E(acc, cur, wr, wc, fr, fq); S.done(cur); }
        if (!has_next) break;
#pragma unroll
        for (int a = 0; a < 2; ++a)
#pragma unroll
            for (int b = 0; b < 2; ++b)
#pragma unroll
                for (int m = 0; m < 4; ++m)
#pragma unroll
                    for (int n = 0; n < 2; ++n) acc[a][b][m][n] = (f32x4){0.f, 0.f, 0.f, 0.f};
        cur = nxt; cA = nA; cB = nB; ++ui;
        if constexpr (ALIGN_EPI) { if (wr == 1) PG8_BAR; }
    }
    PG8_WAIT_V(0);
    if constexpr (!ALIGN_EPI) { if (wr == 0) PG8_BAR; }
    PG8_BAR;
    if constexpr (Epi::AFTER_DRAIN) { E.fused(acc, cur, wr, wc, fr, fq, lds, wid, lane); S.done(cur); }
#undef PG8_SA
#undef PG8_SB
#undef PG8_STAGE
#undef PG8_LDA
#undef PG8_LDB
#undef PG8_MMA
#undef PG8_WAIT_V
#undef PG8_WAIT_L
#undef PG8_BAR
#undef PG8_SCHED
}
}
#ifndef PG8_SP2
#define PG8_SP2 true
#endif
#ifndef PG8_ALIGN
#define PG8_ALIGN true
#endif
constexpr int NWAVES = 8;
constexpr int N_PHASES = 13;
#ifndef MK_N_LAUNCHES
#define MK_N_LAUNCHES 1
#endif
constexpr int N_LAUNCHES = MK_N_LAUNCHES;

constexpr int M = 16384, D = 1024, FF = 2816, NGU = 2 * FF, DPLE = 256;
constexpr int GH = 4, GDK = 64, GDV = 128, MH = 8, MHD = 64, MBLK = 256, NBLK = M / MBLK;
constexpr int UWID = 3328;
constexpr int U_QG = 0, U_KG = 256, U_VG = 512, U_GG = 1024, U_QM = 1792, U_KM = 2304, U_VM = 2816;
constexpr float EPS = 1e-6f;

constexpr size_t MiB = 1u << 20;
constexpr size_t WS_CTL = 0, CTL_ZERO_BYTES = 1 * MiB;
constexpr size_t WS_WGU1 = 1 * MiB, WS_WD1 = 12 * MiB, WS_WIN = 18 * MiB, WS_WOUT = 25 * MiB, WS_WGU2 = 27 * MiB, WS_WD2 = 38 * MiB, WS_WPG = 44 * MiB, WS_WPP = 46 * MiB;
constexpr size_t WS_SSQ1 = 47 * MiB, WS_SSQ2 = 48 * MiB, WS_SSQ3 = 49 * MiB, WS_SSQ4 = 50 * MiB, WS_SSQ5 = 51 * MiB, WS_KMEAN = 52 * MiB;
constexpr size_t WS_HB = 54 * MiB;
constexpr size_t WS_PB = 86 * MiB;
constexpr size_t WS_MIX = 94 * MiB;
constexpr size_t WS_U = 126 * MiB;
constexpr size_t WS_LOGA = 230 * MiB;
constexpr size_t WS_PP = 214 * MiB;
constexpr size_t WS_END = 256 * MiB;
static_assert(WS_U + (size_t)M * UWID * 2 <= WS_LOGA && WS_LOGA + (size_t)M * 256 * 4 <= WS_END && WS_U + (size_t)M * FF * 2 <= WS_PP && WS_PP + (size_t)M * D * 2 <= WS_END, "d_ws map");
constexpr int CW_TMO = 0, CW_CODE = 1;
constexpr int CW_BAR = 4096;

constexpr int RING_OFF = 0, RING_BYTES = 131072;
constexpr int LDSCTL_OFF = RING_BYTES, MISC_OFF = LDSCTL_OFF + 320;
constexpr int LDS_BYTES = 147456;
#define GAS __attribute__((address_space(1)))
#define LAS __attribute__((address_space(3)))
typedef unsigned short bf16;
typedef unsigned v4u __attribute__((ext_vector_type(4)));
typedef float f32x4 __attribute__((ext_vector_type(4)));
typedef short bf16x8 __attribute__((ext_vector_type(8)));
typedef GAS unsigned gu32;
typedef GAS unsigned long long gu64;
#define RLX_AGENT __ATOMIC_RELAXED, __HIP_MEMORY_SCOPE_AGENT
#define LDS_WAIT() asm volatile("s_waitcnt lgkmcnt(0)" ::: "memory")
#define VM_WAIT() asm volatile("s_waitcnt vmcnt(0)" ::: "memory")
__device__ __forceinline__ unsigned long long rt() { return __builtin_amdgcn_s_memrealtime(); }
__device__ __forceinline__ unsigned f2bf(float f) { unsigned u = __builtin_bit_cast(unsigned, f); return (u + 0x7fffu + ((u >> 16) & 1u)) >> 16; }
__device__ __forceinline__ unsigned pk2(float lo, float hi) { return f2bf(lo) | (f2bf(hi) << 16); }

#define XB_TMO      128
#define XB_XCNT(j)  (256  + 64 * (j))
#define XB_XSUB(j)  (1280 + 64 * (j))
#define XB_XGEN(j)  (2304 + 64 * (j))
#define XB_TOP      3328
#define XB_TOPGEN   3392
#define XCD_BAR_WORDS 3456
#define XB_SPIN_CAP (1u << 18)

__device__ __forceinline__ unsigned xb_ld(unsigned* p)              { return __hip_atomic_load(p, __ATOMIC_RELAXED, __HIP_MEMORY_SCOPE_AGENT); }
__device__ __forceinline__ unsigned xb_add(unsigned* p, unsigned v) { return __hip_atomic_fetch_add(p, v, __ATOMIC_RELAXED, __HIP_MEMORY_SCOPE_AGENT); }
__device__ __forceinline__ unsigned xb_xcc_id() { return (unsigned)__builtin_amdgcn_s_getreg((3 << 11) | 20) & 0xFu; }
#define XB_SPIN(cond, bar) do { unsigned _sp = 0; while (cond) { __builtin_amdgcn_s_sleep(1); \
    if ((++_sp & 255u) == 0u) { if (xb_ld(&(bar)[XB_TMO])) break; if (_sp > XB_SPIN_CAP) { atomicAdd(&(bar)[XB_TMO], 1u); break; } } } } while (0)

struct XcdBarrier {
    unsigned* bar; unsigned x;
    volatile LAS unsigned* st;
};

__device__ __forceinline__ XcdBarrier xcd_barrier_post(unsigned* bar, volatile LAS unsigned* st) {
    XcdBarrier b; b.bar = bar; b.x = xb_xcc_id(); b.st = st;
    if (threadIdx.x == 0) (void)xb_add(&bar[XB_XCNT(b.x)], 1u);
    return b;
}
__device__ __forceinline__ void xcd_barrier_complete(unsigned* bar, unsigned x, unsigned& nloc, unsigned& nx) {
    const unsigned G = gridDim.x * gridDim.y * gridDim.z;
    unsigned sum, cnt, mine, sp = 0u;
    for (;;) {
        sum = 0u; cnt = 0u; mine = 0u;
#pragma unroll
        for (unsigned j = 0; j < 16; ++j) { const unsigned c = xb_ld(&bar[XB_XCNT(j)]); sum += c; cnt += (c > 0u) ? 1u : 0u; mine = (j == x) ? c : mine; }
        if (sum == G) break;
        __builtin_amdgcn_s_sleep(1);
        if ((++sp & 255u) == 0u) { if (xb_ld(&bar[XB_TMO])) break; if (sp > XB_SPIN_CAP) { atomicAdd(&bar[XB_TMO], 1u); break; } }
    }
    nloc = mine > 0u ? mine : 1u; nx = cnt > 0u ? cnt : 1u;
}

__device__ __forceinline__ void xcd_barrier(const XcdBarrier& b) {
    asm volatile("s_waitcnt vmcnt(0)" ::: "memory");
    __syncthreads();
    if (threadIdx.x == 0) {
        unsigned* bar = b.bar;
        __builtin_amdgcn_s_waitcnt(0);
        unsigned nloc = b.st[0], nx = b.st[1];
        if (nloc == 0u) { xcd_barrier_complete(bar, b.x, nloc, nx); b.st[0] = nloc; b.st[1] = nx; }
        const unsigned old = xb_add(&bar[XB_XSUB(b.x)], 1u);
        const unsigned gen = old / nloc;
        if (old + 1u == (gen + 1u) * nloc) {
            __builtin_amdgcn_fence(__ATOMIC_RELEASE, "agent");
            asm volatile("s_waitcnt vmcnt(0)" ::: "memory");
            const unsigned og = xb_add(&bar[XB_TOP], 1u);
            const unsigned tg = og / nx;
            if (og + 1u == (tg + 1u) * nx) xb_add(&bar[XB_TOPGEN], 1u);
            else XB_SPIN(xb_ld(&bar[XB_TOPGEN]) == tg, bar);
            __builtin_amdgcn_fence(__ATOMIC_ACQUIRE, "agent");
            xb_add(&bar[XB_XGEN(b.x)], 1u);
            asm volatile("s_waitcnt vmcnt(0)" ::: "memory");
        } else {
            XB_SPIN(xb_ld(&bar[XB_XGEN(b.x)]) == gen, bar);
            __builtin_amdgcn_fence(__ATOMIC_ACQUIRE, "agent");
            asm volatile("s_waitcnt vmcnt(0)" ::: "memory");
        }
    }
    __syncthreads();
}
struct Frame {
    LAS unsigned char* lds;
    volatile LAS unsigned* MISC;
    gu32* ctl;
    int tid, lane, wave;
    int vcu, G;
};
__device__ __forceinline__ int fresh_lane() { int l; asm volatile("v_mbcnt_lo_u32_b32 %0, -1, 0\n\tv_mbcnt_hi_u32_b32 %0, -1, %0" : "=v"(l)); return l; }
__device__ __forceinline__ float wave_sum(float v) {
#pragma unroll
    for (int o = 1; o < 64; o <<= 1) v += __shfl_xor(v, o);
    return v;
}
__device__ __forceinline__ float wave_max(float v) {
#pragma unroll
    for (int o = 1; o < 64; o <<= 1) v = fmaxf(v, __shfl_xor(v, o));
    return v;
}
__device__ __forceinline__ float bf2f(bf16 h) { return __uint_as_float((unsigned)h << 16); }
__device__ __forceinline__ float bf_lo2(unsigned w) { return __uint_as_float(w << 16); }
__device__ __forceinline__ float bf_hi2(unsigned w) { return __uint_as_float(w & 0xffff0000u); }

__device__ __forceinline__ void tr_store(bf16* WT, int K, int k0, int n0dst, LAS float* scr, int lane) {
    LDS_WAIT(); asm volatile("" ::: "memory");
    const int c = lane & 7;
#pragma unroll
    for (int j = 0; j < 4; ++j) { const int n = (lane >> 3) + 8 * j; const LAS float* s = scr + (8 * c) * 33 + n;
        v4u o; o.x = pk2(s[0 * 33], s[1 * 33]); o.y = pk2(s[2 * 33], s[3 * 33]); o.z = pk2(s[4 * 33], s[5 * 33]); o.w = pk2(s[6 * 33], s[7 * 33]);
        *(GAS v4u*)(WT + (size_t)(n0dst + n) * K + k0 + 8 * c) = o; }
    LDS_WAIT(); asm volatile("" ::: "memory");
}
__device__ __forceinline__ void tr_item(const float* W, int K, int N, const float* gain, bf16* WT, int k0, int n0dst, int c0src, LAS float* scr, int lane) {
#pragma unroll 8
    for (int i = 0; i < 32; ++i) { const int kk = 2 * i + (lane >> 5); const float g = gain ? gain[k0 + kk] : 1.0f;
        scr[kk * 33 + (lane & 31)] = W[(size_t)(k0 + kk) * N + c0src + (lane & 31)] * g; }
    tr_store(WT, K, k0, n0dst, scr, lane);
}
__device__ __forceinline__ void tr_item_gk(const float* Win, const float* Wup, const float* gain, bf16* WT, int k0, int j0, LAS float* scr, int lane) {
    for (int i = 0; i < 32; ++i) { const int kk = 2 * i + (lane >> 5), k = k0 + kk, j = j0 + (lane & 31); float a = 0.f;
#pragma unroll
        for (int r = 0; r < 16; ++r) a += Win[(size_t)k * 3088 + 1536 + r] * Wup[r * 256 + j];
        scr[kk * 33 + (lane & 31)] = a * gain[k]; }
    tr_store(WT, 1024, k0, 1536 + j0, scr, lane);
}
struct Args { const float* in[19]; float* out; unsigned char* ws; int ph_lo, ph_hi, li, pad; };

__device__ __forceinline__ void p0_prologue(Frame& F, const Args& A) {
    LAS float* scr = (LAS float*)(F.lds + RING_OFF + F.wave * 16384);
    unsigned char* ws = A.ws;
    const int gw = F.vcu * NWAVES + F.wave, NGW = F.G * NWAVES, lane = fresh_lane();
    constexpr int I_GU = 16 * 176, I_D = 44 * 32, I_IN = 16 * 104, I_O = 16 * 32, I_PP = 4 * 32;
    constexpr int NITEMS = 2 * I_GU + 2 * I_D + I_IN + 2 * I_O + I_PP;
    for (int it = gw; it < NITEMS; it += NGW) {
        int r = it;
        if (r < 2 * I_GU) { const int which = r / I_GU; r -= which * I_GU; const int kb = r / 176, nb = r % 176, t = nb >> 3, g = nb & 7;
            const int src = (g < 4) ? (128 * t + 32 * g) : (FF + 128 * t + 32 * (g - 4));
            tr_item(A.in[which ? 12 : 3], D, NGU, A.in[which ? 11 : 2], (bf16*)(ws + (which ? WS_WGU2 : WS_WGU1)), 64 * kb, 32 * nb, src, scr, lane); continue; } r -= 2 * I_GU;
        if (r < 2 * I_D) { const int which = r / I_D; r -= which * I_D; const int kb = r / 32, nb = r % 32;
            tr_item(A.in[which ? 13 : 4], FF, D, nullptr, (bf16*)(ws + (which ? WS_WD2 : WS_WD1)), 64 * kb, 32 * nb, 32 * nb, scr, lane); continue; } r -= 2 * I_D;
        if (r < I_IN) { const int kb = r / 104, nb = r % 104;
            if (nb >= 48 && nb < 56) tr_item_gk(A.in[6], A.in[7], A.in[5], (bf16*)(ws + WS_WIN), 64 * kb, 32 * (nb - 48), scr, lane);
            else tr_item(A.in[6], D, 3088, A.in[5], (bf16*)(ws + WS_WIN), 64 * kb, 32 * nb, nb < 48 ? 32 * nb : 32 * nb - 240, scr, lane);
            continue; } r -= I_IN;
        if (r < 2 * I_O) { const int which = r / I_O; r -= which * I_O; const int kb = r / 32, nb = r % 32;
            tr_item(A.in[which ? 15 : 10], D, D, which ? A.in[14] : nullptr, (bf16*)(ws + (which ? WS_WPG : WS_WOUT)), 64 * kb, 32 * nb, 32 * nb, scr, lane); continue; } r -= 2 * I_O;
        { const int kb = r / 32, nb = r % 32; tr_item(A.in[16], DPLE, D, nullptr, (bf16*)(ws + WS_WPP), 64 * kb, 32 * nb, 32 * nb, scr, lane); }
    }
    const float* x = A.in[0]; const float* p = A.in[1];
    bf16* xb = (bf16*)(ws + WS_MIX); bf16* pb = (bf16*)(ws + WS_PB); float* ssq1 = (float*)(ws + WS_SSQ1);
    for (int m = gw; m < M; m += NGW) {
        const GAS f32x4* xr = (const GAS f32x4*)(x + (size_t)m * D) + lane; f32x4 v[4]; float s = 0.f;
#pragma unroll
        for (int j = 0; j < 4; ++j) { v[j] = xr[64 * j]; s += (v[j].x * v[j].x + v[j].y * v[j].y) + (v[j].z * v[j].z + v[j].w * v[j].w); }
        s = wave_sum(s);
        GAS unsigned long long* o8 = (GAS unsigned long long*)(xb + (size_t)m * D) + lane;
#pragma unroll
        for (int j = 0; j < 4; ++j) o8[64 * j] = (unsigned long long)pk2(v[j].x, v[j].y) | ((unsigned long long)pk2(v[j].z, v[j].w) << 32);
        if (lane < 16) ssq1[(size_t)m * 16 + lane] = (lane == 0) ? s : 0.f;
        const f32x4 pv = ((const GAS f32x4*)(p + (size_t)m * DPLE))[lane];
        ((GAS unsigned long long*)(pb + (size_t)m * DPLE))[lane] = (unsigned long long)pk2(pv.x, pv.y) | ((unsigned long long)pk2(pv.z, pv.w) << 32);
    }
}

__device__ __forceinline__ void moba_kmean(Frame& F, const bf16* U, bf16* kmean) {
    const int gw = F.vcu * NWAVES + F.wave, NGW = F.G * NWAVES, lane = fresh_lane();
    for (int u = gw; u < MH * NBLK; u += NGW) { const int h = u / NBLK, n = u % NBLK; float s = 0.f;
        const bf16* kp = U + (size_t)(n * MBLK) * UWID + U_KM + h * MHD + lane;
#pragma unroll 8
        for (int r = 0; r < MBLK; ++r) s += bf2f(kp[(size_t)r * UWID]);
        kmean[(size_t)u * 64 + lane] = (bf16)f2bf(s * (1.0f / MBLK)); }
}
__device__ __forceinline__ int rel_bucket(int n) { return n < 16 ? n : min(31, 16 + (31 - __clz(n * n)) - 8); }
typedef float f32x16 __attribute__((ext_vector_type(16)));
typedef short v4i16_t __attribute__((ext_vector_type(4)));
__device__ __forceinline__ f32x16 mfma32(bf16x8 a, bf16x8 b, f32x16 c) { return __builtin_amdgcn_mfma_f32_32x32x16_bf16(a, b, c, 0, 0, 0); }
__device__ __forceinline__ v4i16_t lds_tr(LAS unsigned char* p) { return __builtin_amdgcn_ds_read_tr16_b64_v4i16((LAS v4i16_t*)p); }
__device__ __forceinline__ unsigned cvtpk(float lo, float hi) { unsigned r; asm volatile("v_cvt_pk_bf16_f32 %0, %1, %2" : "=v"(r) : "v"(lo), "v"(hi)); return r; }
constexpr int MB_OACC = 0, MB_OP = 65, MB_LACC = 66560, MB_MREF = 67584, MB_CNT = 68608, MB_OFFS = 68864, MB_LIST = 69184, MB_VST = 71680, MB_VP = 144, MB_VSTW = 32 * MB_VP, MB_BTAB = MB_VST + 8 * MB_VSTW, MB_NTAB = 3584;
static_assert(MB_BTAB + MB_NTAB * 4 <= RING_BYTES, "MoBA LDS map");
constexpr float LOG2E = 1.4426950408889634f, MB_SC = 0.125f * LOG2E;

template <int MODE>
__device__ __forceinline__ void moba_tile(const bf16* U, int h, int n, int nchunks, int qpos, float& mref, LAS unsigned char* vst, LAS const float* rtab, bool nearblk, float cbias,
                                          f32x16& O0, f32x16& O1, float& lsum, int lane) {
    const int half = lane >> 5, l31 = lane & 31;
    bf16x8 qf[4];
    { const bf16* qp = U + (size_t)qpos * UWID + U_QM + h * 64 + 8 * half;
#pragma unroll
      for (int s = 0; s < 4; ++s) qf[s] = *(const bf16x8*)(qp + 16 * s); }
    const bf16* kp = U + (size_t)(n * MBLK + l31) * UWID + U_KM + h * 64 + 8 * half;
    const bf16* vp = U + (size_t)(n * MBLK + (lane >> 1)) * UWID + U_VM + h * 64 + (lane & 1) * 32;
    LAS unsigned char* vdst = vst + (lane >> 1) * MB_VP + (lane & 1) * 64;
    LAS unsigned char* trb = vst + (4 * half + ((lane & 15) >> 2)) * MB_VP + (16 * ((lane >> 4) & 1) + 4 * (lane & 3)) * 2;
    const int jb = 3327 - qpos + n * MBLK + 4 * half;
    float m = -INFINITY;
    for (int ck = 0; ck < nchunks; ++ck) {
        bf16x8 kf[4];
#pragma unroll
        for (int s = 0; s < 4; ++s) kf[s] = *(const bf16x8*)(kp + (size_t)ck * 32 * UWID + 16 * s);
        if (MODE != 0) {
            v4u vr[4];
#pragma unroll
            for (int i = 0; i < 4; ++i) vr[i] = *(const v4u*)(vp + (size_t)ck * 32 * UWID + 8 * i);
#pragma unroll
            for (int i = 0; i < 4; ++i) *(LAS v4u*)(vdst + 16 * i) = vr[i];
        }
        f32x16 S;
#pragma unroll
        for (int r = 0; r < 16; ++r) S[r] = 0.f;
#pragma unroll
        for (int s = 0; s < 4; ++s) S = mfma32(kf[s], qf[s], S);
        float bvv[16];
        if (nearblk) {
#pragma unroll
            for (int r = 0; r < 16; ++r) bvv[r] = rtab[jb + 32 * ck + (r & 3) + 8 * (r >> 2)];
        } else {
#pragma unroll
            for (int r = 0; r < 16; ++r) bvv[r] = cbias;
        }
#pragma unroll
        for (int r = 0; r < 16; ++r) { const int cr = (r & 3) + 8 * (r >> 2);
            float y = S[r] * MB_SC + bvv[r];
            if (MODE != 2) { const int dist = qpos - (n * MBLK + 32 * ck + 4 * half + cr); if (dist < 0) y = -INFINITY; }
            if (MODE == 0) m = fmaxf(m, y);
            else { const float p = __builtin_amdgcn_exp2f(y - mref); lsum += p; S[r] = p; } }
        if (MODE != 0) {
            bf16x8 pf0, pf1;
            { v4u w0, w1; w0.x = cvtpk(S[0], S[1]); w0.y = cvtpk(S[2], S[3]); w0.z = cvtpk(S[4], S[5]); w0.w = cvtpk(S[6], S[7]);
              w1.x = cvtpk(S[8], S[9]); w1.y = cvtpk(S[10], S[11]); w1.z = cvtpk(S[12], S[13]); w1.w = cvtpk(S[14], S[15]);
              pf0 = __builtin_bit_cast(bf16x8, w0); pf1 = __builtin_bit_cast(bf16x8, w1); }
#pragma unroll
            for (int sp = 0; sp < 2; ++sp)
#pragma unroll
                for (int dt = 0; dt < 2; ++dt) {
                    const v4i16_t lo = lds_tr(trb + sp * 16 * MB_VP + dt * 64), hi = lds_tr(trb + sp * 16 * MB_VP + dt * 64 + 8 * MB_VP);
                    const bf16x8 a = (bf16x8){lo[0], lo[1], lo[2], lo[3], hi[0], hi[1], hi[2], hi[3]};
                    if (dt == 0) O0 = mfma32(a, sp ? pf1 : pf0, O0); else O1 = mfma32(a, sp ? pf1 : pf0, O1); }
        }
    }
    if (MODE == 0) mref = fmaxf(m, __shfl_xor(m, 32));
}

__device__ __forceinline__ void moba_unit(Frame& F, const bf16* U, const bf16* kmb, const float* relb, bf16* mix, int h, int b) {
    const int lane = fresh_lane(), wave = F.wave, half = lane >> 5, l31 = lane & 31, tid = wave * 64 + lane;
    LAS unsigned char* L = F.lds + RING_OFF;
    LAS float* oacc = (LAS float*)(L + MB_OACC); LAS float* lacc = (LAS float*)(L + MB_LACC); LAS float* mrefs = (LAS float*)(L + MB_MREF);
    LAS int* cnt = (LAS int*)(L + MB_CNT); LAS int* offs = (LAS int*)(L + MB_OFFS); LAS unsigned short* list = (LAS unsigned short*)(L + MB_LIST);
    LAS unsigned char* vst = L + MB_VST + wave * MB_VSTW; LAS const float* rtab = (LAS const float*)(L + MB_BTAB);
    const float cbias = relb[31 * 8 + h] * LOG2E;
    if (tid < 64) cnt[tid] = 0;
    for (int j = tid; j < MB_NTAB; j += NWAVES * 64) { const int dist = 3327 - j; ((LAS float*)(L + MB_BTAB))[j] = relb[rel_bucket(dist < 0 ? 0 : dist) * 8 + h] * LOG2E; }
    __syncthreads();
    const int qi = wave * 32 + l31, qpos = b * MBLK + qi;
    float g0 = -INFINITY, g1 = -INFINITY, g2 = -INFINITY; int i0 = -1, i1 = -1, i2 = -1;
    if (b > 0) {
        bf16x8 qf[4];
        { const bf16* qp = U + (size_t)qpos * UWID + U_QM + h * 64 + 8 * half;
#pragma unroll
          for (int s = 0; s < 4; ++s) qf[s] = *(const bf16x8*)(qp + 16 * s); }
#pragma unroll
        for (int nt = 0; nt < 2; ++nt) if (32 * nt < b) {
            const bf16* ap = kmb + (size_t)(h * NBLK + 32 * nt + l31) * 64 + 8 * half;
            f32x16 G;
#pragma unroll
            for (int r = 0; r < 16; ++r) G[r] = 0.f;
#pragma unroll
            for (int s = 0; s < 4; ++s) G = mfma32(*(const bf16x8*)(ap + 16 * s), qf[s], G);
#pragma unroll
            for (int r = 0; r < 16; ++r) { const int nn = 32 * nt + (r & 3) + 8 * (r >> 2) + 4 * half; const float v = (nn < b) ? G[r] : -INFINITY;
                if (v > g0) { g2 = g1; i2 = i1; g1 = g0; i1 = i0; g0 = v; i0 = nn; }
                else if (v > g1) { g2 = g1; i2 = i1; g1 = v; i1 = nn; }
                else if (v > g2) { g2 = v; i2 = nn; } }
        }
        float pg[3]; int pi[3];
        pg[0] = __shfl_xor(g0, 32); pg[1] = __shfl_xor(g1, 32); pg[2] = __shfl_xor(g2, 32); pi[0] = __shfl_xor(i0, 32); pi[1] = __shfl_xor(i1, 32); pi[2] = __shfl_xor(i2, 32);
#pragma unroll
        for (int k = 0; k < 3; ++k) { const float v = pg[k]; const int nn = pi[k];
            if (nn >= 0) {
                if (v > g0 || (v == g0 && nn < i0)) { g2 = g1; i2 = i1; g1 = g0; i1 = i0; g0 = v; i0 = nn; }
                else if (v > g1 || (v == g1 && nn < i1)) { g2 = g1; i2 = i1; g1 = v; i1 = nn; }
                else if (v > g2 || (v == g2 && nn < i2)) { g2 = v; i2 = nn; } } }
    }
    int r0 = 0, r1 = 0, r2 = 0;
    if (half == 0) { if (i0 >= 0) r0 = __hip_atomic_fetch_add(cnt + i0, 1, __ATOMIC_RELAXED, __HIP_MEMORY_SCOPE_WORKGROUP); if (i1 >= 0) r1 = __hip_atomic_fetch_add(cnt + i1, 1, __ATOMIC_RELAXED, __HIP_MEMORY_SCOPE_WORKGROUP); if (i2 >= 0) r2 = __hip_atomic_fetch_add(cnt + i2, 1, __ATOMIC_RELAXED, __HIP_MEMORY_SCOPE_WORKGROUP); }
    __syncthreads();
    if (wave == 0) { const int c = cnt[lane]; int inc = c;
#pragma unroll
        for (int o = 1; o < 64; o <<= 1) { const int t = __shfl_up(inc, o); if (lane >= o) inc += t; }
        offs[lane] = inc - c; }
    __syncthreads();
    if (half == 0) { if (i0 >= 0) list[offs[i0] + r0] = (unsigned short)qi; if (i1 >= 0) list[offs[i1] + r1] = (unsigned short)qi; if (i2 >= 0) list[offs[i2] + r2] = (unsigned short)qi; }
    {
        float mref = 0.f, lsum = 0.f; f32x16 O0, O1;
#pragma unroll
        for (int r = 0; r < 16; ++r) { O0[r] = 0.f; O1[r] = 0.f; }
        moba_tile<0>(U, h, b, wave + 1, qpos, mref, vst, rtab, true, cbias, O0, O1, lsum, lane);
        moba_tile<1>(U, h, b, wave + 1, qpos, mref, vst, rtab, true, cbias, O0, O1, lsum, lane);
#pragma unroll
        for (int r = 0; r < 16; ++r) { const int d = (r & 3) + 8 * (r >> 2) + 4 * half; oacc[qi * MB_OP + d] = O0[r]; oacc[qi * MB_OP + 32 + d] = O1[r]; }
        lsum += __shfl_xor(lsum, 32);
        if (half == 0) { lacc[qi] = lsum; mrefs[qi] = mref; }
    }
    __syncthreads();
    { int tcount = 0;
      for (int n = 0; n < b; ++n) { const int c = __builtin_amdgcn_readfirstlane(cnt[n]), o = __builtin_amdgcn_readfirstlane(offs[n]);
        for (int t0 = 0; t0 < c; t0 += 32, ++tcount) { if ((tcount & 7) != wave) continue;
            const bool qv = (t0 + l31) < c; const int gq = list[o + (qv ? t0 + l31 : 0)]; const int gpos = b * MBLK + gq;
            float mref = mrefs[gq], lsum = 0.f; f32x16 O0, O1;
#pragma unroll
            for (int r = 0; r < 16; ++r) { O0[r] = 0.f; O1[r] = 0.f; }
            moba_tile<2>(U, h, n, 8, gpos, mref, vst, rtab, (b - n) <= 12, cbias, O0, O1, lsum, lane);
            if (qv) {
#pragma unroll
                for (int r = 0; r < 16; ++r) { const int d = (r & 3) + 8 * (r >> 2) + 4 * half;
                    __hip_atomic_fetch_add(oacc + gq * MB_OP + d, O0[r], __ATOMIC_RELAXED, __HIP_MEMORY_SCOPE_WORKGROUP);
                    __hip_atomic_fetch_add(oacc + gq * MB_OP + 32 + d, O1[r], __ATOMIC_RELAXED, __HIP_MEMORY_SCOPE_WORKGROUP); }
                __hip_atomic_fetch_add(lacc + gq, lsum, __ATOMIC_RELAXED, __HIP_MEMORY_SCOPE_WORKGROUP); }
        } } }
    __syncthreads();
    { const int q = tid >> 1, dh = tid & 1; const float inv = 1.0f / lacc[q]; LAS const float* op = oacc + q * MB_OP + 32 * dh;
      bf16* dst = mix + (size_t)(b * MBLK + q) * D + 512 + h * 64 + 32 * dh;
#pragma unroll
      for (int i = 0; i < 4; ++i) { v4u w; w.x = pk2(op[8 * i] * inv, op[8 * i + 1] * inv); w.y = pk2(op[8 * i + 2] * inv, op[8 * i + 3] * inv); w.z = pk2(op[8 * i + 4] * inv, op[8 * i + 5] * inv); w.w = pk2(op[8 * i + 6] * inv, op[8 * i + 7] * inv);
          *(GAS v4u*)(dst + 8 * i) = w; } }
    __syncthreads();
}
__device__ __forceinline__ void moba_phase(Frame& F, const bf16* U, const bf16* kmb, const float* relb, bf16* mix) {
    const int h = F.vcu >> 5, bb = F.vcu & 31;
    if (F.G != 256) return;
    moba_unit(F, U, kmb, relb, mix, h, bb);
    moba_unit(F, U, kmb, relb, mix, h, 63 - bb);
}
constexpr int GA_KD = 0, GA_KDP = 160, GA_V = 40960, GA_VP = 288, GA_SEG = GA_V + 256 * GA_VP;
constexpr int GC_KE = 0, GC_KEP = 144, GC_V = 36864, GC_VP = 288, GC_SST = GC_V + 256 * GC_VP, GC_SSTP = 144;
static_assert(GA_SEG + 2048 <= RING_BYTES && GC_SST + 128 * GC_SSTP <= RING_BYTES, "GLA LDS map");
__device__ __forceinline__ bf16x8 tr_pair(LAS unsigned char* p, int second_off) { const v4i16_t lo = lds_tr(p), hi = lds_tr(p + second_off); return (bf16x8){lo[0], lo[1], lo[2], lo[3], hi[0], hi[1], hi[2], hi[3]}; }

__device__ __forceinline__ void gla_A(Frame& F, const bf16* U, float* loga, float* dS, float* dec) {
    if (F.G != 256) return;
    const int c = F.vcu >> 2, h = F.vcu & 3, lane = fresh_lane(), wave = F.wave, tid = wave * 64 + lane;
    LAS unsigned char* L = F.lds + RING_OFF; LAS float* segtot = (LAS float*)(L + GA_SEG);
    const int d = lane, seg = wave, t0 = c * 256 + seg * 32;
    float bl[32]; float run = 0.f;
#pragma unroll
    for (int i = 0; i < 32; ++i) { run += loga[(size_t)(t0 + i) * 256 + h * 64 + d]; bl[i] = run; }
    segtot[seg * 64 + d] = run;
#pragma unroll
    for (int i = 0; i < 8; ++i) { const int p = tid + 512 * i, row = p >> 4, ch = p & 15;
        *(LAS v4u*)(L + GA_V + row * GA_VP + ch * 16) = *(const v4u*)(U + (size_t)(c * 256 + row) * UWID + U_VG + h * 128 + ch * 8); }
    __syncthreads();
    float pre = 0.f, tot = 0.f;
#pragma unroll
    for (int s = 0; s < 8; ++s) { const float v = segtot[s * 64 + d]; tot += v; if (s < seg) pre += v; }
#pragma unroll
    for (int i = 0; i < 32; ++i) { const float b = bl[i] + pre; loga[(size_t)(t0 + i) * 256 + h * 64 + d] = b;
        const float kk = bf2f(U[(size_t)(t0 + i) * UWID + U_KG + h * 64 + d]);
        *(LAS bf16*)(L + GA_KD + (seg * 32 + i) * GA_KDP + d * 2) = (bf16)f2bf(kk * __expf(tot - b)); }
    if (seg == 0) dec[(size_t)(c * 4 + h) * 64 + d] = __expf(tot);
    __syncthreads();
    const int et = wave >> 1, dt = wave & 1, half = lane >> 5, l31 = lane & 31, g1 = (lane >> 4) & 1, q = (lane & 15) >> 2, p = lane & 3;
    LAS unsigned char* trA = L + GA_V + (4 * half + q) * GA_VP + (32 * et + 16 * g1 + 4 * p) * 2;
    LAS unsigned char* trB = L + GA_KD + (4 * half + q) * GA_KDP + (32 * dt + 16 * g1 + 4 * p) * 2;
    f32x16 acc;
#pragma unroll
    for (int r = 0; r < 16; ++r) acc[r] = 0.f;
#pragma unroll 4
    for (int s = 0; s < 16; ++s) { const bf16x8 a = tr_pair(trA + s * 16 * GA_VP, 8 * GA_VP), b = tr_pair(trB + s * 16 * GA_KDP, 8 * GA_KDP); acc = mfma32(a, b, acc); }
    float* dst = dS + (size_t)(c * 4 + h) * 8192;
#pragma unroll
    for (int r = 0; r < 16; ++r) { const int e = 32 * et + (r & 3) + 8 * (r >> 2) + 4 * half; dst[e * 64 + 32 * dt + l31] = acc[r]; }
    __syncthreads();
}
__device__ __forceinline__ void gla_scan(Frame& F, const float* dS, const float* dec, bf16* Sst) {
    const int lane = fresh_lane(), tid = F.wave * 64 + lane;
    if (tid >= 128 || F.G != 256) return;
    const int idx = F.vcu * 128 + tid, h = idx >> 13, d = idx & 63, el = idx & 8191;
    float S = 0.f;
#pragma unroll 16
    for (int c = 0; c < 64; ++c) { Sst[(size_t)(c * 4 + h) * 8192 + el] = (bf16)f2bf(S); S = dec[(size_t)(c * 4 + h) * 64 + d] * S + dS[(size_t)(c * 4 + h) * 8192 + el]; }
}
__device__ __forceinline__ void gla_C(Frame& F, const bf16* U, const float* bcum, const bf16* Sst, const float* gain, bf16* mix) {
    if (F.G != 256) return;
    const int c = F.vcu >> 2, h = F.vcu & 3, lane = fresh_lane(), wave = F.wave, tid = wave * 64 + lane;
    LAS unsigned char* L = F.lds + RING_OFF;
    { const int d = lane, seg = wave, t0 = c * 256 + seg * 32;
#pragma unroll 8
      for (int i = 0; i < 32; ++i) { const float b = bcum[(size_t)(t0 + i) * 256 + h * 64 + d]; const float kk = bf2f(U[(size_t)(t0 + i) * UWID + U_KG + h * 64 + d]);
          *(LAS bf16*)(L + GC_KE + (seg * 32 + i) * GC_KEP + d * 2) = (bf16)f2bf(kk * __expf(-b)); } }
#pragma unroll
    for (int i = 0; i < 8; ++i) { const int p = tid + 512 * i, row = p >> 4, ch = p & 15;
        *(LAS v4u*)(L + GC_V + row * GC_VP + ch * 16) = *(const v4u*)(U + (size_t)(c * 256 + row) * UWID + U_VG + h * 128 + ch * 8); }
#pragma unroll
    for (int i = 0; i < 2; ++i) { const int p = tid + 512 * i, row = p >> 3, ch = p & 7;
        *(LAS v4u*)(L + GC_SST + row * GC_SSTP + ch * 16) = *(const v4u*)(Sst + (size_t)((c * 4 + h) * 128 + row) * 64 + ch * 8); }
    __syncthreads();
    const int half = lane >> 5, l31 = lane & 31, g1 = (lane >> 4) & 1, q = (lane & 15) >> 2, p = lane & 3;
    const size_t tok = (size_t)c * 256 + wave * 32 + l31;
    bf16x8 qf[4];
#pragma unroll
    for (int s = 0; s < 4; ++s) { const v4u q8 = *(const v4u*)(U + tok * UWID + U_QG + h * 64 + 16 * s + 8 * half);
        const f32x4 b0 = *(const f32x4*)(bcum + tok * 256 + h * 64 + 16 * s + 8 * half), b1 = *(const f32x4*)(bcum + tok * 256 + h * 64 + 16 * s + 8 * half + 4);
        v4u w; w.x = cvtpk(bf_lo2(q8.x) * __expf(b0[0]), bf_hi2(q8.x) * __expf(b0[1])); w.y = cvtpk(bf_lo2(q8.y) * __expf(b0[2]), bf_hi2(q8.y) * __expf(b0[3]));
        w.z = cvtpk(bf_lo2(q8.z) * __expf(b1[0]), bf_hi2(q8.z) * __expf(b1[1])); w.w = cvtpk(bf_lo2(q8.w) * __expf(b1[2]), bf_hi2(q8.w) * __expf(b1[3]));
        qf[s] = __builtin_bit_cast(bf16x8, w); }
    f32x16 O[4];
#pragma unroll
    for (int et = 0; et < 4; ++et)
#pragma unroll
        for (int r = 0; r < 16; ++r) O[et][r] = 0.f;
#pragma unroll
    for (int et = 0; et < 4; ++et)
#pragma unroll
        for (int s = 0; s < 4; ++s) O[et] = mfma32(*(LAS const bf16x8*)(L + GC_SST + (32 * et + l31) * GC_SSTP + (16 * s + 8 * half) * 2), qf[s], O[et]);
    LAS unsigned char* trV = L + GC_V + (4 * half + q) * GC_VP + (16 * g1 + 4 * p) * 2;
    for (int jt = 0; jt <= wave; ++jt) {
        f32x16 ST;
#pragma unroll
        for (int r = 0; r < 16; ++r) ST[r] = 0.f;
#pragma unroll
        for (int s = 0; s < 4; ++s) ST = mfma32(*(LAS const bf16x8*)(L + GC_KE + (32 * jt + l31) * GC_KEP + (16 * s + 8 * half) * 2), qf[s], ST);
        if (jt == wave) {
#pragma unroll
            for (int r = 0; r < 16; ++r) { const int jl = (r & 3) + 8 * (r >> 2) + 4 * half; if (jl > l31) ST[r] = 0.f; } }
        bf16x8 pf0, pf1;
        { v4u w0, w1; w0.x = cvtpk(ST[0], ST[1]); w0.y = cvtpk(ST[2], ST[3]); w0.z = cvtpk(ST[4], ST[5]); w0.w = cvtpk(ST[6], ST[7]);
          w1.x = cvtpk(ST[8], ST[9]); w1.y = cvtpk(ST[10], ST[11]); w1.z = cvtpk(ST[12], ST[13]); w1.w = cvtpk(ST[14], ST[15]);
          pf0 = __builtin_bit_cast(bf16x8, w0); pf1 = __builtin_bit_cast(bf16x8, w1); }
#pragma unroll
        for (int sp = 0; sp < 2; ++sp)
#pragma unroll
            for (int et = 0; et < 4; ++et) { const bf16x8 a = tr_pair(trV + (32 * jt + 16 * sp) * GC_VP + et * 64, 8 * GC_VP); O[et] = mfma32(a, sp ? pf1 : pf0, O[et]); }
    }
    float ss = 0.f;
#pragma unroll
    for (int et = 0; et < 4; ++et)
#pragma unroll
        for (int r = 0; r < 16; ++r) ss += O[et][r] * O[et][r];
    ss += __shfl_xor(ss, 32);
    const float rs = 1.0f / sqrtf(ss * (1.0f / 128.0f) + EPS);
#pragma unroll
    for (int et = 0; et < 4; ++et)
#pragma unroll
        for (int rg = 0; rg < 4; ++rg) { const int e0 = 32 * et + 8 * rg + 4 * half;
            const uint2 gw = *(const uint2*)(U + tok * UWID + U_GG + h * 128 + e0); const f32x4 gn = *(const f32x4*)(gain + e0);
            const float g0 = bf_lo2(gw.x), g1v = bf_hi2(gw.x), g2 = bf_lo2(gw.y), g3 = bf_hi2(gw.y);
            const float y0 = O[et][4 * rg + 0] * rs * gn[0] * (g0 / (1.0f + __expf(-g0))), y1 = O[et][4 * rg + 1] * rs * gn[1] * (g1v / (1.0f + __expf(-g1v)));
            const float y2 = O[et][4 * rg + 2] * rs * gn[2] * (g2 / (1.0f + __expf(-g2))), y3 = O[et][4 * rg + 3] * rs * gn[3] * (g3 / (1.0f + __expf(-g3)));
            uint2 o; o.x = cvtpk(y0, y1); o.y = cvtpk(y2, y3);
            *(uint2*)(mix + tok * D + h * 128 + e0) = o; }
    __syncthreads();
}
__device__ __forceinline__ void final_norm(Frame& F, float* out, const float* ssqp, const float* gain) {
    const int gw = F.vcu * NWAVES + F.wave, NGW = F.G * NWAVES, lane = fresh_lane();
    for (int m = gw; m < M; m += NGW) {
        float s = (lane < 16) ? ssqp[(size_t)m * 16 + lane] : 0.f; s = wave_sum(s);
        const float rs = 1.0f / sqrtf(s * (1.0f / 1024.0f) + EPS);
        GAS f32x4* xr = (GAS f32x4*)(out + (size_t)m * D) + lane;
#pragma unroll
        for (int j = 0; j < 4; ++j) { f32x4 v = xr[64 * j]; const f32x4 g = ((const GAS f32x4*)gain)[lane + 64 * j]; v = v * rs * g; xr[64 * j] = v; }
    }
}
__global__ void __launch_bounds__(NWAVES * 64, 2) mega_fwd(Args args) {
    extern __shared__ __attribute__((aligned(16))) unsigned char lds[];
    Frame F;
    F.lds = (LAS unsigned char*)lds;
    F.MISC = (volatile LAS unsigned*)(F.lds + MISC_OFF);
    F.tid = threadIdx.x; F.lane = F.tid & 63; F.wave = __builtin_amdgcn_readfirstlane(F.tid >> 6);
    F.G = gridDim.x; { const int bx = blockIdx.x; F.vcu = (F.G % 8 == 0) ? (bx % 8) * (F.G / 8) + bx / 8 : bx; }
    unsigned char* ws = args.ws;
    F.ctl = (gu32*)(ws + WS_CTL);
    for (int u = F.tid; u < (LDS_BYTES - LDSCTL_OFF) / 4; u += NWAVES * 64) ((LAS unsigned*)(F.lds + LDSCTL_OFF))[u] = 0u;
    __syncthreads();
    XcdBarrier bar; bar.bar = (unsigned*)(F.ctl + CW_BAR); bar.x = 0; bar.st = nullptr;
    if (N_LAUNCHES != N_PHASES) bar = xcd_barrier_post((unsigned*)(F.ctl + CW_BAR), F.MISC + 8);
#define GRID_BAR() do { if (N_LAUNCHES == N_PHASES) { if (F.tid == 0) __hip_atomic_store(F.ctl + CW_TMO, 0xBADBA0u, RLX_AGENT); } else { xcd_barrier(bar); } } while (0)
    const int lo = args.ph_lo, hi = args.ph_hi;
#define IN(k) (lo <= (k) && (k) < hi)
#define BOTH(k) (IN(k) && IN((k) + 1))
    float* out = args.out;
    bf16* Wgu1 = (bf16*)(ws + WS_WGU1); bf16* Wd1 = (bf16*)(ws + WS_WD1); bf16* Win = (bf16*)(ws + WS_WIN); bf16* Wout = (bf16*)(ws + WS_WOUT);
    bf16* Wgu2 = (bf16*)(ws + WS_WGU2); bf16* Wd2 = (bf16*)(ws + WS_WD2); bf16* Wpg = (bf16*)(ws + WS_WPG); bf16* Wpp = (bf16*)(ws + WS_WPP);
    float* ssq1 = (float*)(ws + WS_SSQ1); float* ssq2 = (float*)(ws + WS_SSQ2); float* ssq3 = (float*)(ws + WS_SSQ3); float* ssq4 = (float*)(ws + WS_SSQ4); float* ssq5 = (float*)(ws + WS_SSQ5);
    bf16* kmean = (bf16*)(ws + WS_KMEAN);
    bf16* hb = (bf16*)(ws + WS_HB); float* dSb = (float*)(ws + WS_HB); bf16* Sst = (bf16*)(ws + WS_HB + 8 * MiB); float* decb = (float*)(ws + WS_HB + 12 * MiB); bf16* pb = (bf16*)(ws + WS_PB); bf16* mix = (bf16*)(ws + WS_MIX); bf16* xb = (bf16*)(ws + WS_MIX);
    bf16* U = (bf16*)(ws + WS_U); bf16* hmid = (bf16*)(ws + WS_U); float* loga = (float*)(ws + WS_LOGA); bf16* pp = (bf16*)(ws + WS_PP);
    using pg8::Gemm; using pg8::StaticOrder;
#define RUN_GEMM(EPI, A_, B_, N_, K_, ...) do { Gemm g{A_, B_, M, N_, K_}; StaticOrder S; S.init(M, N_, F.G, (int)blockIdx.x); pg8::EPI E{__VA_ARGS__}; \
        pg8::gemm_phase<pg8::EPI, StaticOrder, PG8_ALIGN, PG8_SP2>(F.lds + RING_OFF, g, S, E); } while (0)

    if (IN(0)) { p0_prologue(F, args); if (BOTH(0)) GRID_BAR(); }
    if (IN(1)) { RUN_GEMM(EpiSwiGLU, xb, Wgu1, NGU, D, hmid, FF, ssq1); if (BOTH(1)) GRID_BAR(); }
    if (IN(2)) { RUN_GEMM(EpiResid<1>, hmid, Wd1, D, FF, args.in[0], out, hb, ssq2); if (BOTH(2)) GRID_BAR(); }
    if (IN(3)) { RUN_GEMM(EpiWin, hb, Win, UWID, D, U, loga, ssq2, args.in[8]); if (BOTH(3)) GRID_BAR(); }
    if (IN(4)) { moba_kmean(F, U, kmean); gla_A(F, U, loga, dSb, decb); if (BOTH(4)) GRID_BAR(); }
    if (IN(5)) { gla_scan(F, dSb, decb, Sst); moba_phase(F, U, kmean, args.in[17], mix); if (BOTH(5)) GRID_BAR(); }
    if (IN(6)) { gla_C(F, U, loga, Sst, args.in[9], mix); if (BOTH(6)) GRID_BAR(); }
    if (IN(7)) { RUN_GEMM(EpiResid<0>, mix, Wout, D, D, out, out, hb, ssq3); if (BOTH(7)) GRID_BAR(); }
    if (IN(8)) { RUN_GEMM(EpiPlain, pb, Wpp, D, DPLE, pp); if (BOTH(8)) GRID_BAR(); }
    if (IN(9)) { RUN_GEMM(EpiSwiGLU, hb, Wgu2, NGU, D, hmid, FF, ssq3); if (BOTH(9)) GRID_BAR(); }
    if (IN(10)) { RUN_GEMM(EpiResid<1>, hmid, Wd2, D, FF, out, out, hb, ssq4); if (BOTH(10)) GRID_BAR(); }
    if (IN(11)) { RUN_GEMM(EpiPle, hb, Wpg, D, D, out, out, pp, ssq4, ssq5); if (BOTH(11)) GRID_BAR(); }
    if (IN(12)) { final_norm(F, out, ssq5, args.in[18]); }
#undef IN
#undef BOTH
}

extern "C" void kernel_launch(void* const* d_in, const int* in_sizes, int n_in, void* d_out, int out_size, void* d_ws, size_t ws_size, hipStream_t stream) {
    static int grid = 0;
    if (grid == 0) {
        if (n_in != 19 || in_sizes[0] != M * D || out_size != M * D || ws_size < WS_END) { fprintf(stderr, "kernel_launch: unexpected shapes (n_in %d, in0 %d, out %d, ws %zu); nothing launched\n", n_in, n_in > 0 ? in_sizes[0] : -1, out_size, ws_size); grid = -1; return; }
        int dev = 0, cus = 0, per_cu = 0;
        if (hipGetDevice(&dev) != hipSuccess || hipDeviceGetAttribute(&cus, hipDeviceAttributeMultiprocessorCount, dev) != hipSuccess) { grid = -1; return; }
        if (hipFuncSetAttribute((const void*)mega_fwd, hipFuncAttributeMaxDynamicSharedMemorySize, LDS_BYTES) != hipSuccess) { fprintf(stderr, "kernel_launch: hipFuncSetAttribute failed\n"); grid = -1; return; }
        if (hipOccupancyMaxActiveBlocksPerMultiprocessor(&per_cu, (const void*)mega_fwd, NWAVES * 64, LDS_BYTES) != hipSuccess || per_cu < 1) { fprintf(stderr, "kernel_launch: occupancy query reports %d workgroups per CU\n", per_cu); }
        (void)hipGetLastError();
        grid = cus;
    }
    if (grid < 0) return;
    if (hipMemsetAsync((char*)d_ws + WS_CTL, 0, CTL_ZERO_BYTES, stream) != hipSuccess) { fprintf(stderr, "kernel_launch: hipMemsetAsync failed\n"); return; }
    Args a{};
    for (int i = 0; i < 19; ++i) a.in[i] = (const float*)d_in[i];
    a.out = (float*)d_out; a.ws = (unsigned char*)d_ws;
    for (int li = 0; li < N_LAUNCHES; ++li) {
        if (N_LAUNCHES == 1) { a.ph_lo = 0; a.ph_hi = N_PHASES; } else { a.ph_lo = li; a.ph_hi = li + 1; }
        a.li = li;
        hipLaunchKernelGGL(mega_fwd, dim3(grid), dim3(NWAVES * 64), LDS_BYTES, stream, a);
        const hipError_t le = hipPeekAtLastError();
        if (le != hipSuccess) { fprintf(stderr, "kernel_launch: launch %d failed: %s\n", li, hipGetErrorName(le)); break; }
    }
}
```

```cpp
#include <hip/hip_runtime.h>
#include <cstdio>
#include <cstdint>
namespace pg8 {
#define PG8_LAS __attribute__((address_space(3)))
typedef unsigned short bf16_t;
typedef short bf16x8 __attribute__((ext_vector_type(8)));
typedef float f32x4 __attribute__((ext_vector_type(4)));
typedef unsigned u32x4 __attribute__((ext_vector_type(4)));
constexpr int BM = 256, BK = 64, HALF = 128, HTB = HALF * BK * 2  , STAGE_BYTES = 8 * HTB, NXCD = 8, WGM = 8;

__host__ __device__ __forceinline__ int lds_byte(int r, int c) { const int st = (r >> 4) * 2 + (c >> 5), rr = r & 15, cc = c & 31, ob = rr * 64 + cc * 2; return st * 1024 + (ob ^ (((ob >> 9) & 1) << 5)); }
__host__ __device__ __forceinline__ void stage_rc(int b, int& R, int& C) { const int st = b / 1024, sb = b % 1024, swz = sb ^ (((sb >> 9) & 1) << 5); R = (st >> 1) * 16 + swz / 64; C = (st & 1) * 32 + (swz % 64) / 2; }
__host__ __device__ __forceinline__ int perm32(int rho) { const int n = rho >> 4, i = rho & 15; return 8 * (i >> 2) + 4 * n + (i & 3); }

struct Unit { int pm, pn; };
struct Gemm { const bf16_t* A; const bf16_t* Bt; int M, N, K; };

struct StaticOrder {
    int nM, nN, nwg, G, c;
    __host__ __device__ void init(int M, int N, int G_, int c_) { nM = M / BM; nN = N / BM; nwg = nM * nN; G = G_; c = c_; }
    __host__ __device__ bool next(int i, Unit& u) const {
        const long L = (long)i * G + c; if (L >= nwg) return false;
        int wgid = (int)L; { const int q = nwg / NXCD, r = nwg % NXCD, xcd = wgid % NXCD, off = wgid / NXCD; wgid = (xcd < r ? xcd * (q + 1) : r * (q + 1) + (xcd - r) * q) + off; }
        const int nig = WGM * nN, gid = wgid / nig, fm = gid * WGM, gsz = (nM - fm) < WGM ? (nM - fm) : WGM;
        u.pm = fm + ((wgid % nig) % gsz); u.pn = (wgid % nig) / gsz; return true;
    }
    __device__ __forceinline__ void a_ready(const Unit&) const {}
    __device__ __forceinline__ void done(const Unit&) const {}
};

__device__ __forceinline__ unsigned cvt_pk_bf16(float lo, float hi) { unsigned r; asm volatile("v_cvt_pk_bf16_f32 %0, %1, %2" : "=v"(r) : "v"(lo), "v"(hi)); return r; }
__device__ __forceinline__ float bf_lo(unsigned w) { return __uint_as_float(w << 16); }
__device__ __forceinline__ float bf_hi(unsigned w) { return __uint_as_float(w & 0xffff0000u); }
constexpr float RMS_EPS = 1e-6f;
__device__ __forceinline__ float row_rstd(const float* ssqp, int r, int fq) {
    const f32x4 p = *(const f32x4*)(ssqp + (size_t)r * 16 + 4 * fq);
    float s = (p[0] + p[1]) + (p[2] + p[3]);
    s += __shfl_xor(s, 16); s += __shfl_xor(s, 32);
    return __builtin_amdgcn_rsqf(s * (1.0f / 1024.0f) + RMS_EPS);
}
__device__ __forceinline__ float fast_sigmoid(float x) { return __builtin_amdgcn_rcpf(1.0f + __builtin_amdgcn_exp2f(-1.4426950408889634f * x)); }
struct EpiSwiGLU {
    static constexpr bool PERM = true, AFTER_DRAIN = false;
    bf16_t* O; int ldc; const float* ssqp;
    __device__ __forceinline__ void operator()(const f32x4 (&acc)[2][2][4][2], const Unit& u, int wr, int wc, int fr, int fq) const {
        const int row0 = u.pm * BM + wr * 64 + fr, col0 = u.pn * HALF + wc * 32 + 8 * fq;
#pragma unroll
        for (int ai = 0; ai < 2; ++ai)
#pragma unroll
            for (int m = 0; m < 4; ++m) { const int r = row0 + ai * HALF + m * 16; const float rs = row_rstd(ssqp, r, fq);
                float h[8];
#pragma unroll
                for (int n = 0; n < 2; ++n)
#pragma unroll
                    for (int j = 0; j < 4; ++j) { const float g = acc[ai][0][m][n][j] * rs, up = acc[ai][1][m][n][j] * rs; h[n * 4 + j] = g * fast_sigmoid(g) * up; }
                u32x4 w; w.x = cvt_pk_bf16(h[0], h[1]); w.y = cvt_pk_bf16(h[2], h[3]); w.z = cvt_pk_bf16(h[4], h[5]); w.w = cvt_pk_bf16(h[6], h[7]);
                *(u32x4*)(O + (size_t)r * ldc + col0) = w; }
    }
};
template <int HALF_ALPHA> struct EpiResid {
    static constexpr bool PERM = true, AFTER_DRAIN = false; static constexpr float alpha = HALF_ALPHA ? 0.5f : 1.0f;
    const float* base; float* out; bf16_t* ob; float* ssq_out;
    __device__ __forceinline__ void operator()(const f32x4 (&acc)[2][2][4][2], const Unit& u, int wr, int wc, int fr, int fq) const {
        const int row0 = u.pm * BM + wr * 64 + fr, col0 = u.pn * BM + wc * 32 + 8 * fq;
#pragma unroll
        for (int ai = 0; ai < 2; ++ai)
#pragma unroll
            for (int m = 0; m < 4; ++m) { const int r = row0 + ai * HALF + m * 16; float ss = 0.f;
#pragma unroll
                for (int bj = 0; bj < 2; ++bj) { const size_t off = (size_t)r * 1024 + col0 + bj * HALF;
                    const f32x4 b0 = *(const f32x4*)(base + off), b1 = *(const f32x4*)(base + off + 4);
                    const f32x4 v0 = b0 + acc[ai][bj][m][0] * alpha, v1 = b1 + acc[ai][bj][m][1] * alpha;
                    *(f32x4*)(out + off) = v0; *(f32x4*)(out + off + 4) = v1;
                    u32x4 w; w.x = cvt_pk_bf16(v0[0], v0[1]); w.y = cvt_pk_bf16(v0[2], v0[3]); w.z = cvt_pk_bf16(v1[0], v1[1]); w.w = cvt_pk_bf16(v1[2], v1[3]);
                    *(u32x4*)(ob + off) = w;
                    ss += (v0[0] * v0[0] + v0[1] * v0[1]) + (v0[2] * v0[2] + v0[3] * v0[3]) + (v1[0] * v1[0] + v1[1] * v1[1]) + (v1[2] * v1[2] + v1[3] * v1[3]); }
                ss += __shfl_xor(ss, 16); ss += __shfl_xor(ss, 32);
                if (fq == 0) ssq_out[(size_t)r * 16 + 4 * u.pn + wc] = ss; }
    }
};
constexpr int UW = 3328;
struct EpiWin {
    static constexpr bool PERM = true, AFTER_DRAIN = false;
    bf16_t* U; float* loga; const float* ssqp; const float* bgk;
    __device__ __forceinline__ void operator()(const f32x4 (&acc)[2][2][4][2], const Unit& u, int wr, int wc, int fr, int fq) const {
        const int row0 = u.pm * BM + wr * 64 + fr, cl0 = wc * 32 + 8 * fq;
        const float sc = (u.pn == 0) ? 0.125f : 1.0f;
#pragma unroll
        for (int ai = 0; ai < 2; ++ai)
#pragma unroll
            for (int m = 0; m < 4; ++m) { const int r = row0 + ai * HALF + m * 16; const float rs = row_rstd(ssqp, r, fq);
#pragma unroll
                for (int bj = 0; bj < 2; ++bj) { const int cl = cl0 + bj * HALF;
                    const f32x4 v0 = acc[ai][bj][m][0] * rs, v1 = acc[ai][bj][m][1] * rs;
                    if (u.pn == 6) {
                        const f32x4 c0 = *(const f32x4*)(bgk + cl), c1 = *(const f32x4*)(bgk + cl + 4); f32x4 o0, o1;
#pragma unroll
                        for (int j = 0; j < 4; ++j) { const float x0 = v0[j] + c0[j], x1 = v1[j] + c1[j];
                            o0[j] = (fminf(x0, 0.f) - log1pf(__expf(-fabsf(x0)))) * (1.0f / 16.0f); o1[j] = (fminf(x1, 0.f) - log1pf(__expf(-fabsf(x1)))) * (1.0f / 16.0f); }
                        *(f32x4*)(loga + (size_t)r * 256 + cl) = o0; *(f32x4*)(loga + (size_t)r * 256 + cl + 4) = o1;
                    } else {
                        u32x4 w; w.x = cvt_pk_bf16(v0[0] * sc, v0[1] * sc); w.y = cvt_pk_bf16(v0[2] * sc, v0[3] * sc); w.z = cvt_pk_bf16(v1[0] * sc, v1[1] * sc); w.w = cvt_pk_bf16(v1[2] * sc, v1[3] * sc);
                        *(u32x4*)(U + (size_t)r * UW + u.pn * BM + cl) = w; } } }
    }
};
struct EpiPlain {
    static constexpr bool PERM = true, AFTER_DRAIN = false;
    bf16_t* O;
    __device__ __forceinline__ void operator()(const f32x4 (&acc)[2][2][4][2], const Unit& u, int wr, int wc, int fr, int fq) const {
        const int row0 = u.pm * BM + wr * 64 + fr, col0 = u.pn * BM + wc * 32 + 8 * fq;
#pragma unroll
        for (int ai = 0; ai < 2; ++ai)
#pragma unroll
            for (int m = 0; m < 4; ++m) { const int r = row0 + ai * HALF + m * 16;
#pragma unroll
                for (int bj = 0; bj < 2; ++bj) { const f32x4 v0 = acc[ai][bj][m][0], v1 = acc[ai][bj][m][1];
                    u32x4 w; w.x = cvt_pk_bf16(v0[0], v0[1]); w.y = cvt_pk_bf16(v0[2], v0[3]); w.z = cvt_pk_bf16(v1[0], v1[1]); w.w = cvt_pk_bf16(v1[2], v1[3]);
                    *(u32x4*)(O + (size_t)r * 1024 + col0 + bj * HALF) = w; } }
    }
};
struct EpiPle {
    static constexpr bool PERM = true, AFTER_DRAIN = false;
    const float* base; float* out; const bf16_t* pp; const float* ssqp; float* ssq_out;
    __device__ __forceinline__ void operator()(const f32x4 (&acc)[2][2][4][2], const Unit& u, int wr, int wc, int fr, int fq) const {
        const int row0 = u.pm * BM + wr * 64 + fr, col0 = u.pn * BM + wc * 32 + 8 * fq;
#pragma unroll
        for (int ai = 0; ai < 2; ++ai)
#pragma unroll
            for (int m = 0; m < 4; ++m) { const int r = row0 + ai * HALF + m * 16; const float rs = row_rstd(ssqp, r, fq); float ss = 0.f;
#pragma unroll
                for (int bj = 0; bj < 2; ++bj) { const size_t off = (size_t)r * 1024 + col0 + bj * HALF;
                    const f32x4 b0 = *(const f32x4*)(base + off), b1 = *(const f32x4*)(base + off + 4);
                    const u32x4 pw = *(const u32x4*)(pp + off);
                    f32x4 v0, v1;
                    v0[0] = b0[0] + fast_sigmoid(acc[ai][bj][m][0][0] * rs) * bf_lo(pw.x); v0[1] = b0[1] + fast_sigmoid(acc[ai][bj][m][0][1] * rs) * bf_hi(pw.x);
                    v0[2] = b0[2] + fast_sigmoid(acc[ai][bj][m][0][2] * rs) * bf_lo(pw.y); v0[3] = b0[3] + fast_sigmoid(acc[ai][bj][m][0][3] * rs) * bf_hi(pw.y);
                    v1[0] = b1[0] + fast_sigmoid(acc[ai][bj][m][1][0] * rs) * bf_lo(pw.z); v1[1] = b1[1] + fast_sigmoid(acc[ai][bj][m][1][1] * rs) * bf_hi(pw.z);
                    v1[2] = b1[2] + fast_sigmoid(acc[ai][bj][m][1][2] * rs) * bf_lo(pw.w); v1[3] = b1[3] + fast_sigmoid(acc[ai][bj][m][1][3] * rs) * bf_hi(pw.w);
                    *(f32x4*)(out + off) = v0; *(f32x4*)(out + off + 4) = v1;
                    ss += (v0[0] * v0[0] + v0[1] * v0[1]) + (v0[2] * v0[2] + v0[3] * v0[3]) + (v1[0] * v1[0] + v1[1] * v1[1]) + (v1[2] * v1[2] + v1[3] * v1[3]); }
                ss += __shfl_xor(ss, 16); ss += __shfl_xor(ss, 32);
                if (fq == 0) ssq_out[(size_t)r * 16 + 4 * u.pn + wc] = ss; }
    }
};
template <class Epi, class Sched, bool ALIGN_EPI = false, bool SP2 = false>
__device__ __forceinline__ void gemm_phase(PG8_LAS unsigned char* lds, const Gemm g, const Sched& S, const Epi& E) {
    const int tid = threadIdx.x, wid = __builtin_amdgcn_readfirstlane(tid >> 6), lane = tid & 63, wr = wid >> 2, wc = wid & 3, fr = lane & 15, fq = lane >> 4;
    const int K = g.K, nt = K / BK;
    unsigned voffA[2], voffB[2];
#pragma unroll
    for (int i = 0; i < 2; ++i) { int R, C; stage_rc(tid * 16 + i * 8192, R, C); const int Rb = Epi::PERM ? ((R & ~31) + perm32(R & 31)) : R;
        voffA[i] = (unsigned)(R * K + C) * 2u; voffB[i] = (unsigned)(Rb * K + C) * 2u; }
    const size_t kstep = (size_t)(BK * 2);
    const size_t hstep = (size_t)HALF * K * 2;
    const size_t tstep = 2 * hstep;
    const unsigned ldsw = (unsigned)wid * 1024u;
    const int aoff = lds_byte(wr * 64 + fr, fq * 8), boff = lds_byte(wc * 32 + fr, fq * 8);
#define PG8_SA(b, h) (((b) * 2 + (h)) * HTB)
#define PG8_SB(b, h) ((4 + (b) * 2 + (h)) * HTB)
#define PG8_STAGE(bufoff, gbase, voff) do { _Pragma("unroll") for (int _i = 0; _i < 2; ++_i) \
        __builtin_amdgcn_global_load_lds((const unsigned*)((const char*)(gbase) + (voff)[_i]), (PG8_LAS unsigned*)(lds + (bufoff) + ldsw + _i * 8192), 16, 0, 0); } while (0)
#define PG8_LDA(dst, b, h) do { _Pragma("unroll") for (int m = 0; m < 4; ++m) _Pragma("unroll") for (int k = 0; k < 2; ++k) dst[m][k] = *(const PG8_LAS bf16x8*)(lds + PG8_SA(b, h) + aoff + m * 2048 + k * 1024); } while (0)
#define PG8_LDB(dst, b, h) do { _Pragma("unroll") for (int n = 0; n < 2; ++n) _Pragma("unroll") for (int k = 0; k < 2; ++k) dst[n][k] = *(const PG8_LAS bf16x8*)(lds + PG8_SB(b, h) + boff + n * 2048 + k * 1024); } while (0)
#define PG8_MMA(ai, bj, At, Bt) do { __builtin_amdgcn_s_setprio(1); _Pragma("unroll") for (int m = 0; m < 4; ++m) _Pragma("unroll") for (int n = 0; n < 2; ++n) _Pragma("unroll") for (int k = 0; k < 2; ++k) \
        acc[ai][bj][m][n] = __builtin_amdgcn_mfma_f32_16x16x32_bf16(Bt[n][k], At[m][k], acc[ai][bj][m][n], 0, 0, 0); __builtin_amdgcn_s_setprio(0); } while (0)
#define PG8_WAIT_V(n) asm volatile("s_waitcnt vmcnt(" #n ")" ::: "memory")
#define PG8_WAIT_L(n) asm volatile("s_waitcnt lgkmcnt(" #n ")" ::: "memory")
#define PG8_BAR __builtin_amdgcn_s_barrier()
#define PG8_SCHED __builtin_amdgcn_sched_barrier(0)
    Unit cur, nxt; int ui = 0;
    if (!S.next(0, cur)) return;
    f32x4 acc[2][2][4][2];
#pragma unroll
    for (int a = 0; a < 2; ++a)
#pragma unroll
        for (int b = 0; b < 2; ++b)
#pragma unroll
            for (int m = 0; m < 4; ++m)
#pragma unroll
                for (int n = 0; n < 2; ++n) acc[a][b][m][n] = (f32x4){0.f, 0.f, 0.f, 0.f};
    bf16x8 At[4][2], B0[2][2], B1[2][2];
    const char* cA = (const char*)g.A + (size_t)cur.pm * tstep; const char* cB = (const char*)g.Bt + (size_t)cur.pn * tstep;
    S.a_ready(cur);
    if constexpr (SP2) {
        PG8_STAGE(PG8_SB(0, 0), cB, voffB); PG8_STAGE(PG8_SB(0, 1), cB + hstep, voffB); PG8_STAGE(PG8_SA(0, 0), cA, voffA); PG8_STAGE(PG8_SA(0, 1), cA + hstep, voffA);
        if (wr == 1) PG8_BAR;
        PG8_WAIT_V(2); PG8_BAR;
        PG8_STAGE(PG8_SB(1, 0), cB + kstep, voffB); PG8_STAGE(PG8_SA(1, 0), cA + kstep, voffA); PG8_STAGE(PG8_SB(1, 1), cB + hstep + kstep, voffB);
        PG8_WAIT_V(6); PG8_BAR;
    } else {
        PG8_STAGE(PG8_SB(0, 0), cB, voffB); PG8_STAGE(PG8_SA(0, 0), cA, voffA); PG8_STAGE(PG8_SB(0, 1), cB + hstep, voffB); PG8_STAGE(PG8_SA(0, 1), cA + hstep, voffA);
        if (wr == 1) PG8_BAR;
        PG8_WAIT_V(4); PG8_BAR;
        PG8_STAGE(PG8_SB(1, 0), cB + kstep, voffB); PG8_STAGE(PG8_SA(1, 0), cA + kstep, voffA); PG8_STAGE(PG8_SB(1, 1), cB + hstep + kstep, voffB);
        PG8_WAIT_V(6); PG8_BAR;
    }
    for (;;) {
        const bool has_next = S.next(ui + 1, nxt);
        const char* nA = has_next ? (const char*)g.A + (size_t)nxt.pm * tstep : cA; const char* nB = has_next ? (const char*)g.Bt + (size_t)nxt.pn * tstep : cB;
        for (int t = 0; t < nt; t += 2) {
            const bool last = (t == nt - 2);
            const char* a1 = cA + (size_t)(t + 1) * kstep;
            const char* a2 = last ? nA : cA + (size_t)(t + 2) * kstep; const char* b2 = last ? nB : cB + (size_t)(t + 2) * kstep;
            const char* a3 = a2 + kstep; const char* b3 = b2 + kstep;
            if (last && has_next) S.a_ready(nxt);
            if constexpr (SP2) {
            PG8_LDB(B0, 0, 0); PG8_LDB(B1, 0, 1); PG8_SCHED; PG8_LDA(At, 0, 0); PG8_STAGE(PG8_SA(1, 1), a1 + hstep, voffA);
            PG8_WAIT_V(8); PG8_WAIT_L(0); PG8_BAR; PG8_MMA(0, 0, At, B0); PG8_MMA(0, 1, At, B1); PG8_BAR; PG8_SCHED;
            PG8_LDA(At, 0, 1); PG8_STAGE(PG8_SB(0, 0), b2, voffB); PG8_STAGE(PG8_SB(0, 1), b2 + hstep, voffB); PG8_STAGE(PG8_SA(0, 0), a2, voffA);
            PG8_WAIT_V(8); PG8_WAIT_L(0); PG8_BAR; PG8_MMA(1, 0, At, B0); PG8_MMA(1, 1, At, B1); PG8_BAR; PG8_SCHED;
            PG8_LDB(B0, 1, 0); PG8_LDB(B1, 1, 1); PG8_SCHED; PG8_LDA(At, 1, 0); PG8_STAGE(PG8_SA(0, 1), a2 + hstep, voffA);
            PG8_WAIT_V(8); PG8_WAIT_L(0); PG8_BAR; PG8_MMA(0, 0, At, B0); PG8_MMA(0, 1, At, B1); PG8_BAR; PG8_SCHED;
            PG8_LDA(At, 1, 1); PG8_STAGE(PG8_SB(1, 0), b3, voffB); PG8_STAGE(PG8_SB(1, 1), b3 + hstep, voffB); PG8_STAGE(PG8_SA(1, 0), a3, voffA);
            PG8_WAIT_V(8); PG8_WAIT_L(0); PG8_BAR; PG8_MMA(1, 0, At, B0); PG8_MMA(1, 1, At, B1); PG8_BAR; PG8_SCHED;
            } else {
            PG8_LDB(B0, 0, 0); PG8_SCHED; PG8_LDA(At, 0, 0); PG8_STAGE(PG8_SA(1, 1), a1 + hstep, voffA);
            PG8_WAIT_L(8); PG8_BAR; PG8_WAIT_L(0); PG8_MMA(0, 0, At, B0); PG8_BAR; PG8_SCHED;
            PG8_LDB(B1, 0, 1); PG8_STAGE(PG8_SB(0, 0), b2, voffB);
            PG8_BAR; PG8_WAIT_L(0); PG8_MMA(0, 1, At, B1); PG8_BAR;
            PG8_LDA(At, 0, 1); PG8_STAGE(PG8_SA(0, 0), a2, voffA);
            PG8_BAR; PG8_WAIT_L(0); PG8_MMA(1, 0, At, B0); PG8_BAR; PG8_SCHED;
            PG8_STAGE(PG8_SB(0, 1), b2 + hstep, voffB);
            PG8_WAIT_V(6); PG8_BAR; PG8_MMA(1, 1, At, B1); PG8_BAR;
            PG8_LDB(B0, 1, 0); PG8_SCHED; PG8_LDA(At, 1, 0); PG8_STAGE(PG8_SA(0, 1), a2 + hstep, voffA);
            PG8_WAIT_L(8); PG8_BAR; PG8_WAIT_L(0); PG8_MMA(0, 0, At, B0); PG8_BAR; PG8_SCHED;
            PG8_LDB(B1, 1, 1); PG8_STAGE(PG8_SB(1, 0), b3, voffB);
            PG8_BAR; PG8_WAIT_L(0); PG8_MMA(0, 1, At, B1); PG8_BAR;
            PG8_LDA(At, 1, 1); PG8_STAGE(PG8_SA(1, 0), a3, voffA);
            PG8_BAR; PG8_WAIT_L(0); PG8_MMA(1, 0, At, B0); PG8_BAR; PG8_SCHED;
            PG8_STAGE(PG8_SB(1, 1), b3 + hstep, voffB);
            PG8_WAIT_V(6); PG8_BAR; PG8_MMA(1, 1, At, B1); PG8_BAR;
            }
        }
        if constexpr (ALIGN_EPI) { if (wr == 0) PG8_BAR; }
        if constexpr (!Epi::AFTER_DRAIN) { E(acc, cur, wr, wc, fr, fq); S.done(cur); }
        if (!has_next) break;
#pragma unroll
        for (int a = 0; a < 2; ++a)
#pragma unroll
            for (int b = 0; b < 2; ++b)
#pragma unroll
                for (int m = 0; m < 4; ++m)
#pragma unroll
                    for (int n = 0; n < 2; ++n) acc[a][b][m][n] = (f32x4){0.f, 0.f, 0.f, 0.f};
        cur = nxt; cA = nA; cB = nB; ++ui;
        if constexpr (ALIGN_EPI) { if (wr == 1) PG8_BAR; }
    }
    PG8_WAIT_V(0);
    if constexpr (!ALIGN_EPI) { if (wr == 0) PG8_BAR; }
    PG8_BAR;
    if constexpr (Epi::AFTER_DRAIN) { E.fused(acc, cur, wr, wc, fr, fq, lds, wid, lane); S.done(cur); }
#undef PG8_SA
#undef PG8_SB
#undef PG8_STAGE
#undef PG8_LDA
#undef PG8_LDB
#undef PG8_MMA
#undef PG8_WAIT_V
#undef PG8_WAIT_L
#undef PG8_BAR
#undef PG8_SCHED
}
}
#ifndef PG8_SP2
#define PG8_SP2 true
#endif
#ifndef PG8_ALIGN
#define PG8_ALIGN true
#endif
constexpr int NWAVES = 8;
constexpr int N_PHASES = 13;
#ifndef MK_N_LAUNCHES
#define MK_N_LAUNCHES 1
#endif
constexpr int N_LAUNCHES = MK_N_LAUNCHES;

constexpr int M = 16384, D = 1024, FF = 2816, NGU = 2 * FF, DPLE = 256;
constexpr int GH = 4, GDK = 64, GDV = 128, MH = 8, MHD = 64, MBLK = 256, NBLK = M / MBLK;
constexpr int UWID = 3328;
constexpr int U_QG = 0, U_KG = 256, U_VG = 512, U_GG = 1024, U_QM = 1792, U_KM = 2304, U_VM = 2816;
constexpr float EPS = 1e-6f;

constexpr size_t MiB = 1u << 20;
constexpr size_t WS_CTL = 0, CTL_ZERO_BYTES = 1 * MiB;
constexpr size_t WS_WGU1 = 1 * MiB, WS_WD1 = 12 * MiB, WS_WIN = 18 * MiB, WS_WOUT = 25 * MiB, WS_WGU2 = 27 * MiB, WS_WD2 = 38 * MiB, WS_WPG = 44 * MiB, WS_WPP = 46 * MiB;
constexpr size_t WS_SSQ1 = 47 * MiB, WS_SSQ2 = 48 * MiB, WS_SSQ3 = 49 * MiB, WS_SSQ4 = 50 * MiB, WS_SSQ5 = 51 * MiB, WS_KMEAN = 52 * MiB;
constexpr size_t WS_HB = 54 * MiB;
constexpr size_t WS_PB = 86 * MiB;
constexpr size_t WS_MIX = 94 * MiB;
constexpr size_t WS_U = 126 * MiB;
constexpr size_t WS_LOGA = 230 * MiB;
constexpr size_t WS_PP = 214 * MiB;
constexpr size_t WS_END = 256 * MiB;
static_assert(WS_U + (size_t)M * UWID * 2 <= WS_LOGA && WS_LOGA + (size_t)M * 256 * 4 <= WS_END && WS_U + (size_t)M * FF * 2 <= WS_PP && WS_PP + (size_t)M * D * 2 <= WS_END, "d_ws map");
constexpr int CW_TMO = 0, CW_CODE = 1;
constexpr int CW_BAR = 4096;

constexpr int RING_OFF = 0, RING_BYTES = 131072;
constexpr int LDS_BYTES = 163840;
constexpr int LDSCTL_OFF = LDS_BYTES - 512, MISC_OFF = LDSCTL_OFF + 320;
#define GAS __attribute__((address_space(1)))
#define LAS __attribute__((address_space(3)))
typedef unsigned short bf16;
typedef unsigned v4u __attribute__((ext_vector_type(4)));
typedef float f32x4 __attribute__((ext_vector_type(4)));
typedef short bf16x8 __attribute__((ext_vector_type(8)));
typedef GAS unsigned gu32;
typedef GAS unsigned long long gu64;
#define RLX_AGENT __ATOMIC_RELAXED, __HIP_MEMORY_SCOPE_AGENT
#define LDS_WAIT() asm volatile("s_waitcnt lgkmcnt(0)" ::: "memory")
#define VM_WAIT() asm volatile("s_waitcnt vmcnt(0)" ::: "memory")
__device__ __forceinline__ unsigned long long rt() { return __builtin_amdgcn_s_memrealtime(); }
__device__ __forceinline__ unsigned f2bf(float f) { unsigned u = __builtin_bit_cast(unsigned, f); return (u + 0x7fffu + ((u >> 16) & 1u)) >> 16; }
__device__ __forceinline__ unsigned pk2(float lo, float hi) { return f2bf(lo) | (f2bf(hi) << 16); }

#define XB_TMO      128
#define XB_XCNT(j)  (256  + 64 * (j))
#define XB_XSUB(j)  (1280 + 64 * (j))
#define XB_XGEN(j)  (2304 + 64 * (j))
#define XB_TOP      3328
#define XB_TOPGEN   3392
#define XCD_BAR_WORDS 3456
#define XB_SPIN_CAP (1u << 18)

__device__ __forceinline__ unsigned xb_ld(unsigned* p)              { return __hip_atomic_load(p, __ATOMIC_RELAXED, __HIP_MEMORY_SCOPE_AGENT); }
__device__ __forceinline__ unsigned xb_add(unsigned* p, unsigned v) { return __hip_atomic_fetch_add(p, v, __ATOMIC_RELAXED, __HIP_MEMORY_SCOPE_AGENT); }
__device__ __forceinline__ unsigned xb_xcc_id() { return (unsigned)__builtin_amdgcn_s_getreg((3 << 11) | 20) & 0xFu; }
#define XB_SPIN(cond, bar) do { unsigned _sp = 0; while (cond) { __builtin_amdgcn_s_sleep(1); \
    if ((++_sp & 255u) == 0u) { if (xb_ld(&(bar)[XB_TMO])) break; if (_sp > XB_SPIN_CAP) { atomicAdd(&(bar)[XB_TMO], 1u); break; } } } } while (0)

struct XcdBarrier {
    unsigned* bar; unsigned x;
    volatile LAS unsigned* st;
};

__device__ __forceinline__ XcdBarrier xcd_barrier_post(unsigned* bar, volatile LAS unsigned* st) {
    XcdBarrier b; b.bar = bar; b.x = xb_xcc_id(); b.st = st;
    if (threadIdx.x == 0) (void)xb_add(&bar[XB_XCNT(b.x)], 1u);
    return b;
}
__device__ __forceinline__ void xcd_barrier_complete(unsigned* bar, unsigned x, unsigned& nloc, unsigned& nx) {
    const unsigned G = gridDim.x * gridDim.y * gridDim.z;
    unsigned sum, cnt, mine, sp = 0u;
    for (;;) {
        sum = 0u; cnt = 0u; mine = 0u;
#pragma unroll
        for (unsigned j = 0; j < 16; ++j) { const unsigned c = xb_ld(&bar[XB_XCNT(j)]); sum += c; cnt += (c > 0u) ? 1u : 0u; mine = (j == x) ? c : mine; }
        if (sum == G) break;
        __builtin_amdgcn_s_sleep(1);
        if ((++sp & 255u) == 0u) { if (xb_ld(&bar[XB_TMO])) break; if (sp > XB_SPIN_CAP) { atomicAdd(&bar[XB_TMO], 1u); break; } }
    }
    nloc = mine > 0u ? mine : 1u; nx = cnt > 0u ? cnt : 1u;
}

__device__ __forceinline__ void xcd_barrier(const XcdBarrier& b) {
    asm volatile("s_waitcnt vmcnt(0)" ::: "memory");
    __syncthreads();
    if (threadIdx.x == 0) {
        unsigned* bar = b.bar;
        __builtin_amdgcn_s_waitcnt(0);
        unsigned nloc = b.st[0], nx = b.st[1];
        if (nloc == 0u) { xcd_barrier_complete(bar, b.x, nloc, nx); b.st[0] = nloc; b.st[1] = nx; }
        const unsigned old = xb_add(&bar[XB_XSUB(b.x)], 1u);
        const unsigned gen = old / nloc;
        if (old + 1u == (gen + 1u) * nloc) {
            __builtin_amdgcn_fence(__ATOMIC_RELEASE, "agent");
            asm volatile("s_waitcnt vmcnt(0)" ::: "memory");
            const unsigned og = xb_add(&bar[XB_TOP], 1u);
            const unsigned tg = og / nx;
            if (og + 1u == (tg + 1u) * nx) xb_add(&bar[XB_TOPGEN], 1u);
            else XB_SPIN(xb_ld(&bar[XB_TOPGEN]) == tg, bar);
            __builtin_amdgcn_fence(__ATOMIC_ACQUIRE, "agent");
            xb_add(&bar[XB_XGEN(b.x)], 1u);
            asm volatile("s_waitcnt vmcnt(0)" ::: "memory");
        } else {
            XB_SPIN(xb_ld(&bar[XB_XGEN(b.x)]) == gen, bar);
            __builtin_amdgcn_fence(__ATOMIC_ACQUIRE, "agent");
            asm volatile("s_waitcnt vmcnt(0)" ::: "memory");
        }
    }
    __syncthreads();
}
struct Frame {
    LAS unsigned char* lds;
    volatile LAS unsigned* MISC;
    gu32* ctl;
    int tid, lane, wave;
    int vcu, G;
};
__device__ __forceinline__ int fresh_lane() { int l; asm volatile("v_mbcnt_lo_u32_b32 %0, -1, 0\n\tv_mbcnt_hi_u32_b32 %0, -1, %0" : "=v"(l)); return l; }
__device__ __forceinline__ float wave_sum(float v) {
#pragma unroll
    for (int o = 1; o < 64; o <<= 1) v += __shfl_xor(v, o);
    return v;
}
__device__ __forceinline__ float wave_max(float v) {
#pragma unroll
    for (int o = 1; o < 64; o <<= 1) v = fmaxf(v, __shfl_xor(v, o));
    return v;
}
__device__ __forceinline__ float bf2f(bf16 h) { return __uint_as_float((unsigned)h << 16); }
__device__ __forceinline__ float bf_lo2(unsigned w) { return __uint_as_float(w << 16); }
__device__ __forceinline__ float bf_hi2(unsigned w) { return __uint_as_float(w & 0xffff0000u); }

__device__ __forceinline__ void tr_store(bf16* WT, int K, int k0, int n0dst, LAS float* scr, int lane) {
    LDS_WAIT(); asm volatile("" ::: "memory");
    const int c = lane & 7;
#pragma unroll
    for (int j = 0; j < 4; ++j) { const int n = (lane >> 3) + 8 * j; const LAS float* s = scr + (8 * c) * 33 + n;
        v4u o; o.x = pk2(s[0 * 33], s[1 * 33]); o.y = pk2(s[2 * 33], s[3 * 33]); o.z = pk2(s[4 * 33], s[5 * 33]); o.w = pk2(s[6 * 33], s[7 * 33]);
        *(GAS v4u*)(WT + (size_t)(n0dst + n) * K + k0 + 8 * c) = o; }
    LDS_WAIT(); asm volatile("" ::: "memory");
}
__device__ __forceinline__ void tr_item(const float* W, int K, int N, const float* gain, bf16* WT, int k0, int n0dst, int c0src, LAS float* scr, int lane) {
#pragma unroll 8
    for (int i = 0; i < 32; ++i) { const int kk = 2 * i + (lane >> 5); const float g = gain ? gain[k0 + kk] : 1.0f;
        scr[kk * 33 + (lane & 31)] = W[(size_t)(k0 + kk) * N + c0src + (lane & 31)] * g; }
    tr_store(WT, K, k0, n0dst, scr, lane);
}
__device__ __forceinline__ void tr_item_gk(const float* Win, const float* Wup, const float* gain, bf16* WT, int k0, int j0, LAS float* scr, int lane) {
    for (int i = 0; i < 32; ++i) { const int kk = 2 * i + (lane >> 5), k = k0 + kk, j = j0 + (lane & 31); float a = 0.f;
#pragma unroll
        for (int r = 0; r < 16; ++r) a += Win[(size_t)k * 3088 + 1536 + r] * Wup[r * 256 + j];
        scr[kk * 33 + (lane & 31)] = a * gain[k]; }
    tr_store(WT, 1024, k0, 1536 + j0, scr, lane);
}
struct Args { const float* in[19]; float* out; unsigned char* ws; int ph_lo, ph_hi, li, pad; };

__device__ __forceinline__ void p0_prologue(Frame& F, const Args& A) {
    LAS float* scr = (LAS float*)(F.lds + RING_OFF + F.wave * 16384);
    unsigned char* ws = A.ws;
    const int gw = F.vcu * NWAVES + F.wave, NGW = F.G * NWAVES, lane = fresh_lane();
    constexpr int I_GU = 16 * 176, I_D = 44 * 32, I_IN = 16 * 104, I_O = 16 * 32, I_PP = 4 * 32;
    constexpr int NITEMS = 2 * I_GU + 2 * I_D + I_IN + 2 * I_O + I_PP;
    for (int it = gw; it < NITEMS; it += NGW) {
        int r = it;
        if (r < 2 * I_GU) { const int which = r / I_GU; r -= which * I_GU; const int kb = r / 176, nb = r % 176, t = nb >> 3, g = nb & 7;
            const int src = (g < 4) ? (128 * t + 32 * g) : (FF + 128 * t + 32 * (g - 4));
            tr_item(A.in[which ? 12 : 3], D, NGU, A.in[which ? 11 : 2], (bf16*)(ws + (which ? WS_WGU2 : WS_WGU1)), 64 * kb, 32 * nb, src, scr, lane); continue; } r -= 2 * I_GU;
        if (r < 2 * I_D) { const int which = r / I_D; r -= which * I_D; const int kb = r / 32, nb = r % 32;
            tr_item(A.in[which ? 13 : 4], FF, D, nullptr, (bf16*)(ws + (which ? WS_WD2 : WS_WD1)), 64 * kb, 32 * nb, 32 * nb, scr, lane); continue; } r -= 2 * I_D;
        if (r < I_IN) { const int kb = r / 104, nb = r % 104;
            if (nb >= 48 && nb < 56) tr_item_gk(A.in[6], A.in[7], A.in[5], (bf16*)(ws + WS_WIN), 64 * kb, 32 * (nb - 48), scr, lane);
            else tr_item(A.in[6], D, 3088, A.in[5], (bf16*)(ws + WS_WIN), 64 * kb, 32 * nb, nb < 48 ? 32 * nb : 32 * nb - 240, scr, lane);
            continue; } r -= I_IN;
        if (r < 2 * I_O) { const int which = r / I_O; r -= which * I_O; const int kb = r / 32, nb = r % 32;
            tr_item(A.in[which ? 15 : 10], D, D, which ? A.in[14] : nullptr, (bf16*)(ws + (which ? WS_WPG : WS_WOUT)), 64 * kb, 32 * nb, 32 * nb, scr, lane); continue; } r -= 2 * I_O;
        { const int kb = r / 32, nb = r % 32; tr_item(A.in[16], DPLE, D, nullptr, (bf16*)(ws + WS_WPP), 64 * kb, 32 * nb, 32 * nb, scr, lane); }
    }
    const float* x = A.in[0]; const float* p = A.in[1];
    bf16* xb = (bf16*)(ws + WS_MIX); bf16* pb = (bf16*)(ws + WS_PB); float* ssq1 = (float*)(ws + WS_SSQ1);
    for (int m = gw; m < M; m += NGW) {
        const GAS f32x4* xr = (const GAS f32x4*)(x + (size_t)m * D) + lane; f32x4 v[4]; float s = 0.f;
#pragma unroll
        for (int j = 0; j < 4; ++j) { v[j] = xr[64 * j]; s += (v[j].x * v[j].x + v[j].y * v[j].y) + (v[j].z * v[j].z + v[j].w * v[j].w); }
        s = wave_sum(s);
        GAS unsigned long long* o8 = (GAS unsigned long long*)(xb + (size_t)m * D) + lane;
#pragma unroll
        for (int j = 0; j < 4; ++j) o8[64 * j] = (unsigned long long)pk2(v[j].x, v[j].y) | ((unsigned long long)pk2(v[j].z, v[j].w) << 32);
        if (lane < 16) ssq1[(size_t)m * 16 + lane] = (lane == 0) ? s : 0.f;
        const f32x4 pv = ((const GAS f32x4*)(p + (size_t)m * DPLE))[lane];
        ((GAS unsigned long long*)(pb + (size_t)m * DPLE))[lane] = (unsigned long long)pk2(pv.x, pv.y) | ((unsigned long long)pk2(pv.z, pv.w) << 32);
    }
}

__device__ __forceinline__ void moba_kmean(Frame& F, const bf16* U, bf16* kmean) {
    const int gw = F.vcu * NWAVES + F.wave, NGW = F.G * NWAVES, lane = fresh_lane();
    for (int u = gw; u < MH * NBLK; u += NGW) { const int h = u / NBLK, n = u % NBLK; float s = 0.f;
        const bf16* kp = U + (size_t)(n * MBLK) * UWID + U_KM + h * MHD + lane;
#pragma unroll 8
        for (int r = 0; r < MBLK; ++r) s += bf2f(kp[(size_t)r * UWID]);
        kmean[(size_t)u * 64 + lane] = (bf16)f2bf(s * (1.0f / MBLK)); }
}
__device__ __forceinline__ int rel_bucket(int n) { return n < 16 ? n : min(31, 16 + (31 - __clz(n * n)) - 8); }
typedef float f32x16 __attribute__((ext_vector_type(16)));
typedef short v4i16_t __attribute__((ext_vector_type(4)));
__device__ __forceinline__ f32x16 mfma32(bf16x8 a, bf16x8 b, f32x16 c) { return __builtin_amdgcn_mfma_f32_32x32x16_bf16(a, b, c, 0, 0, 0); }
__device__ __forceinline__ v4i16_t lds_tr(LAS unsigned char* p) { return __builtin_amdgcn_ds_read_tr16_b64_v4i16((LAS v4i16_t*)p); }
__device__ __forceinline__ unsigned cvtpk(float lo, float hi) { unsigned r; asm volatile("v_cvt_pk_bf16_f32 %0, %1, %2" : "=v"(r) : "v"(lo), "v"(hi)); return r; }
constexpr int MB_OACC = 0, MB_OP = 65, MB_LACC = 66560, MB_MREF = 67584, MB_CNT = 68608, MB_OFFS = 68864, MB_LIST = 69184, MB_NSEL = 70912, MB_VST = 71680, MB_VP = 144, MB_VSTW = 2 * 32 * MB_VP  , MB_BTAB = MB_VST + 8 * MB_VSTW, MB_NTAB = 3584;
static_assert(MB_BTAB + MB_NTAB * 4 <= LDSCTL_OFF, "MoBA LDS map");
constexpr float LOG2E = 1.4426950408889634f, MB_SC = 0.125f * LOG2E;

template <int MODE>
__device__ __forceinline__ void moba_tile(const bf16* U, int h, int n, int nchunks, int qpos, float& mref, LAS unsigned char* vst, LAS const float* rtab, bool nearblk, float cbias,
                                          f32x16& O0, f32x16& O1, float& lsum, int lane) {
    const int half = lane >> 5, l31 = lane & 31;
    bf16x8 qf[4];
    { const bf16* qp = U + (size_t)qpos * UWID + U_QM + h * 64 + 8 * half;
#pragma unroll
      for (int s = 0; s < 4; ++s) qf[s] = *(const bf16x8*)(qp + 16 * s); }
    const int r8 = lane >> 3, pc = lane & 7;
    const bf16* kp = U + (size_t)(n * MBLK + r8) * UWID + U_KM + h * 64 + pc * 8;
    const bf16* vp = U + (size_t)(n * MBLK + r8) * UWID + U_VM + h * 64 + pc * 8;
    LAS unsigned char* kst = vst + 32 * MB_VP;
    LAS unsigned char* vdst = vst + r8 * MB_VP + pc * 16;
    LAS unsigned char* kdst = kst + r8 * MB_VP + pc * 16;
    LAS const unsigned char* kfp = kst + l31 * MB_VP + 16 * half;
    LAS unsigned char* trb = vst + (4 * half + ((lane & 15) >> 2)) * MB_VP + (16 * ((lane >> 4) & 1) + 4 * (lane & 3)) * 2;
    const int jb = 3327 - qpos + n * MBLK + 4 * half;
    float m = -INFINITY;
    v4u kr[4], kn[4], vr[4], vn[4];
#pragma unroll
    for (int i = 0; i < 4; ++i) { kr[i] = *(const v4u*)(kp + (size_t)(8 * i) * UWID); kn[i] = kr[i]; }
    if (MODE != 0) {
#pragma unroll
        for (int i = 0; i < 4; ++i) { vr[i] = *(const v4u*)(vp + (size_t)(8 * i) * UWID); vn[i] = vr[i]; } }
    for (int ck = 0; ck < nchunks; ++ck) {
#pragma unroll
        for (int i = 0; i < 4; ++i) *(LAS v4u*)(kdst + 8 * i * MB_VP) = kr[i];
        if (MODE != 0) {
#pragma unroll
            for (int i = 0; i < 4; ++i) *(LAS v4u*)(vdst + 8 * i * MB_VP) = vr[i]; }
        if (ck + 1 < nchunks) {
#pragma unroll
            for (int i = 0; i < 4; ++i) kn[i] = *(const v4u*)(kp + (size_t)((ck + 1) * 32 + 8 * i) * UWID);
            if (MODE != 0) {
#pragma unroll
                for (int i = 0; i < 4; ++i) vn[i] = *(const v4u*)(vp + (size_t)((ck + 1) * 32 + 8 * i) * UWID); } }
        bf16x8 kf[4];
#pragma unroll
        for (int s = 0; s < 4; ++s) kf[s] = *(LAS const bf16x8*)(kfp + 32 * s);
        f32x16 S;
#pragma unroll
        for (int r = 0; r < 16; ++r) S[r] = 0.f;
#pragma unroll
        for (int s = 0; s < 4; ++s) S = mfma32(kf[s], qf[s], S);
        float bvv[16];
        if (nearblk) {
#pragma unroll
            for (int r = 0; r < 16; ++r) bvv[r] = rtab[jb + 32 * ck + (r & 3) + 8 * (r >> 2)];
        } else {
#pragma unroll
            for (int r = 0; r < 16; ++r) bvv[r] = cbias;
        }
#pragma unroll
        for (int r = 0; r < 16; ++r) { const int cr = (r & 3) + 8 * (r >> 2);
            float y = S[r] * MB_SC + bvv[r];
            if (MODE != 2) { const int dist = qpos - (n * MBLK + 32 * ck + 4 * half + cr); if (dist < 0) y = -INFINITY; }
            if (MODE == 0) m = fmaxf(m, y);
            else { const float p = __builtin_amdgcn_exp2f(y - mref); lsum += p; S[r] = p; } }
        if (MODE != 0) {
            bf16x8 pf0, pf1;
            { v4u w0, w1; w0.x = cvtpk(S[0], S[1]); w0.y = cvtpk(S[2], S[3]); w0.z = cvtpk(S[4], S[5]); w0.w = cvtpk(S[6], S[7]);
              w1.x = cvtpk(S[8], S[9]); w1.y = cvtpk(S[10], S[11]); w1.z = cvtpk(S[12], S[13]); w1.w = cvtpk(S[14], S[15]);
              pf0 = __builtin_bit_cast(bf16x8, w0); pf1 = __builtin_bit_cast(bf16x8, w1); }
#pragma unroll
            for (int sp = 0; sp < 2; ++sp)
#pragma unroll
                for (int dt = 0; dt < 2; ++dt) {
                    const v4i16_t lo = lds_tr(trb + sp * 16 * MB_VP + dt * 64), hi = lds_tr(trb + sp * 16 * MB_VP + dt * 64 + 8 * MB_VP);
                    const bf16x8 a = (bf16x8){lo[0], lo[1], lo[2], lo[3], hi[0], hi[1], hi[2], hi[3]};
                    if (dt == 0) O0 = mfma32(a, sp ? pf1 : pf0, O0); else O1 = mfma32(a, sp ? pf1 : pf0, O1); }
        }
#pragma unroll
        for (int i = 0; i < 4; ++i) kr[i] = kn[i];
        if (MODE != 0) {
#pragma unroll
            for (int i = 0; i < 4; ++i) vr[i] = vn[i]; }
    }
    if (MODE == 0) mref = fmaxf(m, __shfl_xor(m, 32));
}

typedef unsigned u32x2 __attribute__((ext_vector_type(2)));
#define MPARGS GAS bf16* Po00, GAS bf16* Po01, GAS bf16* Po10, GAS bf16* Po11, GAS bf16* Po20, GAS bf16* Po21, GAS float* Pl
#define MPPASS Po00, Po01, Po10, Po11, Po20, Po21, Pl
__device__ __forceinline__ void moba_unit(Frame& F, const bf16* U, const bf16* kmb, const float* relb, bf16* mix, MPARGS, int h, int b) {
    const int lane = fresh_lane(), wave = F.wave, half = lane >> 5, l31 = lane & 31, tid = wave * 64 + lane;
    LAS unsigned char* L = F.lds + RING_OFF;
    LAS float* oacc = (LAS float*)(L + MB_OACC); LAS float* lacc = (LAS float*)(L + MB_LACC); LAS float* mrefs = (LAS float*)(L + MB_MREF);
    LAS int* cnt = (LAS int*)(L + MB_CNT); LAS int* offs = (LAS int*)(L + MB_OFFS); LAS unsigned short* list = (LAS unsigned short*)(L + MB_LIST); LAS unsigned char* nsel = L + MB_NSEL;
    LAS unsigned char* vst = L + MB_VST + wave * MB_VSTW; LAS const float* rtab = (LAS const float*)(L + MB_BTAB);
    const float cbias = relb[31 * 8 + h] * LOG2E;
    if (tid < 64) cnt[tid] = 0;
    for (int j = tid; j < MB_NTAB; j += NWAVES * 64) { const int dist = 3327 - j; ((LAS float*)(L + MB_BTAB))[j] = relb[rel_bucket(dist < 0 ? 0 : dist) * 8 + h] * LOG2E; }
    __syncthreads();
    const int qi = wave * 32 + l31, qpos = b * MBLK + qi;
    float g0 = -INFINITY, g1 = -INFINITY, g2 = -INFINITY; int i0 = -1, i1 = -1, i2 = -1;
    if (b > 0) {
        bf16x8 qf[4];
        { const bf16* qp = U + (size_t)qpos * UWID + U_QM + h * 64 + 8 * half;
#pragma unroll
          for (int s = 0; s < 4; ++s) qf[s] = *(const bf16x8*)(qp + 16 * s); }
#pragma unroll
        for (int nt = 0; nt < 2; ++nt) if (32 * nt < b) {
            const bf16* ap = kmb + (size_t)(h * NBLK + 32 * nt + l31) * 64 + 8 * half;
            f32x16 G;
#pragma unroll
            for (int r = 0; r < 16; ++r) G[r] = 0.f;
#pragma unroll
            for (int s = 0; s < 4; ++s) G = mfma32(*(const bf16x8*)(ap + 16 * s), qf[s], G);
#pragma unroll
            for (int r = 0; r < 16; ++r) { const int nn = 32 * nt + (r & 3) + 8 * (r >> 2) + 4 * half; const float v = (nn < b) ? G[r] : -INFINITY;
                if (v > g0) { g2 = g1; i2 = i1; g1 = g0; i1 = i0; g0 = v; i0 = nn; }
                else if (v > g1) { g2 = g1; i2 = i1; g1 = v; i1 = nn; }
                else if (v > g2) { g2 = v; i2 = nn; } }
        }
        float pg[3]; int pi[3];
        pg[0] = __shfl_xor(g0, 32); pg[1] = __shfl_xor(g1, 32); pg[2] = __shfl_xor(g2, 32); pi[0] = __shfl_xor(i0, 32); pi[1] = __shfl_xor(i1, 32); pi[2] = __shfl_xor(i2, 32);
#pragma unroll
        for (int k = 0; k < 3; ++k) { const float v = pg[k]; const int nn = pi[k];
            if (nn >= 0) {
                if (v > g0 || (v == g0 && nn < i0)) { g2 = g1; i2 = i1; g1 = g0; i1 = i0; g0 = v; i0 = nn; }
                else if (v > g1 || (v == g1 && nn < i1)) { g2 = g1; i2 = i1; g1 = v; i1 = nn; }
                else if (v > g2 || (v == g2 && nn < i2)) { g2 = v; i2 = nn; } } }
    }
    int r0 = 0, r1 = 0, r2 = 0;
    if (half == 0) { if (i0 >= 0) r0 = __hip_atomic_fetch_add(cnt + i0, 1, __ATOMIC_RELAXED, __HIP_MEMORY_SCOPE_WORKGROUP); if (i1 >= 0) r1 = __hip_atomic_fetch_add(cnt + i1, 1, __ATOMIC_RELAXED, __HIP_MEMORY_SCOPE_WORKGROUP); if (i2 >= 0) r2 = __hip_atomic_fetch_add(cnt + i2, 1, __ATOMIC_RELAXED, __HIP_MEMORY_SCOPE_WORKGROUP); }
    __syncthreads();
    if (wave == 0) { const int c = cnt[lane]; int inc = c;
#pragma unroll
        for (int o = 1; o < 64; o <<= 1) { const int t = __shfl_up(inc, o); if (lane >= o) inc += t; }
        offs[lane] = inc - c; }
    __syncthreads();
    if (half == 0) { if (i0 >= 0) list[offs[i0] + r0] = (unsigned short)qi; if (i1 >= 0) list[offs[i1] + r1] = (unsigned short)(qi | 0x100); if (i2 >= 0) list[offs[i2] + r2] = (unsigned short)(qi | 0x200);
                      nsel[qi] = (unsigned char)((i0 >= 0) + (i1 >= 0) + (i2 >= 0)); }
    {
        float mref = 0.f, lsum = 0.f; f32x16 O0, O1;
#pragma unroll
        for (int r = 0; r < 16; ++r) { O0[r] = 0.f; O1[r] = 0.f; }
        moba_tile<0>(U, h, b, wave + 1, qpos, mref, vst, rtab, true, cbias, O0, O1, lsum, lane);
        moba_tile<1>(U, h, b, wave + 1, qpos, mref, vst, rtab, true, cbias, O0, O1, lsum, lane);
#pragma unroll
        for (int r = 0; r < 16; ++r) { const int d = (r & 3) + 8 * (r >> 2) + 4 * half; oacc[qi * MB_OP + d] = O0[r]; oacc[qi * MB_OP + 32 + d] = O1[r]; }
        lsum += __shfl_xor(lsum, 32);
        if (half == 0) { lacc[qi] = lsum; mrefs[qi] = mref; }
    }
    __syncthreads();
    { int tcount = 0;
      for (int n = 0; n < b; ++n) { const int c = __builtin_amdgcn_readfirstlane(cnt[n]), o = __builtin_amdgcn_readfirstlane(offs[n]);
        for (int t0 = 0; t0 < c; t0 += 32, ++tcount) { if ((tcount & 7) != wave) continue;
            const bool qv = (t0 + l31) < c; const int ge = list[o + (qv ? t0 + l31 : 0)]; const int gq = ge & 255, slot = ge >> 8; const int gpos = b * MBLK + gq;
            float mref = mrefs[gq], lsum = 0.f; f32x16 O0, O1;
#pragma unroll
            for (int r = 0; r < 16; ++r) { O0[r] = 0.f; O1[r] = 0.f; }
            moba_tile<2>(U, h, n, 8, gpos, mref, vst, rtab, (b - n) <= 12, cbias, O0, O1, lsum, lane);
            lsum += __shfl_xor(lsum, 32);
            if (qv) { const size_t row = (size_t)gpos * 8 + h;
                GAS bf16* p0 = (slot == 0 ? Po00 : slot == 1 ? Po10 : Po20) + row * 32 + 4 * half;
                GAS bf16* p1 = (slot == 0 ? Po01 : slot == 1 ? Po11 : Po21) + row * 32 + 4 * half;
#pragma unroll
                for (int rg = 0; rg < 4; ++rg) { u32x2 w0, w1; w0.x = cvtpk(O0[4 * rg], O0[4 * rg + 1]); w0.y = cvtpk(O0[4 * rg + 2], O0[4 * rg + 3]); w1.x = cvtpk(O1[4 * rg], O1[4 * rg + 1]); w1.y = cvtpk(O1[4 * rg + 2], O1[4 * rg + 3]);
                    *(GAS u32x2*)(p0 + 8 * rg) = w0; *(GAS u32x2*)(p1 + 8 * rg) = w1; }
                if (half == 0) Pl[row * 4 + slot] = lsum; }
        } } }
    __syncthreads();
    { const int q = tid >> 1, dh = tid & 1; const int ns = nsel[q]; const size_t row = (size_t)(b * MBLK + q) * 8 + h; LAS const float* op = oacc + q * MB_OP + 32 * dh;
      float acc[32]; float l = lacc[q];
#pragma unroll
      for (int i = 0; i < 32; ++i) acc[i] = op[i];
#pragma unroll
      for (int j = 0; j < 3; ++j) if (j < ns) { const GAS bf16* pp = (j == 0 ? (dh ? Po01 : Po00) : j == 1 ? (dh ? Po11 : Po10) : (dh ? Po21 : Po20)) + row * 32; l += Pl[row * 4 + j];
#pragma unroll
          for (int i = 0; i < 4; ++i) { const v4u w = *(const GAS v4u*)(pp + 8 * i);
              acc[8 * i + 0] += bf_lo2(w.x); acc[8 * i + 1] += bf_hi2(w.x); acc[8 * i + 2] += bf_lo2(w.y); acc[8 * i + 3] += bf_hi2(w.y);
              acc[8 * i + 4] += bf_lo2(w.z); acc[8 * i + 5] += bf_hi2(w.z); acc[8 * i + 6] += bf_lo2(w.w); acc[8 * i + 7] += bf_hi2(w.w); } }
      const float inv = 1.0f / l;
      bf16* dst = mix + (size_t)(b * MBLK + q) * D + 512 + h * 64 + 32 * dh;
#pragma unroll
      for (int i = 0; i < 4; ++i) { v4u w; w.x = pk2(acc[8 * i] * inv, acc[8 * i + 1] * inv); w.y = pk2(acc[8 * i + 2] * inv, acc[8 * i + 3] * inv); w.z = pk2(acc[8 * i + 4] * inv, acc[8 * i + 5] * inv); w.w = pk2(acc[8 * i + 6] * inv, acc[8 * i + 7] * inv);
          *(GAS v4u*)(dst + 8 * i) = w; } }
    __syncthreads();
}
__device__ __forceinline__ void moba_phase(Frame& F, const bf16* U, const bf16* kmb, const float* relb, bf16* mix, MPARGS) {
    const int h = F.vcu >> 5, bb = F.vcu & 31;
    if (F.G != 256) return;
    moba_unit(F, U, kmb, relb, mix, MPPASS, h, bb);
    moba_unit(F, U, kmb, relb, mix, MPPASS, h, 63 - bb);
}
constexpr int GA_KD = 0, GA_KDP = 160, GA_V = 40960, GA_VP = 288, GA_SEG = GA_V + 256 * GA_VP;
constexpr int GC_KE = 0, GC_KEP = 144, GC_V = 36864, GC_VP = 288, GC_SST = GC_V + 256 * GC_VP, GC_SSTP = 144;
static_assert(GA_SEG + 2048 <= RING_BYTES && GC_SST + 128 * GC_SSTP <= RING_BYTES, "GLA LDS map");
__device__ __forceinline__ bf16x8 tr_pair(LAS unsigned char* p, int second_off) { const v4i16_t lo = lds_tr(p), hi = lds_tr(p + second_off); return (bf16x8){lo[0], lo[1], lo[2], lo[3], hi[0], hi[1], hi[2], hi[3]}; }

__device__ __forceinline__ void gla_A(Frame& F, const bf16* U, float* loga, float* dS, float* dec) {
    if (F.G != 256) return;
    const int c = F.vcu >> 2, h = F.vcu & 3, lane = fresh_lane(), wave = F.wave, tid = wave * 64 + lane;
    LAS unsigned char* L = F.lds + RING_OFF; LAS float* segtot = (LAS float*)(L + GA_SEG);
    const int d = lane, seg = wave, t0 = c * 256 + seg * 32;
    float bl[32]; float run = 0.f;
#pragma unroll
    for (int i = 0; i < 32; ++i) { run += loga[(size_t)(t0 + i) * 256 + h * 64 + d]; bl[i] = run; }
    segtot[seg * 64 + d] = run;
#pragma unroll
    for (int i = 0; i < 8; ++i) { const int p = tid + 512 * i, row = p >> 4, ch = p & 15;
        *(LAS v4u*)(L + GA_V + row * GA_VP + ch * 16) = *(const v4u*)(U + (size_t)(c * 256 + row) * UWID + U_VG + h * 128 + ch * 8); }
    __syncthreads();
    float pre = 0.f, tot = 0.f;
#pragma unroll
    for (int s = 0; s < 8; ++s) { const float v = segtot[s * 64 + d]; tot += v; if (s < seg) pre += v; }
#pragma unroll
    for (int i = 0; i < 32; ++i) { const float b = bl[i] + pre; loga[(size_t)(t0 + i) * 256 + h * 64 + d] = b;
        const float kk = bf2f(U[(size_t)(t0 + i) * UWID + U_KG + h * 64 + d]);
        *(LAS bf16*)(L + GA_KD + (seg * 32 + i) * GA_KDP + d * 2) = (bf16)f2bf(kk * __expf(tot - b)); }
    if (seg == 0) dec[(size_t)(c * 4 + h) * 64 + d] = __expf(tot);
    __syncthreads();
    const int et = wave >> 1, dt = wave & 1, half = lane >> 5, l31 = lane & 31, g1 = (lane >> 4) & 1, q = (lane & 15) >> 2, p = lane & 3;
    LAS unsigned char* trA = L + GA_V + (4 * half + q) * GA_VP + (32 * et + 16 * g1 + 4 * p) * 2;
    LAS unsigned char* trB = L + GA_KD + (4 * half + q) * GA_KDP + (32 * dt + 16 * g1 + 4 * p) * 2;
    f32x16 acc;
#pragma unroll
    for (int r = 0; r < 16; ++r) acc[r] = 0.f;
#pragma unroll 4
    for (int s = 0; s < 16; ++s) { const bf16x8 a = tr_pair(trA + s * 16 * GA_VP, 8 * GA_VP), b = tr_pair(trB + s * 16 * GA_KDP, 8 * GA_KDP); acc = mfma32(a, b, acc); }
    float* dst = dS + (size_t)(c * 4 + h) * 8192;
#pragma unroll
    for (int r = 0; r < 16; ++r) { const int e = 32 * et + (r & 3) + 8 * (r >> 2) + 4 * half; dst[e * 64 + 32 * dt + l31] = acc[r]; }
    __syncthreads();
}
__device__ __forceinline__ void gla_scan(Frame& F, const float* dS, const float* dec, bf16* Sst) {
    const int lane = fresh_lane(), tid = F.wave * 64 + lane;
    if (tid >= 128 || F.G != 256) return;
    const int idx = F.vcu * 128 + tid, h = idx >> 13, d = idx & 63, el = idx & 8191;
    float S = 0.f;
#pragma unroll 1
    for (int c0 = 0; c0 < 64; c0 += 32) {
        float ds[32], dc[32];
#pragma unroll
        for (int c = 0; c < 32; ++c) { ds[c] = dS[(size_t)((c0 + c) * 4 + h) * 8192 + el]; dc[c] = dec[(size_t)((c0 + c) * 4 + h) * 64 + d]; }
#pragma unroll
        for (int c = 0; c < 32; ++c) { Sst[(size_t)((c0 + c) * 4 + h) * 8192 + el] = (bf16)f2bf(S); S = dc[c] * S + ds[c]; }
    }
}
__device__ __forceinline__ void gla_C(Frame& F, const bf16* U, const float* bcum, const bf16* Sst, const float* gain, bf16* mix) {
    if (F.G != 256) return;
    const int c = F.vcu >> 2, h = F.vcu & 3, lane = fresh_lane(), wave = F.wave, tid = wave * 64 + lane;
    LAS unsigned char* L = F.lds + RING_OFF;
    { const int d = lane, seg = wave, t0 = c * 256 + seg * 32;
#pragma unroll 8
      for (int i = 0; i < 32; ++i) { const float b = bcum[(size_t)(t0 + i) * 256 + h * 64 + d]; const float kk = bf2f(U[(size_t)(t0 + i) * UWID + U_KG + h * 64 + d]);
          *(LAS bf16*)(L + GC_KE + (seg * 32 + i) * GC_KEP + d * 2) = (bf16)f2bf(kk * __expf(-b)); } }
#pragma unroll
    for (int i = 0; i < 8; ++i) { const int p = tid + 512 * i, row = p >> 4, ch = p & 15;
        *(LAS v4u*)(L + GC_V + row * GC_VP + ch * 16) = *(const v4u*)(U + (size_t)(c * 256 + row) * UWID + U_VG + h * 128 + ch * 8); }
#pragma unroll
    for (int i = 0; i < 2; ++i) { const int p = tid + 512 * i, row = p >> 3, ch = p & 7;
        *(LAS v4u*)(L + GC_SST + row * GC_SSTP + ch * 16) = *(const v4u*)(Sst + (size_t)((c * 4 + h) * 128 + row) * 64 + ch * 8); }
    __syncthreads();
    const int half = lane >> 5, l31 = lane & 31, g1 = (lane >> 4) & 1, q = (lane & 15) >> 2, p = lane & 3;
    const size_t tok = (size_t)c * 256 + wave * 32 + l31;
    bf16x8 qf[4];
#pragma unroll
    for (int s = 0; s < 4; ++s) { const v4u q8 = *(const v4u*)(U + tok * UWID + U_QG + h * 64 + 16 * s + 8 * half);
        const f32x4 b0 = *(const f32x4*)(bcum + tok * 256 + h * 64 + 16 * s + 8 * half), b1 = *(const f32x4*)(bcum + tok * 256 + h * 64 + 16 * s + 8 * half + 4);
        v4u w; w.x = cvtpk(bf_lo2(q8.x) * __expf(b0[0]), bf_hi2(q8.x) * __expf(b0[1])); w.y = cvtpk(bf_lo2(q8.y) * __expf(b0[2]), bf_hi2(q8.y) * __expf(b0[3]));
        w.z = cvtpk(bf_lo2(q8.z) * __expf(b1[0]), bf_hi2(q8.z) * __expf(b1[1])); w.w = cvtpk(bf_lo2(q8.w) * __expf(b1[2]), bf_hi2(q8.w) * __expf(b1[3]));
        qf[s] = __builtin_bit_cast(bf16x8, w); }
    f32x16 O[4];
#pragma unroll
    for (int et = 0; et < 4; ++et)
#pragma unroll
        for (int r = 0; r < 16; ++r) O[et][r] = 0.f;
#pragma unroll
    for (int et = 0; et < 4; ++et)
#pragma unroll
        for (int s = 0; s < 4; ++s) O[et] = mfma32(*(LAS const bf16x8*)(L + GC_SST + (32 * et + l31) * GC_SSTP + (16 * s + 8 * half) * 2), qf[s], O[et]);
    LAS unsigned char* trV = L + GC_V + (4 * half + q) * GC_VP + (16 * g1 + 4 * p) * 2;
    for (int jt = 0; jt <= wave; ++jt) {
        f32x16 ST;
#pragma unroll
        for (int r = 0; r < 16; ++r) ST[r] = 0.f;
#pragma unroll
        for (int s = 0; s < 4; ++s) ST = mfma32(*(LAS const bf16x8*)(L + GC_KE + (32 * jt + l31) * GC_KEP + (16 * s + 8 * half) * 2), qf[s], ST);
        if (jt == wave) {
#pragma unroll
            for (int r = 0; r < 16; ++r) { const int jl = (r & 3) + 8 * (r >> 2) + 4 * half; if (jl > l31) ST[r] = 0.f; } }
        bf16x8 pf0, pf1;
        { v4u w0, w1; w0.x = cvtpk(ST[0], ST[1]); w0.y = cvtpk(ST[2], ST[3]); w0.z = cvtpk(ST[4], ST[5]); w0.w = cvtpk(ST[6], ST[7]);
          w1.x = cvtpk(ST[8], ST[9]); w1.y = cvtpk(ST[10], ST[11]); w1.z = cvtpk(ST[12], ST[13]); w1.w = cvtpk(ST[14], ST[15]);
          pf0 = __builtin_bit_cast(bf16x8, w0); pf1 = __builtin_bit_cast(bf16x8, w1); }
#pragma unroll
        for (int sp = 0; sp < 2; ++sp)
#pragma unroll
            for (int et = 0; et < 4; ++et) { const bf16x8 a = tr_pair(trV + (32 * jt + 16 * sp) * GC_VP + et * 64, 8 * GC_VP); O[et] = mfma32(a, sp ? pf1 : pf0, O[et]); }
    }
    float ss = 0.f;
#pragma unroll
    for (int et = 0; et < 4; ++et)
#pragma unroll
        for (int r = 0; r < 16; ++r) ss += O[et][r] * O[et][r];
    ss += __shfl_xor(ss, 32);
    const float rs = 1.0f / sqrtf(ss * (1.0f / 128.0f) + EPS);
#pragma unroll
    for (int et = 0; et < 4; ++et)
#pragma unroll
        for (int rg = 0; rg < 4; ++rg) { const int e0 = 32 * et + 8 * rg + 4 * half;
            const uint2 gw = *(const uint2*)(U + tok * UWID + U_GG + h * 128 + e0); const f32x4 gn = *(const f32x4*)(gain + e0);
            const float g0 = bf_lo2(gw.x), g1v = bf_hi2(gw.x), g2 = bf_lo2(gw.y), g3 = bf_hi2(gw.y);
            const float y0 = O[et][4 * rg + 0] * rs * gn[0] * (g0 / (1.0f + __expf(-g0))), y1 = O[et][4 * rg + 1] * rs * gn[1] * (g1v / (1.0f + __expf(-g1v)));
            const float y2 = O[et][4 * rg + 2] * rs * gn[2] * (g2 / (1.0f + __expf(-g2))), y3 = O[et][4 * rg + 3] * rs * gn[3] * (g3 / (1.0f + __expf(-g3)));
            uint2 o; o.x = cvtpk(y0, y1); o.y = cvtpk(y2, y3);
            *(uint2*)(mix + tok * D + h * 128 + e0) = o; }
    __syncthreads();
}
__device__ __forceinline__ void final_norm(Frame& F, float* out, const float* ssqp, const float* gain) {
    const int gw = F.vcu * NWAVES + F.wave, NGW = F.G * NWAVES, lane = fresh_lane();
    for (int m = gw; m < M; m += NGW) {
        float s = (lane < 16) ? ssqp[(size_t)m * 16 + lane] : 0.f; s = wave_sum(s);
        const float rs = 1.0f / sqrtf(s * (1.0f / 1024.0f) + EPS);
        GAS f32x4* xr = (GAS f32x4*)(out + (size_t)m * D) + lane;
#pragma unroll
        for (int j = 0; j < 4; ++j) { f32x4 v = xr[64 * j]; const f32x4 g = ((const GAS f32x4*)gain)[lane + 64 * j]; v = v * rs * g; xr[64 * j] = v; }
    }
}
__global__ void __launch_bounds__(NWAVES * 64, 2) mega_fwd(Args args) {
    extern __shared__ __attribute__((aligned(16))) unsigned char lds[];
    Frame F;
    F.lds = (LAS unsigned char*)lds;
    F.MISC = (volatile LAS unsigned*)(F.lds + MISC_OFF);
    F.tid = threadIdx.x; F.lane = F.tid & 63; F.wave = __builtin_amdgcn_readfirstlane(F.tid >> 6);
    F.G = gridDim.x; { const int bx = blockIdx.x; F.vcu = (F.G % 8 == 0) ? (bx % 8) * (F.G / 8) + bx / 8 : bx; }
    unsigned char* ws = args.ws;
    F.ctl = (gu32*)(ws + WS_CTL);
    for (int u = F.tid; u < (LDS_BYTES - LDSCTL_OFF) / 4; u += NWAVES * 64) ((LAS unsigned*)(F.lds + LDSCTL_OFF))[u] = 0u;
    __syncthreads();
    XcdBarrier bar; bar.bar = (unsigned*)(F.ctl + CW_BAR); bar.x = 0; bar.st = nullptr;
    if (N_LAUNCHES != N_PHASES) bar = xcd_barrier_post((unsigned*)(F.ctl + CW_BAR), F.MISC + 8);
#define GRID_BAR() do { if (N_LAUNCHES == N_PHASES) { if (F.tid == 0) __hip_atomic_store(F.ctl + CW_TMO, 0xBADBA0u, RLX_AGENT); } else { xcd_barrier(bar); } } while (0)
    const int lo = args.ph_lo, hi = args.ph_hi;
#define IN(k) (lo <= (k) && (k) < hi)
#define BOTH(k) (IN(k) && IN((k) + 1))
    using pg8::Gemm; using pg8::StaticOrder;
#define RUN_GEMM(EPI, A_, B_, N_, K_, ...) do { Gemm g{A_, B_, M, N_, K_}; StaticOrder S; S.init(M, N_, F.G, (int)blockIdx.x); pg8::EPI E{__VA_ARGS__}; \
        pg8::gemm_phase<pg8::EPI, StaticOrder, PG8_ALIGN, PG8_SP2>(F.lds + RING_OFF, g, S, E); } while (0)
#define WSB() GAS unsigned char* w_ = (GAS unsigned char*)args.ws; GAS float* out_ = (GAS float*)args.out; asm volatile("" : "+s"(w_), "+s"(out_)); float* out = (float*)out_
#define PB16(off) ((bf16*)(w_ + (off)))
#define PF32(off) ((float*)(w_ + (off)))
#define PHASE(k, ...) if (IN(k)) { WSB(); __VA_ARGS__; if (BOTH(k)) GRID_BAR(); }
    PHASE(0, p0_prologue(F, args))
    PHASE(1, RUN_GEMM(EpiSwiGLU, PB16(WS_MIX), PB16(WS_WGU1), NGU, D, PB16(WS_U), FF, PF32(WS_SSQ1)))
    PHASE(2, RUN_GEMM(EpiResid<1>, PB16(WS_U), PB16(WS_WD1), D, FF, args.in[0], out, PB16(WS_HB), PF32(WS_SSQ2)))
    PHASE(3, RUN_GEMM(EpiWin, PB16(WS_HB), PB16(WS_WIN), UWID, D, PB16(WS_U), PF32(WS_LOGA), PF32(WS_SSQ2), args.in[8]))
    PHASE(4, moba_kmean(F, PB16(WS_U), PB16(WS_KMEAN)); gla_A(F, PB16(WS_U), PF32(WS_LOGA), PF32(WS_HB), PF32(WS_HB + 12 * MiB)))
    PHASE(5, gla_scan(F, PF32(WS_HB), PF32(WS_HB + 12 * MiB), PB16(WS_HB + 8 * MiB)); moba_phase(F, PB16(WS_U), PB16(WS_KMEAN), args.in[17], PB16(WS_MIX), (GAS bf16*)(w_ + 1 * MiB), (GAS bf16*)(w_ + 9 * MiB), (GAS bf16*)(w_ + 67 * MiB), (GAS bf16*)(w_ + 75 * MiB), (GAS bf16*)(w_ + 17 * MiB), (GAS bf16*)(w_ + 246 * MiB), (GAS float*)(w_ + 254 * MiB)))
    PHASE(6, gla_C(F, PB16(WS_U), PF32(WS_LOGA), PB16(WS_HB + 8 * MiB), args.in[9], PB16(WS_MIX)))
    PHASE(7, RUN_GEMM(EpiResid<0>, PB16(WS_MIX), PB16(WS_WOUT), D, D, out, out, PB16(WS_HB), PF32(WS_SSQ3)))
    PHASE(8, RUN_GEMM(EpiPlain, PB16(WS_PB), PB16(WS_WPP), D, DPLE, PB16(WS_PP)))
    PHASE(9, RUN_GEMM(EpiSwiGLU, PB16(WS_HB), PB16(WS_WGU2), NGU, D, PB16(WS_U), FF, PF32(WS_SSQ3)))
    PHASE(10, RUN_GEMM(EpiResid<1>, PB16(WS_U), PB16(WS_WD2), D, FF, out, out, PB16(WS_HB), PF32(WS_SSQ4)))
    PHASE(11, RUN_GEMM(EpiPle, PB16(WS_HB), PB16(WS_WPG), D, D, out, out, PB16(WS_PP), PF32(WS_SSQ4), PF32(WS_SSQ5)))
    if (IN(12)) { WSB(); final_norm(F, out, PF32(WS_SSQ5), args.in[18]); }
#undef IN
#undef BOTH
}

extern "C" void kernel_launch(void* const* d_in, const int* in_sizes, int n_in, void* d_out, int out_size, void* d_ws, size_t ws_size, hipStream_t stream) {
    static int grid = 0;
    if (grid == 0) {
        if (n_in != 19 || in_sizes[0] != M * D || out_size != M * D || ws_size < WS_END) { fprintf(stderr, "kernel_launch: unexpected shapes (n_in %d, in0 %d, out %d, ws %zu); nothing launched\n", n_in, n_in > 0 ? in_sizes[0] : -1, out_size, ws_size); grid = -1; return; }
        int dev = 0, cus = 0, per_cu = 0;
        if (hipGetDevice(&dev) != hipSuccess || hipDeviceGetAttribute(&cus, hipDeviceAttributeMultiprocessorCount, dev) != hipSuccess) { grid = -1; return; }
        if (hipFuncSetAttribute((const void*)mega_fwd, hipFuncAttributeMaxDynamicSharedMemorySize, LDS_BYTES) != hipSuccess) { fprintf(stderr, "kernel_launch: hipFuncSetAttribute failed\n"); grid = -1; return; }
        if (hipOccupancyMaxActiveBlocksPerMultiprocessor(&per_cu, (const void*)mega_fwd, NWAVES * 64, LDS_BYTES) != hipSuccess || per_cu < 1) { fprintf(stderr, "kernel_launch: occupancy query reports %d workgroups per CU\n", per_cu); }
        (void)hipGetLastError();
        grid = cus;
    }
    if (grid < 0) return;
    if (hipMemsetAsync((char*)d_ws + WS_CTL, 0, CTL_ZERO_BYTES, stream) != hipSuccess) { fprintf(stderr, "kernel_launch: hipMemsetAsync failed\n"); return; }
    Args a{};
    for (int i = 0; i < 19; ++i) a.in[i] = (const float*)d_in[i];
    a.out = (float*)d_out; a.ws = (unsigned char*)d_ws;
    for (int li = 0; li < N_LAUNCHES; ++li) {
        if (N_LAUNCHES == 1) { a.ph_lo = 0; a.ph_hi = N_PHASES; } else { a.ph_lo = li; a.ph_hi = li + 1; }
        a.li = li;
        hipLaunchKernelGGL(mega_fwd, dim3(grid), dim3(NWAVES * 64), LDS_BYTES, stream, a);
        const hipError_t le = hipPeekAtLastError();
        if (le != hipSuccess) { fprintf(stderr, "kernel_launch: launch %d failed: %s\n", li, hipGetErrorName(le)); break; }
    }
}
```

```cpp
#include <hip/hip_runtime.h>
#include <cstdio>
#include <cstdint>
namespace pg8 {
#define PG8_LAS __attribute__((address_space(3)))
typedef unsigned short bf16_t;
typedef short bf16x8 __attribute__((ext_vector_type(8)));
typedef float f32x4 __attribute__((ext_vector_type(4)));
typedef unsigned u32x4 __attribute__((ext_vector_type(4)));
constexpr int BM = 256, BK = 64, HALF = 128, HTB = HALF * BK * 2  , STAGE_BYTES = 8 * HTB, NXCD = 8, WGM = 8;

__host__ __device__ __forceinline__ int lds_byte(int r, int c) { const int st = (r >> 4) * 2 + (c >> 5), rr = r & 15, cc = c & 31, ob = rr * 64 + cc * 2; return st * 1024 + (ob ^ (((ob >> 9) & 1) << 5)); }
__host__ __device__ __forceinline__ void stage_rc(int b, int& R, int& C) { const int st = b / 1024, sb = b % 1024, swz = sb ^ (((sb >> 9) & 1) << 5); R = (st >> 1) * 16 + swz / 64; C = (st & 1) * 32 + (swz % 64) / 2; }
__host__ __device__ __forceinline__ int perm32(int rho) { const int n = rho >> 4, i = rho & 15; return 8 * (i >> 2) + 4 * n + (i & 3); }

struct Unit { int pm, pn; };
struct Gemm { const bf16_t* A; const bf16_t* Bt; int M, N, K; };

struct StaticOrder {
    int nM, nN, nwg, G, c;
    __host__ __device__ void init(int M, int N, int G_, int c_) { nM = M / BM; nN = N / BM; nwg = nM * nN; G = G_; c = c_; }
    __host__ __device__ bool next(int i, Unit& u) const {
        const long L = (long)i * G + c; if (L >= nwg) return false;
        int wgid = (int)L; { const int q = nwg / NXCD, r = nwg % NXCD, xcd = wgid % NXCD, off = wgid / NXCD; wgid = (xcd < r ? xcd * (q + 1) : r * (q + 1) + (xcd - r) * q) + off; }
        const int nig = WGM * nN, gid = wgid / nig, fm = gid * WGM, gsz = (nM - fm) < WGM ? (nM - fm) : WGM;
        u.pm = fm + ((wgid % nig) % gsz); u.pn = (wgid % nig) / gsz; return true;
    }
    __device__ __forceinline__ void a_ready(const Unit&) const {}
    __device__ __forceinline__ void done(const Unit&) const {}
};

__device__ __forceinline__ unsigned cvt_pk_bf16(float lo, float hi) { unsigned r; asm volatile("v_cvt_pk_bf16_f32 %0, %1, %2" : "=v"(r) : "v"(lo), "v"(hi)); return r; }
__device__ __forceinline__ float bf_lo(unsigned w) { return __uint_as_float(w << 16); }
__device__ __forceinline__ float bf_hi(unsigned w) { return __uint_as_float(w & 0xffff0000u); }
constexpr float RMS_EPS = 1e-6f;
__device__ __forceinline__ float row_rstd(const float* ssqp, int r, int fq) {
    const f32x4 p = *(const f32x4*)(ssqp + (size_t)r * 16 + 4 * fq);
    float s = (p[0] + p[1]) + (p[2] + p[3]);
    s += __shfl_xor(s, 16); s += __shfl_xor(s, 32);
    return __builtin_amdgcn_rsqf(s * (1.0f / 1024.0f) + RMS_EPS);
}
__device__ __forceinline__ float fast_sigmoid(float x) { return __builtin_amdgcn_rcpf(1.0f + __builtin_amdgcn_exp2f(-1.4426950408889634f * x)); }
struct EpiSwiGLU {
    static constexpr bool PERM = true, AFTER_DRAIN = false;
    bf16_t* O; int ldc; const float* ssqp;
    __device__ __forceinline__ void operator()(const f32x4 (&acc)[2][2][4][2], const Unit& u, int wr, int wc, int fr, int fq) const {
        const int row0 = u.pm * BM + wr * 64 + fr, col0 = u.pn * HALF + wc * 32 + 8 * fq;
#pragma unroll
        for (int ai = 0; ai < 2; ++ai)
#pragma unroll
            for (int m = 0; m < 4; ++m) { const int r = row0 + ai * HALF + m * 16; const float rs = row_rstd(ssqp, r, fq);
                float h[8];
#pragma unroll
                for (int n = 0; n < 2; ++n)
#pragma unroll
                    for (int j = 0; j < 4; ++j) { const float g = acc[ai][0][m][n][j] * rs, up = acc[ai][1][m][n][j] * rs; h[n * 4 + j] = g * fast_sigmoid(g) * up; }
                u32x4 w; w.x = cvt_pk_bf16(h[0], h[1]); w.y = cvt_pk_bf16(h[2], h[3]); w.z = cvt_pk_bf16(h[4], h[5]); w.w = cvt_pk_bf16(h[6], h[7]);
                *(u32x4*)(O + (size_t)r * ldc + col0) = w; }
    }
};
template <int HALF_ALPHA> struct EpiResid {
    static constexpr bool PERM = true, AFTER_DRAIN = false; static constexpr float alpha = HALF_ALPHA ? 0.5f : 1.0f;
    const float* base; float* out; bf16_t* ob; float* ssq_out;
    __device__ __forceinline__ void operator()(const f32x4 (&acc)[2][2][4][2], const Unit& u, int wr, int wc, int fr, int fq) const {
        const int row0 = u.pm * BM + wr * 64 + fr, col0 = u.pn * BM + wc * 32 + 8 * fq;
#pragma unroll
        for (int ai = 0; ai < 2; ++ai)
#pragma unroll
            for (int m = 0; m < 4; ++m) { const int r = row0 + ai * HALF + m * 16; float ss = 0.f;
#pragma unroll
                for (int bj = 0; bj < 2; ++bj) { const size_t off = (size_t)r * 1024 + col0 + bj * HALF;
                    const f32x4 b0 = *(const f32x4*)(base + off), b1 = *(const f32x4*)(base + off + 4);
                    const f32x4 v0 = b0 + acc[ai][bj][m][0] * alpha, v1 = b1 + acc[ai][bj][m][1] * alpha;
                    *(f32x4*)(out + off) = v0; *(f32x4*)(out + off + 4) = v1;
                    u32x4 w; w.x = cvt_pk_bf16(v0[0], v0[1]); w.y = cvt_pk_bf16(v0[2], v0[3]); w.z = cvt_pk_bf16(v1[0], v1[1]); w.w = cvt_pk_bf16(v1[2], v1[3]);
                    *(u32x4*)(ob + off) = w;
                    ss += (v0[0] * v0[0] + v0[1] * v0[1]) + (v0[2] * v0[2] + v0[3] * v0[3]) + (v1[0] * v1[0] + v1[1] * v1[1]) + (v1[2] * v1[2] + v1[3] * v1[3]); }
                ss += __shfl_xor(ss, 16); ss += __shfl_xor(ss, 32);
                if (fq == 0) ssq_out[(size_t)r * 16 + 4 * u.pn + wc] = ss; }
    }
};
constexpr int UW = 3328;
struct EpiWin {
    static constexpr bool PERM = true, AFTER_DRAIN = false;
    bf16_t* U; float* loga; const float* ssqp; const float* bgk;
    __device__ __forceinline__ void operator()(const f32x4 (&acc)[2][2][4][2], const Unit& u, int wr, int wc, int fr, int fq) const {
        const int row0 = u.pm * BM + wr * 64 + fr, cl0 = wc * 32 + 8 * fq;
        const float sc = (u.pn == 0) ? 0.125f : 1.0f;
#pragma unroll
        for (int ai = 0; ai < 2; ++ai)
#pragma unroll
            for (int m = 0; m < 4; ++m) { const int r = row0 + ai * HALF + m * 16; const float rs = row_rstd(ssqp, r, fq);
#pragma unroll
                for (int bj = 0; bj < 2; ++bj) { const int cl = cl0 + bj * HALF;
                    const f32x4 v0 = acc[ai][bj][m][0] * rs, v1 = acc[ai][bj][m][1] * rs;
                    if (u.pn == 6) {
                        const f32x4 c0 = *(const f32x4*)(bgk + cl), c1 = *(const f32x4*)(bgk + cl + 4); f32x4 o0, o1;
#pragma unroll
                        for (int j = 0; j < 4; ++j) { const float x0 = v0[j] + c0[j], x1 = v1[j] + c1[j];
                            o0[j] = (fminf(x0, 0.f) - log1pf(__expf(-fabsf(x0)))) * (1.0f / 16.0f); o1[j] = (fminf(x1, 0.f) - log1pf(__expf(-fabsf(x1)))) * (1.0f / 16.0f); }
                        *(f32x4*)(loga + (size_t)r * 256 + cl) = o0; *(f32x4*)(loga + (size_t)r * 256 + cl + 4) = o1;
                    } else {
                        u32x4 w; w.x = cvt_pk_bf16(v0[0] * sc, v0[1] * sc); w.y = cvt_pk_bf16(v0[2] * sc, v0[3] * sc); w.z = cvt_pk_bf16(v1[0] * sc, v1[1] * sc); w.w = cvt_pk_bf16(v1[2] * sc, v1[3] * sc);
                        *(u32x4*)(U + (size_t)r * UW + u.pn * BM + cl) = w; } } }
    }
};
struct EpiPlain {
    static constexpr bool PERM = true, AFTER_DRAIN = false;
    bf16_t* O;
    __device__ __forceinline__ void operator()(const f32x4 (&acc)[2][2][4][2], const Unit& u, int wr, int wc, int fr, int fq) const {
        const int row0 = u.pm * BM + wr * 64 + fr, col0 = u.pn * BM + wc * 32 + 8 * fq;
#pragma unroll
        for (int ai = 0; ai < 2; ++ai)
#pragma unroll
            for (int m = 0; m < 4; ++m) { const int r = row0 + ai * HALF + m * 16;
#pragma unroll
                for (int bj = 0; bj < 2; ++bj) { const f32x4 v0 = acc[ai][bj][m][0], v1 = acc[ai][bj][m][1];
                    u32x4 w; w.x = cvt_pk_bf16(v0[0], v0[1]); w.y = cvt_pk_bf16(v0[2], v0[3]); w.z = cvt_pk_bf16(v1[0], v1[1]); w.w = cvt_pk_bf16(v1[2], v1[3]);
                    *(u32x4*)(O + (size_t)r * 1024 + col0 + bj * HALF) = w; } }
    }
};
struct EpiPle {
    static constexpr bool PERM = true, AFTER_DRAIN = false;
    const float* base; float* out; const bf16_t* pp; const float* ssqp; float* ssq_out;
    __device__ __forceinline__ void operator()(const f32x4 (&acc)[2][2][4][2], const Unit& u, int wr, int wc, int fr, int fq) const {
        const int row0 = u.pm * BM + wr * 64 + fr, col0 = u.pn * BM + wc * 32 + 8 * fq;
#pragma unroll
        for (int ai = 0; ai < 2; ++ai)
#pragma unroll
            for (int m = 0; m < 4; ++m) { const int r = row0 + ai * HALF + m * 16; const float rs = row_rstd(ssqp, r, fq); float ss = 0.f;
#pragma unroll
                for (int bj = 0; bj < 2; ++bj) { const size_t off = (size_t)r * 1024 + col0 + bj * HALF;
                    const f32x4 b0 = *(const f32x4*)(base + off), b1 = *(const f32x4*)(base + off + 4);
                    const u32x4 pw = *(const u32x4*)(pp + off);
                    f32x4 v0, v1;
                    v0[0] = b0[0] + fast_sigmoid(acc[ai][bj][m][0][0] * rs) * bf_lo(pw.x); v0[1] = b0[1] + fast_sigmoid(acc[ai][bj][m][0][1] * rs) * bf_hi(pw.x);
                    v0[2] = b0[2] + fast_sigmoid(acc[ai][bj][m][0][2] * rs) * bf_lo(pw.y); v0[3] = b0[3] + fast_sigmoid(acc[ai][bj][m][0][3] * rs) * bf_hi(pw.y);
                    v1[0] = b1[0] + fast_sigmoid(acc[ai][bj][m][1][0] * rs) * bf_lo(pw.z); v1[1] = b1[1] + fast_sigmoid(acc[ai][bj][m][1][1] * rs) * bf_hi(pw.z);
                    v1[2] = b1[2] + fast_sigmoid(acc[ai][bj][m][1][2] * rs) * bf_lo(pw.w); v1[3] = b1[3] + fast_sigmoid(acc[ai][bj][m][1][3] * rs) * bf_hi(pw.w);
                    *(f32x4*)(out + off) = v0; *(f32x4*)(out + off + 4) = v1;
                    ss += (v0[0] * v0[0] + v0[1] * v0[1]) + (v0[2] * v0[2] + v0[3] * v0[3]) + (v1[0] * v1[0] + v1[1] * v1[1]) + (v1[2] * v1[2] + v1[3] * v1[3]); }
                ss += __shfl_xor(ss, 16); ss += __shfl_xor(ss, 32);
                if (fq == 0) ssq_out[(size_t)r * 16 + 4 * u.pn + wc] = ss; }
    }
};
template <class Epi, class Sched, bool ALIGN_EPI = false, bool SP2 = false>
__device__ __forceinline__ void gemm_phase(PG8_LAS unsigned char* lds, const Gemm g, const Sched& S, const Epi& E) {
    const int tid = threadIdx.x, wid = __builtin_amdgcn_readfirstlane(tid >> 6), lane = tid & 63, wr = wid >> 2, wc = wid & 3, fr = lane & 15, fq = lane >> 4;
    const int K = g.K, nt = K / BK;
    unsigned voffA[2], voffB[2];
#pragma unroll
    for (int i = 0; i < 2; ++i) { int R, C; stage_rc(tid * 16 + i * 8192, R, C); const int Rb = Epi::PERM ? ((R & ~31) + perm32(R & 31)) : R;
        voffA[i] = (unsigned)(R * K + C) * 2u; voffB[i] = (unsigned)(Rb * K + C) * 2u; }
    const size_t kstep = (size_t)(BK * 2);
    const size_t hstep = (size_t)HALF * K * 2;
    const size_t tstep = 2 * hstep;
    const unsigned ldsw = (unsigned)wid * 1024u;
    const int aoff = lds_byte(wr * 64 + fr, fq * 8), boff = lds_byte(wc * 32 + fr, fq * 8);
#define PG8_SA(b, h) (((b) * 2 + (h)) * HTB)
#define PG8_SB(b, h) ((4 + (b) * 2 + (h)) * HTB)
#define PG8_STAGE(bufoff, gbase, voff) do { _Pragma("unroll") for (int _i = 0; _i < 2; ++_i) \
        __builtin_amdgcn_global_load_lds((const unsigned*)((const char*)(gbase) + (voff)[_i]), (PG8_LAS unsigned*)(lds + (bufoff) + ldsw + _i * 8192), 16, 0, 0); } while (0)
#define PG8_LDA(dst, b, h) do { _Pragma("unroll") for (int m = 0; m < 4; ++m) _Pragma("unroll") for (int k = 0; k < 2; ++k) dst[m][k] = *(const PG8_LAS bf16x8*)(lds + PG8_SA(b, h) + aoff + m * 2048 + k * 1024); } while (0)
#define PG8_LDB(dst, b, h) do { _Pragma("unroll") for (int n = 0; n < 2; ++n) _Pragma("unroll") for (int k = 0; k < 2; ++k) dst[n][k] = *(const PG8_LAS bf16x8*)(lds + PG8_SB(b, h) + boff + n * 2048 + k * 1024); } while (0)
#define PG8_MMA(ai, bj, At, Bt) do { __builtin_amdgcn_s_setprio(1); _Pragma("unroll") for (int m = 0; m < 4; ++m) _Pragma("unroll") for (int n = 0; n < 2; ++n) _Pragma("unroll") for (int k = 0; k < 2; ++k) \
        acc[ai][bj][m][n] = __builtin_amdgcn_mfma_f32_16x16x32_bf16(Bt[n][k], At[m][k], acc[ai][bj][m][n], 0, 0, 0); __builtin_amdgcn_s_setprio(0); } while (0)
#define PG8_WAIT_V(n) asm volatile("s_waitcnt vmcnt(" #n ")" ::: "memory")
#define PG8_WAIT_L(n) asm volatile("s_waitcnt lgkmcnt(" #n ")" ::: "memory")
#define PG8_BAR __builtin_amdgcn_s_barrier()
#define PG8_SCHED __builtin_amdgcn_sched_barrier(0)
    Unit cur, nxt; int ui = 0;
    if (!S.next(0, cur)) return;
    f32x4 acc[2][2][4][2];
#pragma unroll
    for (int a = 0; a < 2; ++a)
#pragma unroll
        for (int b = 0; b < 2; ++b)
#pragma unroll
            for (int m = 0; m < 4; ++m)
#pragma unroll
                for (int n = 0; n < 2; ++n) acc[a][b][m][n] = (f32x4){0.f, 0.f, 0.f, 0.f};
    bf16x8 At[4][2], B0[2][2], B1[2][2];
    const char* cA = (const char*)g.A + (size_t)cur.pm * tstep; const char* cB = (const char*)g.Bt + (size_t)cur.pn * tstep;
    S.a_ready(cur);
    if constexpr (SP2) {
        PG8_STAGE(PG8_SB(0, 0), cB, voffB); PG8_STAGE(PG8_SB(0, 1), cB + hstep, voffB); PG8_STAGE(PG8_SA(0, 0), cA, voffA); PG8_STAGE(PG8_SA(0, 1), cA + hstep, voffA);
        if (wr == 1) PG8_BAR;
        PG8_WAIT_V(2); PG8_BAR;
        PG8_STAGE(PG8_SB(1, 0), cB + kstep, voffB); PG8_STAGE(PG8_SA(1, 0), cA + kstep, voffA); PG8_STAGE(PG8_SB(1, 1), cB + hstep + kstep, voffB);
        PG8_WAIT_V(6); PG8_BAR;
    } else {
        PG8_STAGE(PG8_SB(0, 0), cB, voffB); PG8_STAGE(PG8_SA(0, 0), cA, voffA); PG8_STAGE(PG8_SB(0, 1), cB + hstep, voffB); PG8_STAGE(PG8_SA(0, 1), cA + hstep, voffA);
        if (wr == 1) PG8_BAR;
        PG8_WAIT_V(4); PG8_BAR;
        PG8_STAGE(PG8_SB(1, 0), cB + kstep, voffB); PG8_STAGE(PG8_SA(1, 0), cA + kstep, voffA); PG8_STAGE(PG8_SB(1, 1), cB + hstep + kstep, voffB);
        PG8_WAIT_V(6); PG8_BAR;
    }
    for (;;) {
        const bool has_next = S.next(ui + 1, nxt);
        const char* nA = has_next ? (const char*)g.A + (size_t)nxt.pm * tstep : cA; const char* nB = has_next ? (const char*)g.Bt + (size_t)nxt.pn * tstep : cB;
        for (int t = 0; t < nt; t += 2) {
            const bool last = (t == nt - 2);
            const char* a1 = cA + (size_t)(t + 1) * kstep;
            const char* a2 = last ? nA : cA + (size_t)(t + 2) * kstep; const char* b2 = last ? nB : cB + (size_t)(t + 2) * kstep;
            const char* a3 = a2 + kstep; const char* b3 = b2 + kstep;
            if (last && has_next) S.a_ready(nxt);
            if constexpr (SP2) {
            PG8_LDB(B0, 0, 0); PG8_LDB(B1, 0, 1); PG8_SCHED; PG8_LDA(At, 0, 0); PG8_STAGE(PG8_SA(1, 1), a1 + hstep, voffA);
            PG8_WAIT_V(8); PG8_WAIT_L(0); PG8_BAR; PG8_MMA(0, 0, At, B0); PG8_MMA(0, 1, At, B1); PG8_BAR; PG8_SCHED;
            PG8_LDA(At, 0, 1); PG8_STAGE(PG8_SB(0, 0), b2, voffB); PG8_STAGE(PG8_SB(0, 1), b2 + hstep, voffB); PG8_STAGE(PG8_SA(0, 0), a2, voffA);
            PG8_WAIT_V(8); PG8_WAIT_L(0); PG8_BAR; PG8_MMA(1, 0, At, B0); PG8_MMA(1, 1, At, B1); PG8_BAR; PG8_SCHED;
            PG8_LDB(B0, 1, 0); PG8_LDB(B1, 1, 1); PG8_SCHED; PG8_LDA(At, 1, 0); PG8_STAGE(PG8_SA(0, 1), a2 + hstep, voffA);
            PG8_WAIT_V(8); PG8_WAIT_L(0); PG8_BAR; PG8_MMA(0, 0, At, B0); PG8_MMA(0, 1, At, B1); PG8_BAR; PG8_SCHED;
            PG8_LDA(At, 1, 1); PG8_STAGE(PG8_SB(1, 0), b3, voffB); PG8_STAGE(PG8_SB(1, 1), b3 + hstep, voffB); PG8_STAGE(PG8_SA(1, 0), a3, voffA);
            PG8_WAIT_V(8); PG8_WAIT_L(0); PG8_BAR; PG8_MMA(1, 0, At, B0); PG8_MMA(1, 1, At, B1); PG8_BAR; PG8_SCHED;
            } else {
            PG8_LDB(B0, 0, 0); PG8_SCHED; PG8_LDA(At, 0, 0); PG8_STAGE(PG8_SA(1, 1), a1 + hstep, voffA);
            PG8_WAIT_L(8); PG8_BAR; PG8_WAIT_L(0); PG8_MMA(0, 0, At, B0); PG8_BAR; PG8_SCHED;
            PG8_LDB(B1, 0, 1); PG8_STAGE(PG8_SB(0, 0), b2, voffB);
            PG8_BAR; PG8_WAIT_L(0); PG8_MMA(0, 1, At, B1); PG8_BAR;
            PG8_LDA(At, 0, 1); PG8_STAGE(PG8_SA(0, 0), a2, voffA);
            PG8_BAR; PG8_WAIT_L(0); PG8_MMA(1, 0, At, B0); PG8_BAR; PG8_SCHED;
            PG8_STAGE(PG8_SB(0, 1), b2 + hstep, voffB);
            PG8_WAIT_V(6); PG8_BAR; PG8_MMA(1, 1, At, B1); PG8_BAR;
            PG8_LDB(B0, 1, 0); PG8_SCHED; PG8_LDA(At, 1, 0); PG8_STAGE(PG8_SA(0, 1), a2 + hstep, voffA);
            PG8_WAIT_L(8); PG8_BAR; PG8_WAIT_L(0); PG8_MMA(0, 0, At, B0); PG8_BAR; PG8_SCHED;
            PG8_LDB(B1, 1, 1); PG8_STAGE(PG8_SB(1, 0), b3, voffB);
            PG8_BAR; PG8_WAIT_L(0); PG8_MMA(0, 1, At, B1); PG8_BAR;
            PG8_LDA(At, 1, 1); PG8_STAGE(PG8_SA(1, 0), a3, voffA);
            PG8_BAR; PG8_WAIT_L(0); PG8_MMA(1, 0, At, B0); PG8_BAR; PG8_SCHED;
            PG8_STAGE(PG8_SB(1, 1), b3 + hstep, voffB);
            PG8_WAIT_V(6); PG8_BAR; PG8_MMA(1, 1, At, B1); PG8_BAR;
            }
        }
        if constexpr (ALIGN_EPI) { if (wr == 0) PG8_BAR; }
        if constexpr (!Epi::AFTER_DRAIN) { E(acc, cur, wr, wc, fr, fq); S.done(cur); }
        if (!has_next) break;
#pragma unroll
        for (int a = 0; a < 2; ++a)
#pragma unroll
            for (int b = 0; b < 2; ++b)
#pragma unroll
                for (int m = 0; m < 4; ++m)
#pragma unroll
                    for (int n = 0; n < 2; ++n) acc[a][b][m][n] = (f32x4){0.f, 0.f, 0.f, 0.f};
        cur = nxt; cA = nA; cB = nB; ++ui;
        if constexpr (ALIGN_EPI) { if (wr == 1) PG8_BAR; }
    }
    PG8_WAIT_V(0);
    if constexpr (!ALIGN_EPI) { if (wr == 0) PG8_BAR; }
    PG8_BAR;
    if constexpr (Epi::AFTER_DRAIN) { E.fused(acc, cur, wr, wc, fr, fq, lds, wid, lane); S.done(cur); }
#undef PG8_SA
#undef PG8_SB
#undef PG8_STAGE
#undef PG8_LDA
#undef PG8_LDB
#undef PG8_MMA
#undef PG8_WAIT_V
#undef PG8_WAIT_L
#undef PG8_BAR
#undef PG8_SCHED
}
}
#ifndef PG8_SP2
#define PG8_SP2 true
#endif
#ifndef PG8_ALIGN
#define PG8_ALIGN true
#endif
constexpr int NWAVES = 8;
constexpr int N_PHASES = 12;
#ifndef MK_N_LAUNCHES
#define MK_N_LAUNCHES 1
#endif
constexpr int N_LAUNCHES = MK_N_LAUNCHES;

constexpr int M = 16384, D = 1024, FF = 2816, NGU = 2 * FF, DPLE = 256;
constexpr int GH = 4, GDK = 64, GDV = 128, MH = 8, MHD = 64, MBLK = 256, NBLK = M / MBLK;
constexpr int UWID = 3328;
constexpr int U_QG = 0, U_KG = 256, U_VG = 512, U_GG = 1024, U_QM = 1792, U_KM = 2304, U_VM = 2816;
constexpr float EPS = 1e-6f;

constexpr size_t MiB = 1u << 20;
constexpr size_t WS_CTL = 0, CTL_ZERO_BYTES = 1 * MiB;
constexpr size_t WS_WGU1 = 1 * MiB, WS_WD1 = 12 * MiB, WS_WIN = 18 * MiB, WS_WOUT = 25 * MiB, WS_WGU2 = 27 * MiB, WS_WD2 = 38 * MiB, WS_WPG = 44 * MiB, WS_WPP = 46 * MiB;
constexpr size_t WS_SSQ1 = 47 * MiB, WS_SSQ2 = 48 * MiB, WS_SSQ3 = 49 * MiB, WS_SSQ4 = 50 * MiB, WS_SSQ5 = 51 * MiB, WS_KMEAN = 52 * MiB;
constexpr size_t WS_HB = 54 * MiB;
constexpr size_t WS_PB = 86 * MiB;
constexpr size_t WS_MIX = 94 * MiB;
constexpr size_t WS_U = 126 * MiB;
constexpr size_t WS_LOGA = 230 * MiB;
constexpr size_t WS_PP = 214 * MiB;
constexpr size_t WS_END = 256 * MiB;
static_assert(WS_U + (size_t)M * UWID * 2 <= WS_LOGA && WS_LOGA + (size_t)M * 256 * 4 <= WS_END && WS_U + (size_t)M * FF * 2 <= WS_PP && WS_PP + (size_t)M * D * 2 <= WS_END, "d_ws map");
constexpr int CW_TMO = 0, CW_CODE = 1;
constexpr int CW_BAR = 4096;

constexpr int RING_OFF = 0, RING_BYTES = 131072;
constexpr int LDS_BYTES = 163840;
constexpr int LDSCTL_OFF = LDS_BYTES - 512, MISC_OFF = LDSCTL_OFF + 320;
#define GAS __attribute__((address_space(1)))
#define LAS __attribute__((address_space(3)))
typedef unsigned short bf16;
typedef unsigned v4u __attribute__((ext_vector_type(4)));
typedef float f32x4 __attribute__((ext_vector_type(4)));
typedef short bf16x8 __attribute__((ext_vector_type(8)));
typedef GAS unsigned gu32;
typedef GAS unsigned long long gu64;
#define RLX_AGENT __ATOMIC_RELAXED, __HIP_MEMORY_SCOPE_AGENT
#define LDS_WAIT() asm volatile("s_waitcnt lgkmcnt(0)" ::: "memory")
#define VM_WAIT() asm volatile("s_waitcnt vmcnt(0)" ::: "memory")
__device__ __forceinline__ unsigned long long rt() { return __builtin_amdgcn_s_memrealtime(); }
__device__ __forceinline__ unsigned f2bf(float f) { unsigned u = __builtin_bit_cast(unsigned, f); return (u + 0x7fffu + ((u >> 16) & 1u)) >> 16; }
__device__ __forceinline__ unsigned pk2(float lo, float hi) { return f2bf(lo) | (f2bf(hi) << 16); }

#define XB_TMO      128
#define XB_XCNT(j)  (256  + 64 * (j))
#define XB_XSUB(j)  (1280 + 64 * (j))
#define XB_XGEN(j)  (2304 + 64 * (j))
#define XB_TOP      3328
#define XB_TOPGEN   3392
#define XCD_BAR_WORDS 3456
#define XB_SPIN_CAP (1u << 18)

__device__ __forceinline__ unsigned xb_ld(unsigned* p)              { return __hip_atomic_load(p, __ATOMIC_RELAXED, __HIP_MEMORY_SCOPE_AGENT); }
__device__ __forceinline__ unsigned xb_add(unsigned* p, unsigned v) { return __hip_atomic_fetch_add(p, v, __ATOMIC_RELAXED, __HIP_MEMORY_SCOPE_AGENT); }
__device__ __forceinline__ unsigned xb_xcc_id() { return (unsigned)__builtin_amdgcn_s_getreg((3 << 11) | 20) & 0xFu; }
#define XB_SPIN(cond, bar) do { unsigned _sp = 0; while (cond) { __builtin_amdgcn_s_sleep(1); \
    if ((++_sp & 255u) == 0u) { if (xb_ld(&(bar)[XB_TMO])) break; if (_sp > XB_SPIN_CAP) { atomicAdd(&(bar)[XB_TMO], 1u); break; } } } } while (0)

struct XcdBarrier {
    unsigned* bar; unsigned x;
    volatile LAS unsigned* st;
};

__device__ __forceinline__ XcdBarrier xcd_barrier_post(unsigned* bar, volatile LAS unsigned* st) {
    XcdBarrier b; b.bar = bar; b.x = xb_xcc_id(); b.st = st;
    if (threadIdx.x == 0) (void)xb_add(&bar[XB_XCNT(b.x)], 1u);
    return b;
}
__device__ __forceinline__ void xcd_barrier_complete(unsigned* bar, unsigned x, unsigned& nloc, unsigned& nx) {
    const unsigned G = gridDim.x * gridDim.y * gridDim.z;
    unsigned sum, cnt, mine, sp = 0u;
    for (;;) {
        sum = 0u; cnt = 0u; mine = 0u;
#pragma unroll
        for (unsigned j = 0; j < 16; ++j) { const unsigned c = xb_ld(&bar[XB_XCNT(j)]); sum += c; cnt += (c > 0u) ? 1u : 0u; mine = (j == x) ? c : mine; }
        if (sum == G) break;
        __builtin_amdgcn_s_sleep(1);
        if ((++sp & 255u) == 0u) { if (xb_ld(&bar[XB_TMO])) break; if (sp > XB_SPIN_CAP) { atomicAdd(&bar[XB_TMO], 1u); break; } }
    }
    nloc = mine > 0u ? mine : 1u; nx = cnt > 0u ? cnt : 1u;
}

__device__ __forceinline__ void xcd_barrier(const XcdBarrier& b) {
    asm volatile("s_waitcnt vmcnt(0)" ::: "memory");
    __syncthreads();
    if (threadIdx.x == 0) {
        unsigned* bar = b.bar;
        __builtin_amdgcn_s_waitcnt(0);
        unsigned nloc = b.st[0], nx = b.st[1];
        if (nloc == 0u) { xcd_barrier_complete(bar, b.x, nloc, nx); b.st[0] = nloc; b.st[1] = nx; }
        const unsigned old = xb_add(&bar[XB_XSUB(b.x)], 1u);
        const unsigned gen = old / nloc;
        if (old + 1u == (gen + 1u) * nloc) {
            __builtin_amdgcn_fence(__ATOMIC_RELEASE, "agent");
            asm volatile("s_waitcnt vmcnt(0)" ::: "memory");
            const unsigned og = xb_add(&bar[XB_TOP], 1u);
            const unsigned tg = og / nx;
            if (og + 1u == (tg + 1u) * nx) xb_add(&bar[XB_TOPGEN], 1u);
            else XB_SPIN(xb_ld(&bar[XB_TOPGEN]) == tg, bar);
            __builtin_amdgcn_fence(__ATOMIC_ACQUIRE, "agent");
            xb_add(&bar[XB_XGEN(b.x)], 1u);
            asm volatile("s_waitcnt vmcnt(0)" ::: "memory");
        } else {
            XB_SPIN(xb_ld(&bar[XB_XGEN(b.x)]) == gen, bar);
            __builtin_amdgcn_fence(__ATOMIC_ACQUIRE, "agent");
            asm volatile("s_waitcnt vmcnt(0)" ::: "memory");
        }
    }
    __syncthreads();
}
struct Frame {
    LAS unsigned char* lds;
    volatile LAS unsigned* MISC;
    gu32* ctl;
    int tid, lane, wave;
    int vcu, G;
};
__device__ __forceinline__ int fresh_lane() { int l; asm volatile("v_mbcnt_lo_u32_b32 %0, -1, 0\n\tv_mbcnt_hi_u32_b32 %0, -1, %0" : "=v"(l)); return l; }
__device__ __forceinline__ float wave_sum(float v) {
#pragma unroll
    for (int o = 1; o < 64; o <<= 1) v += __shfl_xor(v, o);
    return v;
}
__device__ __forceinline__ float wave_max(float v) {
#pragma unroll
    for (int o = 1; o < 64; o <<= 1) v = fmaxf(v, __shfl_xor(v, o));
    return v;
}
__device__ __forceinline__ float bf2f(bf16 h) { return __uint_as_float((unsigned)h << 16); }
__device__ __forceinline__ float bf_lo2(unsigned w) { return __uint_as_float(w << 16); }
__device__ __forceinline__ float bf_hi2(unsigned w) { return __uint_as_float(w & 0xffff0000u); }

constexpr int TRP = 68;
__device__ __forceinline__ void tr_item(const float* W, int K, int N, const float* gain, bf16* WT, int k0, int n0dst, int c0src, LAS float* scr, int lane) {
    const int kr = lane >> 4, n4 = lane & 15;
    f32x4 v[16];
#pragma unroll
    for (int i = 0; i < 16; ++i) v[i] = *(const GAS f32x4*)(W + (size_t)(k0 + kr + 4 * i) * N + c0src + 4 * n4);
#pragma unroll
    for (int i = 0; i < 16; ++i) *(LAS f32x4*)(scr + (kr + 4 * i) * TRP + 4 * n4) = v[i];
    LDS_WAIT(); asm volatile("" ::: "memory");
#pragma unroll
    for (int c = 0; c < 8; ++c) { float f[8];
#pragma unroll
        for (int i = 0; i < 8; ++i) f[i] = scr[(8 * c + i) * TRP + lane] * (gain ? gain[k0 + 8 * c + i] : 1.0f);
        v4u o; o.x = pk2(f[0], f[1]); o.y = pk2(f[2], f[3]); o.z = pk2(f[4], f[5]); o.w = pk2(f[6], f[7]);
        *(GAS v4u*)(WT + (size_t)(n0dst + lane) * K + k0 + 8 * c) = o; }
    LDS_WAIT(); asm volatile("" ::: "memory");
}
__device__ __forceinline__ void tr_item_gk(const float* Win, const float* Wup, const float* gain, bf16* WT, int k0, int j0, int lane) {
    float wu[16];
#pragma unroll
    for (int r = 0; r < 16; ++r) wu[r] = Wup[r * 256 + j0 + lane];
#pragma unroll 2
    for (int c = 0; c < 8; ++c) { float f[8];
#pragma unroll
        for (int i = 0; i < 8; ++i) { const int k = k0 + 8 * c + i; const float* wr = Win + (size_t)k * 3088 + 1536; float a = 0.f;
#pragma unroll
            for (int r = 0; r < 16; ++r) a += wr[r] * wu[r];
            f[i] = a * gain[k]; }
        v4u o; o.x = pk2(f[0], f[1]); o.y = pk2(f[2], f[3]); o.z = pk2(f[4], f[5]); o.w = pk2(f[6], f[7]);
        *(GAS v4u*)(WT + (size_t)(1536 + j0 + lane) * 1024 + k0 + 8 * c) = o; }
}
struct Args { const float* in[19]; float* out; unsigned char* ws; int ph_lo, ph_hi, li, pad; };

template <int LIST>
__device__ __forceinline__ void convert_weights(Frame& F, const Args& A, int gw, int NGW) {
    LAS float* scr = (LAS float*)(F.lds + RING_OFF + F.wave * (64 * TRP * 4));
    GAS unsigned char* ws = (GAS unsigned char*)A.ws; asm volatile("" : "+s"(ws));
    const int lane = fresh_lane();
    constexpr int I_GU = 16 * 88, I_D = 44 * 16, I_IN = 16 * 52, I_O = 16 * 16, I_PP = 4 * 16;
    constexpr int NITEMS = LIST == 0 ? I_GU : LIST == 1 ? I_D + I_IN : 2 * I_O + I_GU + I_D + I_PP;
    for (int it = gw; it < NITEMS; it += NGW) {
        int r = it;
        if (LIST == 0) { const int kb = r / 88, nb = r % 88, t = nb >> 2, g = nb & 3; const int src = (g < 2) ? (128 * t + 64 * g) : (FF + 128 * t + 64 * (g - 2));
            tr_item(A.in[3], D, NGU, A.in[2], (bf16*)(ws + WS_WGU1), 64 * kb, 64 * nb, src, scr, lane); }
        if (LIST == 1) {
            if (r < I_D) { const int kb = r / 16, nb = r % 16; tr_item(A.in[4], FF, D, nullptr, (bf16*)(ws + WS_WD1), 64 * kb, 64 * nb, 64 * nb, scr, lane); continue; } r -= I_D;
            { const int kb = r / 52, nb = r % 52;
              if (nb >= 24 && nb < 28) tr_item_gk(A.in[6], A.in[7], A.in[5], (bf16*)(ws + WS_WIN), 64 * kb, 64 * (nb - 24), lane);
              else tr_item(A.in[6], D, 3088, A.in[5], (bf16*)(ws + WS_WIN), 64 * kb, 64 * nb, nb < 24 ? 64 * nb : 64 * nb - 240, scr, lane); } }
        if (LIST == 2) {
            if (r < 2 * I_O) { const int which = r / I_O; r -= which * I_O; const int kb = r / 16, nb = r % 16;
                tr_item(A.in[which ? 15 : 10], D, D, which ? A.in[14] : nullptr, (bf16*)(ws + (which ? WS_WPG : WS_WOUT)), 64 * kb, 64 * nb, 64 * nb, scr, lane); continue; } r -= 2 * I_O;
            if (r < I_GU) { const int kb = r / 88, nb = r % 88, t = nb >> 2, g = nb & 3; const int src = (g < 2) ? (128 * t + 64 * g) : (FF + 128 * t + 64 * (g - 2));
                tr_item(A.in[12], D, NGU, A.in[11], (bf16*)(ws + WS_WGU2), 64 * kb, 64 * nb, src, scr, lane); continue; } r -= I_GU;
            if (r < I_D) { const int kb = r / 16, nb = r % 16; tr_item(A.in[13], FF, D, nullptr, (bf16*)(ws + WS_WD2), 64 * kb, 64 * nb, 64 * nb, scr, lane); continue; } r -= I_D;
            { const int kb = r / 16, nb = r % 16; tr_item(A.in[16], DPLE, D, nullptr, (bf16*)(ws + WS_WPP), 64 * kb, 64 * nb, 64 * nb, scr, lane); } }
    }
}
__device__ __forceinline__ void p0_prologue(Frame& F, const Args& A) {
    const int gw = F.vcu * NWAVES + F.wave, NGW = F.G * NWAVES, lane = fresh_lane();
    convert_weights<0>(F, A, gw, NGW);
    GAS unsigned char* ws = (GAS unsigned char*)A.ws; asm volatile("" : "+s"(ws));
    const float* x = A.in[0]; const float* p = A.in[1];
    bf16* xb = (bf16*)(ws + WS_MIX); bf16* pb = (bf16*)(ws + WS_PB); float* ssq1 = (float*)(ws + WS_SSQ1);
    for (int m0 = gw; m0 < M; m0 += 2 * NGW) {
        f32x4 v[2][4]; f32x4 pv[2]; float sq[2];
#pragma unroll
        for (int u = 0; u < 2; ++u) { const int m = m0 + u * NGW; const GAS f32x4* xr = (const GAS f32x4*)(x + (size_t)m * D) + lane;
#pragma unroll
            for (int j = 0; j < 4; ++j) v[u][j] = xr[64 * j];
            pv[u] = ((const GAS f32x4*)(p + (size_t)m * DPLE))[lane]; }
#pragma unroll
        for (int u = 0; u < 2; ++u) { float s = 0.f;
#pragma unroll
            for (int j = 0; j < 4; ++j) s += (v[u][j].x * v[u][j].x + v[u][j].y * v[u][j].y) + (v[u][j].z * v[u][j].z + v[u][j].w * v[u][j].w);
            sq[u] = wave_sum(s); }
#pragma unroll
        for (int u = 0; u < 2; ++u) { const int m = m0 + u * NGW;
            GAS unsigned long long* o8 = (GAS unsigned long long*)(xb + (size_t)m * D) + lane;
#pragma unroll
            for (int j = 0; j < 4; ++j) o8[64 * j] = (unsigned long long)pk2(v[u][j].x, v[u][j].y) | ((unsigned long long)pk2(v[u][j].z, v[u][j].w) << 32);
            if (lane < 16) ssq1[(size_t)m * 16 + lane] = (lane == 0) ? sq[u] : 0.f;
            ((GAS unsigned long long*)(pb + (size_t)m * DPLE))[lane] = (unsigned long long)pk2(pv[u].x, pv[u].y) | ((unsigned long long)pk2(pv[u].z, pv[u].w) << 32); }
    }
}

__device__ __forceinline__ void moba_kmean(Frame& F, const bf16* U, bf16* kmean) {
    const int gw = F.vcu * NWAVES + F.wave, NGW = F.G * NWAVES, lane = fresh_lane();
    for (int u = gw; u < MH * NBLK; u += NGW) { const int h = u / NBLK, n = u % NBLK; float s = 0.f;
        const bf16* kp = U + (size_t)(n * MBLK) * UWID + U_KM + h * MHD + lane;
#pragma unroll 8
        for (int r = 0; r < MBLK; ++r) s += bf2f(kp[(size_t)r * UWID]);
        kmean[(size_t)u * 64 + lane] = (bf16)f2bf(s * (1.0f / MBLK)); }
}
__device__ __forceinline__ int rel_bucket(int n) { return n < 16 ? n : min(31, 16 + (31 - __clz(n * n)) - 8); }
typedef float f32x16 __attribute__((ext_vector_type(16)));
typedef short v4i16_t __attribute__((ext_vector_type(4)));
__device__ __forceinline__ f32x16 mfma32(bf16x8 a, bf16x8 b, f32x16 c) { return __builtin_amdgcn_mfma_f32_32x32x16_bf16(a, b, c, 0, 0, 0); }
__device__ __forceinline__ v4i16_t lds_tr(LAS unsigned char* p) { return __builtin_amdgcn_ds_read_tr16_b64_v4i16((LAS v4i16_t*)p); }
__device__ __forceinline__ unsigned cvtpk(float lo, float hi) { unsigned r; asm volatile("v_cvt_pk_bf16_f32 %0, %1, %2" : "=v"(r) : "v"(lo), "v"(hi)); return r; }
constexpr int MB_OACC = 0, MB_OP = 65, MB_LACC = 66560, MB_MREF = 67584, MB_CNT = 68608, MB_OFFS = 68864, MB_LIST = 69184, MB_NSEL = 70912, MB_VST = 71680, MB_VP = 144, MB_VSTW = 2 * 32 * MB_VP  , MB_BTAB = MB_VST + 8 * MB_VSTW, MB_NTAB = 3584;
static_assert(MB_BTAB + MB_NTAB * 4 <= LDSCTL_OFF, "MoBA LDS map");
constexpr float LOG2E = 1.4426950408889634f, MB_SC = 0.125f * LOG2E;

template <int MODE>
__device__ __forceinline__ void moba_tile(const bf16* U, int h, int n, int nchunks, int qpos, float& mref, LAS unsigned char* vst, LAS const float* rtab, bool nearblk, float cbias,
                                          f32x16& O0, f32x16& O1, float& lsum, int lane) {
    const int half = lane >> 5, l31 = lane & 31;
    bf16x8 qf[4];
    { const bf16* qp = U + (size_t)qpos * UWID + U_QM + h * 64 + 8 * half;
#pragma unroll
      for (int s = 0; s < 4; ++s) qf[s] = *(const bf16x8*)(qp + 16 * s); }
    const int r8 = lane >> 3, pc = lane & 7;
    const bf16* kp = U + (size_t)(n * MBLK + r8) * UWID + U_KM + h * 64 + pc * 8;
    const bf16* vp = U + (size_t)(n * MBLK + r8) * UWID + U_VM + h * 64 + pc * 8;
    LAS unsigned char* kst = vst + 32 * MB_VP;
    LAS unsigned char* vdst = vst + r8 * MB_VP + pc * 16;
    LAS unsigned char* kdst = kst + r8 * MB_VP + pc * 16;
    LAS const unsigned char* kfp = kst + l31 * MB_VP + 16 * half;
    LAS unsigned char* trb = vst + (4 * half + ((lane & 15) >> 2)) * MB_VP + (16 * ((lane >> 4) & 1) + 4 * (lane & 3)) * 2;
    const int jb = 3327 - qpos + n * MBLK + 4 * half;
    float m = -INFINITY;
    v4u kr[4], kn[4], vr[4], vn[4];
#pragma unroll
    for (int i = 0; i < 4; ++i) { kr[i] = *(const v4u*)(kp + (size_t)(8 * i) * UWID); kn[i] = kr[i]; }
    if (MODE != 0) {
#pragma unroll
        for (int i = 0; i < 4; ++i) { vr[i] = *(const v4u*)(vp + (size_t)(8 * i) * UWID); vn[i] = vr[i]; } }
    for (int ck = 0; ck < nchunks; ++ck) {
#pragma unroll
        for (int i = 0; i < 4; ++i) *(LAS v4u*)(kdst + 8 * i * MB_VP) = kr[i];
        if (MODE != 0) {
#pragma unroll
            for (int i = 0; i < 4; ++i) *(LAS v4u*)(vdst + 8 * i * MB_VP) = vr[i]; }
        if (ck + 1 < nchunks) {
#pragma unroll
            for (int i = 0; i < 4; ++i) kn[i] = *(const v4u*)(kp + (size_t)((ck + 1) * 32 + 8 * i) * UWID);
            if (MODE != 0) {
#pragma unroll
                for (int i = 0; i < 4; ++i) vn[i] = *(const v4u*)(vp + (size_t)((ck + 1) * 32 + 8 * i) * UWID); } }
        bf16x8 kf[4];
#pragma unroll
        for (int s = 0; s < 4; ++s) kf[s] = *(LAS const bf16x8*)(kfp + 32 * s);
        f32x16 S;
#pragma unroll
        for (int r = 0; r < 16; ++r) S[r] = 0.f;
#pragma unroll
        for (int s = 0; s < 4; ++s) S = mfma32(kf[s], qf[s], S);
        float bvv[16];
        if (nearblk) {
#pragma unroll
            for (int r = 0; r < 16; ++r) bvv[r] = rtab[jb + 32 * ck + (r & 3) + 8 * (r >> 2)];
        } else {
#pragma unroll
            for (int r = 0; r < 16; ++r) bvv[r] = cbias;
        }
#pragma unroll
        for (int r = 0; r < 16; ++r) { const int cr = (r & 3) + 8 * (r >> 2);
            float y = S[r] * MB_SC + bvv[r];
            if (MODE != 2) { const int dist = qpos - (n * MBLK + 32 * ck + 4 * half + cr); if (dist < 0) y = -INFINITY; }
            if (MODE == 0) m = fmaxf(m, y);
            else { const float p = __builtin_amdgcn_exp2f(y - mref); lsum += p; S[r] = p; } }
        if (MODE != 0) {
            bf16x8 pf0, pf1;
            { v4u w0, w1; w0.x = cvtpk(S[0], S[1]); w0.y = cvtpk(S[2], S[3]); w0.z = cvtpk(S[4], S[5]); w0.w = cvtpk(S[6], S[7]);
              w1.x = cvtpk(S[8], S[9]); w1.y = cvtpk(S[10], S[11]); w1.z = cvtpk(S[12], S[13]); w1.w = cvtpk(S[14], S[15]);
              pf0 = __builtin_bit_cast(bf16x8, w0); pf1 = __builtin_bit_cast(bf16x8, w1); }
#pragma unroll
            for (int sp = 0; sp < 2; ++sp)
#pragma unroll
                for (int dt = 0; dt < 2; ++dt) {
                    const v4i16_t lo = lds_tr(trb + sp * 16 * MB_VP + dt * 64), hi = lds_tr(trb + sp * 16 * MB_VP + dt * 64 + 8 * MB_VP);
                    const bf16x8 a = (bf16x8){lo[0], lo[1], lo[2], lo[3], hi[0], hi[1], hi[2], hi[3]};
                    if (dt == 0) O0 = mfma32(a, sp ? pf1 : pf0, O0); else O1 = mfma32(a, sp ? pf1 : pf0, O1); }
        }
#pragma unroll
        for (int i = 0; i < 4; ++i) kr[i] = kn[i];
        if (MODE != 0) {
#pragma unroll
            for (int i = 0; i < 4; ++i) vr[i] = vn[i]; }
    }
    if (MODE == 0) mref = fmaxf(m, __shfl_xor(m, 32));
}

typedef unsigned u32x2 __attribute__((ext_vector_type(2)));
#define MPARGS GAS bf16* Po00, GAS bf16* Po01, GAS bf16* Po10, GAS bf16* Po11, GAS bf16* Po20, GAS bf16* Po21, GAS float* Pl
#define MPPASS Po00, Po01, Po10, Po11, Po20, Po21, Pl
__device__ __forceinline__ void moba_unit(Frame& F, const bf16* U, const bf16* kmb, const float* relb, bf16* mix, MPARGS, int h, int b) {
    const int lane = fresh_lane(), wave = F.wave, half = lane >> 5, l31 = lane & 31, tid = wave * 64 + lane;
    LAS unsigned char* L = F.lds + RING_OFF;
    LAS float* oacc = (LAS float*)(L + MB_OACC); LAS float* lacc = (LAS float*)(L + MB_LACC); LAS float* mrefs = (LAS float*)(L + MB_MREF);
    LAS int* cnt = (LAS int*)(L + MB_CNT); LAS int* offs = (LAS int*)(L + MB_OFFS); LAS unsigned short* list = (LAS unsigned short*)(L + MB_LIST); LAS unsigned char* nsel = L + MB_NSEL;
    LAS unsigned char* vst = L + MB_VST + wave * MB_VSTW; LAS const float* rtab = (LAS const float*)(L + MB_BTAB);
    const float cbias = relb[31 * 8 + h] * LOG2E;
    if (tid < 64) cnt[tid] = 0;
    for (int j = tid; j < MB_NTAB; j += NWAVES * 64) { const int dist = 3327 - j; ((LAS float*)(L + MB_BTAB))[j] = relb[rel_bucket(dist < 0 ? 0 : dist) * 8 + h] * LOG2E; }
    __syncthreads();
    const int qi = wave * 32 + l31, qpos = b * MBLK + qi;
    float g0 = -INFINITY, g1 = -INFINITY, g2 = -INFINITY; int i0 = -1, i1 = -1, i2 = -1;
    if (b > 0) {
        bf16x8 qf[4];
        { const bf16* qp = U + (size_t)qpos * UWID + U_QM + h * 64 + 8 * half;
#pragma unroll
          for (int s = 0; s < 4; ++s) qf[s] = *(const bf16x8*)(qp + 16 * s); }
#pragma unroll
        for (int nt = 0; nt < 2; ++nt) if (32 * nt < b) {
            const bf16* ap = kmb + (size_t)(h * NBLK + 32 * nt + l31) * 64 + 8 * half;
            f32x16 G;
#pragma unroll
            for (int r = 0; r < 16; ++r) G[r] = 0.f;
#pragma unroll
            for (int s = 0; s < 4; ++s) G = mfma32(*(const bf16x8*)(ap + 16 * s), qf[s], G);
#pragma unroll
            for (int r = 0; r < 16; ++r) { const int nn = 32 * nt + (r & 3) + 8 * (r >> 2) + 4 * half; const float v = (nn < b) ? G[r] : -INFINITY;
                if (v > g0) { g2 = g1; i2 = i1; g1 = g0; i1 = i0; g0 = v; i0 = nn; }
                else if (v > g1) { g2 = g1; i2 = i1; g1 = v; i1 = nn; }
                else if (v > g2) { g2 = v; i2 = nn; } }
        }
        float pg[3]; int pi[3];
        pg[0] = __shfl_xor(g0, 32); pg[1] = __shfl_xor(g1, 32); pg[2] = __shfl_xor(g2, 32); pi[0] = __shfl_xor(i0, 32); pi[1] = __shfl_xor(i1, 32); pi[2] = __shfl_xor(i2, 32);
#pragma unroll
        for (int k = 0; k < 3; ++k) { const float v = pg[k]; const int nn = pi[k];
            if (nn >= 0) {
                if (v > g0 || (v == g0 && nn < i0)) { g2 = g1; i2 = i1; g1 = g0; i1 = i0; g0 = v; i0 = nn; }
                else if (v > g1 || (v == g1 && nn < i1)) { g2 = g1; i2 = i1; g1 = v; i1 = nn; }
                else if (v > g2 || (v == g2 && nn < i2)) { g2 = v; i2 = nn; } } }
    }
    int r0 = 0, r1 = 0, r2 = 0;
    if (half == 0) { if (i0 >= 0) r0 = __hip_atomic_fetch_add(cnt + i0, 1, __ATOMIC_RELAXED, __HIP_MEMORY_SCOPE_WORKGROUP); if (i1 >= 0) r1 = __hip_atomic_fetch_add(cnt + i1, 1, __ATOMIC_RELAXED, __HIP_MEMORY_SCOPE_WORKGROUP); if (i2 >= 0) r2 = __hip_atomic_fetch_add(cnt + i2, 1, __ATOMIC_RELAXED, __HIP_MEMORY_SCOPE_WORKGROUP); }
    __syncthreads();
    if (wave == 0) { const int c = cnt[lane]; int inc = c;
#pragma unroll
        for (int o = 1; o < 64; o <<= 1) { const int t = __shfl_up(inc, o); if (lane >= o) inc += t; }
        offs[lane] = inc - c; }
    __syncthreads();
    if (half == 0) { if (i0 >= 0) list[offs[i0] + r0] = (unsigned short)qi; if (i1 >= 0) list[offs[i1] + r1] = (unsigned short)(qi | 0x100); if (i2 >= 0) list[offs[i2] + r2] = (unsigned short)(qi | 0x200);
                      nsel[qi] = (unsigned char)((i0 >= 0) + (i1 >= 0) + (i2 >= 0)); }
    {
        float mref = 0.f, lsum = 0.f; f32x16 O0, O1;
#pragma unroll
        for (int r = 0; r < 16; ++r) { O0[r] = 0.f; O1[r] = 0.f; }
        moba_tile<0>(U, h, b, wave + 1, qpos, mref, vst, rtab, true, cbias, O0, O1, lsum, lane);
        moba_tile<1>(U, h, b, wave + 1, qpos, mref, vst, rtab, true, cbias, O0, O1, lsum, lane);
#pragma unroll
        for (int r = 0; r < 16; ++r) { const int d = (r & 3) + 8 * (r >> 2) + 4 * half; oacc[qi * MB_OP + d] = O0[r]; oacc[qi * MB_OP + 32 + d] = O1[r]; }
        lsum += __shfl_xor(lsum, 32);
        if (half == 0) { lacc[qi] = lsum; mrefs[qi] = mref; }
    }
    __syncthreads();
    { int tcount = 0;
      for (int n = 0; n < b; ++n) { const int c = __builtin_amdgcn_readfirstlane(cnt[n]), o = __builtin_amdgcn_readfirstlane(offs[n]);
        for (int t0 = 0; t0 < c; t0 += 32, ++tcount) { if ((tcount & 7) != wave) continue;
            const bool qv = (t0 + l31) < c; const int ge = list[o + (qv ? t0 + l31 : 0)]; const int gq = ge & 255, slot = ge >> 8; const int gpos = b * MBLK + gq;
            float mref = mrefs[gq], lsum = 0.f; f32x16 O0, O1;
#pragma unroll
            for (int r = 0; r < 16; ++r) { O0[r] = 0.f; O1[r] = 0.f; }
            moba_tile<2>(U, h, n, 8, gpos, mref, vst, rtab, (b - n) <= 12, cbias, O0, O1, lsum, lane);
            lsum += __shfl_xor(lsum, 32);
            if (qv) { const size_t row = (size_t)gpos * 8 + h;
                GAS bf16* p0 = (slot == 0 ? Po00 : slot == 1 ? Po10 : Po20) + row * 32 + 4 * half;
                GAS bf16* p1 = (slot == 0 ? Po01 : slot == 1 ? Po11 : Po21) + row * 32 + 4 * half;
#pragma unroll
                for (int rg = 0; rg < 4; ++rg) { u32x2 w0, w1; w0.x = cvtpk(O0[4 * rg], O0[4 * rg + 1]); w0.y = cvtpk(O0[4 * rg + 2], O0[4 * rg + 3]); w1.x = cvtpk(O1[4 * rg], O1[4 * rg + 1]); w1.y = cvtpk(O1[4 * rg + 2], O1[4 * rg + 3]);
                    *(GAS u32x2*)(p0 + 8 * rg) = w0; *(GAS u32x2*)(p1 + 8 * rg) = w1; }
                if (half == 0) Pl[row * 4 + slot] = lsum; }
        } } }
    __syncthreads();
    { const int q = tid >> 1, dh = tid & 1; const int ns = nsel[q]; const size_t row = (size_t)(b * MBLK + q) * 8 + h; LAS const float* op = oacc + q * MB_OP + 32 * dh;
      float acc[32]; float l = lacc[q];
#pragma unroll
      for (int i = 0; i < 32; ++i) acc[i] = op[i];
#pragma unroll
      for (int j = 0; j < 3; ++j) if (j < ns) { const GAS bf16* pp = (j == 0 ? (dh ? Po01 : Po00) : j == 1 ? (dh ? Po11 : Po10) : (dh ? Po21 : Po20)) + row * 32; l += Pl[row * 4 + j];
#pragma unroll
          for (int i = 0; i < 4; ++i) { const v4u w = *(const GAS v4u*)(pp + 8 * i);
              acc[8 * i + 0] += bf_lo2(w.x); acc[8 * i + 1] += bf_hi2(w.x); acc[8 * i + 2] += bf_lo2(w.y); acc[8 * i + 3] += bf_hi2(w.y);
              acc[8 * i + 4] += bf_lo2(w.z); acc[8 * i + 5] += bf_hi2(w.z); acc[8 * i + 6] += bf_lo2(w.w); acc[8 * i + 7] += bf_hi2(w.w); } }
      const float inv = 1.0f / l;
      bf16* dst = mix + (size_t)(b * MBLK + q) * D + 512 + h * 64 + 32 * dh;
#pragma unroll
      for (int i = 0; i < 4; ++i) { v4u w; w.x = pk2(acc[8 * i] * inv, acc[8 * i + 1] * inv); w.y = pk2(acc[8 * i + 2] * inv, acc[8 * i + 3] * inv); w.z = pk2(acc[8 * i + 4] * inv, acc[8 * i + 5] * inv); w.w = pk2(acc[8 * i + 6] * inv, acc[8 * i + 7] * inv);
          *(GAS v4u*)(dst + 8 * i) = w; } }
    __syncthreads();
}
__device__ __forceinline__ void moba_phase(Frame& F, const bf16* U, const bf16* kmb, const float* relb, bf16* mix, MPARGS) {
    const int h = F.vcu >> 5, bb = F.vcu & 31;
    if (F.G != 256) return;
    moba_unit(F, U, kmb, relb, mix, MPPASS, h, bb);
    moba_unit(F, U, kmb, relb, mix, MPPASS, h, 63 - bb);
}
constexpr int GA_KD = 0, GA_KDP = 160, GA_V = 40960, GA_VP = 288, GA_SEG = GA_V + 256 * GA_VP;
constexpr int GC_KE = 0, GC_KEP = 144, GC_V = 36864, GC_VP = 288, GC_SST = GC_V + 256 * GC_VP, GC_SSTP = 144;
static_assert(GA_SEG + 2048 <= RING_BYTES && GC_SST + 128 * GC_SSTP <= RING_BYTES, "GLA LDS map");
__device__ __forceinline__ bf16x8 tr_pair(LAS unsigned char* p, int second_off) { const v4i16_t lo = lds_tr(p), hi = lds_tr(p + second_off); return (bf16x8){lo[0], lo[1], lo[2], lo[3], hi[0], hi[1], hi[2], hi[3]}; }

__device__ __forceinline__ void gla_A(Frame& F, const bf16* U, float* loga, float* dS, float* dec) {
    if (F.G != 256) return;
    const int c = F.vcu >> 2, h = F.vcu & 3, lane = fresh_lane(), wave = F.wave, tid = wave * 64 + lane;
    LAS unsigned char* L = F.lds + RING_OFF; LAS float* segtot = (LAS float*)(L + GA_SEG);
    const int d = lane, seg = wave, t0 = c * 256 + seg * 32;
    float bl[32]; float run = 0.f;
#pragma unroll
    for (int i = 0; i < 32; ++i) { run += loga[(size_t)(t0 + i) * 256 + h * 64 + d]; bl[i] = run; }
    segtot[seg * 64 + d] = run;
#pragma unroll
    for (int i = 0; i < 8; ++i) { const int p = tid + 512 * i, row = p >> 4, ch = p & 15;
        *(LAS v4u*)(L + GA_V + row * GA_VP + ch * 16) = *(const v4u*)(U + (size_t)(c * 256 + row) * UWID + U_VG + h * 128 + ch * 8); }
    __syncthreads();
    float pre = 0.f, tot = 0.f;
#pragma unroll
    for (int s = 0; s < 8; ++s) { const float v = segtot[s * 64 + d]; tot += v; if (s < seg) pre += v; }
#pragma unroll
    for (int i = 0; i < 32; ++i) { const float b = bl[i] + pre; loga[(size_t)(t0 + i) * 256 + h * 64 + d] = b;
        const float kk = bf2f(U[(size_t)(t0 + i) * UWID + U_KG + h * 64 + d]);
        *(LAS bf16*)(L + GA_KD + (seg * 32 + i) * GA_KDP + d * 2) = (bf16)f2bf(kk * __expf(tot - b)); }
    if (seg == 0) dec[(size_t)(c * 4 + h) * 64 + d] = __expf(tot);
    __syncthreads();
    const int et = wave >> 1, dt = wave & 1, half = lane >> 5, l31 = lane & 31, g1 = (lane >> 4) & 1, q = (lane & 15) >> 2, p = lane & 3;
    LAS unsigned char* trA = L + GA_V + (4 * half + q) * GA_VP + (32 * et + 16 * g1 + 4 * p) * 2;
    LAS unsigned char* trB = L + GA_KD + (4 * half + q) * GA_KDP + (32 * dt + 16 * g1 + 4 * p) * 2;
    f32x16 acc;
#pragma unroll
    for (int r = 0; r < 16; ++r) acc[r] = 0.f;
#pragma unroll 4
    for (int s = 0; s < 16; ++s) { const bf16x8 a = tr_pair(trA + s * 16 * GA_VP, 8 * GA_VP), b = tr_pair(trB + s * 16 * GA_KDP, 8 * GA_KDP); acc = mfma32(a, b, acc); }
    float* dst = dS + (size_t)(c * 4 + h) * 8192;
#pragma unroll
    for (int r = 0; r < 16; ++r) { const int e = 32 * et + (r & 3) + 8 * (r >> 2) + 4 * half; dst[e * 64 + 32 * dt + l31] = acc[r]; }
    __syncthreads();
}
__device__ __forceinline__ void gla_scan(Frame& F, const float* dS, const float* dec, bf16* Sst) {
    const int lane = fresh_lane(), tid = F.wave * 64 + lane;
    if (tid >= 128 || F.G != 256) return;
    const int idx = F.vcu * 128 + tid, h = idx >> 13, d = idx & 63, el = idx & 8191;
    float S = 0.f;
#pragma unroll 1
    for (int c0 = 0; c0 < 64; c0 += 32) {
        float ds[32], dc[32];
#pragma unroll
        for (int c = 0; c < 32; ++c) { ds[c] = dS[(size_t)((c0 + c) * 4 + h) * 8192 + el]; dc[c] = dec[(size_t)((c0 + c) * 4 + h) * 64 + d]; }
#pragma unroll
        for (int c = 0; c < 32; ++c) { Sst[(size_t)((c0 + c) * 4 + h) * 8192 + el] = (bf16)f2bf(S); S = dc[c] * S + ds[c]; }
    }
}
__device__ __forceinline__ void gla_C(Frame& F, const bf16* U, const float* bcum, const bf16* Sst, const float* gain, bf16* mix) {
    if (F.G != 256) return;
    const int c = F.vcu >> 2, h = F.vcu & 3, lane = fresh_lane(), wave = F.wave, tid = wave * 64 + lane;
    LAS unsigned char* L = F.lds + RING_OFF;
    { const int d = lane, seg = wave, t0 = c * 256 + seg * 32;
#pragma unroll 8
      for (int i = 0; i < 32; ++i) { const float b = bcum[(size_t)(t0 + i) * 256 + h * 64 + d]; const float kk = bf2f(U[(size_t)(t0 + i) * UWID + U_KG + h * 64 + d]);
          *(LAS bf16*)(L + GC_KE + (seg * 32 + i) * GC_KEP + d * 2) = (bf16)f2bf(kk * __expf(-b)); } }
#pragma unroll
    for (int i = 0; i < 8; ++i) { const int p = tid + 512 * i, row = p >> 4, ch = p & 15;
        *(LAS v4u*)(L + GC_V + row * GC_VP + ch * 16) = *(const v4u*)(U + (size_t)(c * 256 + row) * UWID + U_VG + h * 128 + ch * 8); }
#pragma unroll
    for (int i = 0; i < 2; ++i) { const int p = tid + 512 * i, row = p >> 3, ch = p & 7;
        *(LAS v4u*)(L + GC_SST + row * GC_SSTP + ch * 16) = *(const v4u*)(Sst + (size_t)((c * 4 + h) * 128 + row) * 64 + ch * 8); }
    __syncthreads();
    const int half = lane >> 5, l31 = lane & 31, g1 = (lane >> 4) & 1, q = (lane & 15) >> 2, p = lane & 3;
    const size_t tok = (size_t)c * 256 + wave * 32 + l31;
    bf16x8 qf[4];
#pragma unroll
    for (int s = 0; s < 4; ++s) { const v4u q8 = *(const v4u*)(U + tok * UWID + U_QG + h * 64 + 16 * s + 8 * half);
        const f32x4 b0 = *(const f32x4*)(bcum + tok * 256 + h * 64 + 16 * s + 8 * half), b1 = *(const f32x4*)(bcum + tok * 256 + h * 64 + 16 * s + 8 * half + 4);
        v4u w; w.x = cvtpk(bf_lo2(q8.x) * __expf(b0[0]), bf_hi2(q8.x) * __expf(b0[1])); w.y = cvtpk(bf_lo2(q8.y) * __expf(b0[2]), bf_hi2(q8.y) * __expf(b0[3]));
        w.z = cvtpk(bf_lo2(q8.z) * __expf(b1[0]), bf_hi2(q8.z) * __expf(b1[1])); w.w = cvtpk(bf_lo2(q8.w) * __expf(b1[2]), bf_hi2(q8.w) * __expf(b1[3]));
        qf[s] = __builtin_bit_cast(bf16x8, w); }
    f32x16 O[4];
#pragma unroll
    for (int et = 0; et < 4; ++et)
#pragma unroll
        for (int r = 0; r < 16; ++r) O[et][r] = 0.f;
#pragma unroll
    for (int et = 0; et < 4; ++et)
#pragma unroll
        for (int s = 0; s < 4; ++s) O[et] = mfma32(*(LAS const bf16x8*)(L + GC_SST + (32 * et + l31) * GC_SSTP + (16 * s + 8 * half) * 2), qf[s], O[et]);
    LAS unsigned char* trV = L + GC_V + (4 * half + q) * GC_VP + (16 * g1 + 4 * p) * 2;
    for (int jt = 0; jt <= wave; ++jt) {
        f32x16 ST;
#pragma unroll
        for (int r = 0; r < 16; ++r) ST[r] = 0.f;
#pragma unroll
        for (int s = 0; s < 4; ++s) ST = mfma32(*(LAS const bf16x8*)(L + GC_KE + (32 * jt + l31) * GC_KEP + (16 * s + 8 * half) * 2), qf[s], ST);
        if (jt == wave) {
#pragma unroll
            for (int r = 0; r < 16; ++r) { const int jl = (r & 3) + 8 * (r >> 2) + 4 * half; if (jl > l31) ST[r] = 0.f; } }
        bf16x8 pf0, pf1;
        { v4u w0, w1; w0.x = cvtpk(ST[0], ST[1]); w0.y = cvtpk(ST[2], ST[3]); w0.z = cvtpk(ST[4], ST[5]); w0.w = cvtpk(ST[6], ST[7]);
          w1.x = cvtpk(ST[8], ST[9]); w1.y = cvtpk(ST[10], ST[11]); w1.z = cvtpk(ST[12], ST[13]); w1.w = cvtpk(ST[14], ST[15]);
          pf0 = __builtin_bit_cast(bf16x8, w0); pf1 = __builtin_bit_cast(bf16x8, w1); }
#pragma unroll
        for (int sp = 0; sp < 2; ++sp)
#pragma unroll
            for (int et = 0; et < 4; ++et) { const bf16x8 a = tr_pair(trV + (32 * jt + 16 * sp) * GC_VP + et * 64, 8 * GC_VP); O[et] = mfma32(a, sp ? pf1 : pf0, O[et]); }
    }
    float ss = 0.f;
#pragma unroll
    for (int et = 0; et < 4; ++et)
#pragma unroll
        for (int r = 0; r < 16; ++r) ss += O[et][r] * O[et][r];
    ss += __shfl_xor(ss, 32);
    const float rs = 1.0f / sqrtf(ss * (1.0f / 128.0f) + EPS);
#pragma unroll
    for (int et = 0; et < 4; ++et)
#pragma unroll
        for (int rg = 0; rg < 4; ++rg) { const int e0 = 32 * et + 8 * rg + 4 * half;
            const uint2 gw = *(const uint2*)(U + tok * UWID + U_GG + h * 128 + e0); const f32x4 gn = *(const f32x4*)(gain + e0);
            const float g0 = bf_lo2(gw.x), g1v = bf_hi2(gw.x), g2 = bf_lo2(gw.y), g3 = bf_hi2(gw.y);
            const float y0 = O[et][4 * rg + 0] * rs * gn[0] * (g0 / (1.0f + __expf(-g0))), y1 = O[et][4 * rg + 1] * rs * gn[1] * (g1v / (1.0f + __expf(-g1v)));
            const float y2 = O[et][4 * rg + 2] * rs * gn[2] * (g2 / (1.0f + __expf(-g2))), y3 = O[et][4 * rg + 3] * rs * gn[3] * (g3 / (1.0f + __expf(-g3)));
            uint2 o; o.x = cvtpk(y0, y1); o.y = cvtpk(y2, y3);
            *(uint2*)(mix + tok * D + h * 128 + e0) = o; }
    __syncthreads();
}
__device__ __forceinline__ void final_norm(Frame& F, float* out, const float* ssqp, const float* gain) {
    const int gw = F.vcu * NWAVES + F.wave, NGW = F.G * NWAVES, lane = fresh_lane();
    for (int m = gw; m < M; m += NGW) {
        float s = (lane < 16) ? ssqp[(size_t)m * 16 + lane] : 0.f; s = wave_sum(s);
        const float rs = 1.0f / sqrtf(s * (1.0f / 1024.0f) + EPS);
        GAS f32x4* xr = (GAS f32x4*)(out + (size_t)m * D) + lane;
#pragma unroll
        for (int j = 0; j < 4; ++j) { f32x4 v = xr[64 * j]; const f32x4 g = ((const GAS f32x4*)gain)[lane + 64 * j]; v = v * rs * g; xr[64 * j] = v; }
    }
}
struct PpOrder { int c, nu;
    __device__ __forceinline__ bool next(int i, pg8::Unit& u) const { if (c < 128 || i >= nu) return false; const int L = (c - 128) + 128 * i; u.pm = L >> 2; u.pn = L & 3; return true; }
    __device__ __forceinline__ void a_ready(const pg8::Unit&) const {}
    __device__ __forceinline__ void done(const pg8::Unit&) const {} };
__global__ void __launch_bounds__(NWAVES * 64, 2) mega_fwd(Args args) {
    extern __shared__ __attribute__((aligned(16))) unsigned char lds[];
    Frame F;
    F.lds = (LAS unsigned char*)lds;
    F.MISC = (volatile LAS unsigned*)(F.lds + MISC_OFF);
    F.tid = threadIdx.x; F.lane = F.tid & 63; F.wave = __builtin_amdgcn_readfirstlane(F.tid >> 6);
    F.G = gridDim.x; { const int bx = blockIdx.x; F.vcu = (F.G % 8 == 0) ? (bx % 8) * (F.G / 8) + bx / 8 : bx; }
    unsigned char* ws = args.ws;
    F.ctl = (gu32*)(ws + WS_CTL);
    for (int u = F.tid; u < (LDS_BYTES - LDSCTL_OFF) / 4; u += NWAVES * 64) ((LAS unsigned*)(F.lds + LDSCTL_OFF))[u] = 0u;
    __syncthreads();
    XcdBarrier bar; bar.bar = (unsigned*)(F.ctl + CW_BAR); bar.x = 0; bar.st = nullptr;
    if (N_LAUNCHES != N_PHASES) bar = xcd_barrier_post((unsigned*)(F.ctl + CW_BAR), F.MISC + 8);
#define GRID_BAR() do { if (N_LAUNCHES == N_PHASES) { if (F.tid == 0) __hip_atomic_store(F.ctl + CW_TMO, 0xBADBA0u, RLX_AGENT); } else { xcd_barrier(bar); } } while (0)
    const int lo = args.ph_lo, hi = args.ph_hi;
#define IN(k) (lo <= (k) && (k) < hi)
#define BOTH(k) (IN(k) && IN((k) + 1))
    using pg8::Gemm; using pg8::StaticOrder;
#define RUN_GEMM(EPI, A_, B_, N_, K_, ...) do { Gemm g{A_, B_, M, N_, K_}; StaticOrder S; S.init(M, N_, F.G, (int)blockIdx.x); pg8::EPI E{__VA_ARGS__}; \
        pg8::gemm_phase<pg8::EPI, StaticOrder, PG8_ALIGN, PG8_SP2>(F.lds + RING_OFF, g, S, E); } while (0)
#define WSB() GAS unsigned char* w_ = (GAS unsigned char*)args.ws; GAS float* out_ = (GAS float*)args.out; asm volatile("" : "+s"(w_), "+s"(out_)); float* out = (float*)out_
#define PB16(off) ((bf16*)(w_ + (off)))
#define PF32(off) ((float*)(w_ + (off)))
#define PHASE(k, ...) if (IN(k)) { WSB(); __VA_ARGS__; if (BOTH(k)) GRID_BAR(); }
    PHASE(0, p0_prologue(F, args))
    PHASE(1, RUN_GEMM(EpiSwiGLU, PB16(WS_MIX), PB16(WS_WGU1), NGU, D, PB16(WS_U), FF, PF32(WS_SSQ1));
             if (F.G == 256 && blockIdx.x >= 128) convert_weights<1>(F, args, ((int)blockIdx.x - 128) * NWAVES + F.wave, 128 * NWAVES); else if (F.G != 256) convert_weights<1>(F, args, F.vcu * NWAVES + F.wave, F.G * NWAVES))
    PHASE(2, RUN_GEMM(EpiResid<1>, PB16(WS_U), PB16(WS_WD1), D, FF, args.in[0], out, PB16(WS_HB), PF32(WS_SSQ2)))
    PHASE(3, RUN_GEMM(EpiWin, PB16(WS_HB), PB16(WS_WIN), UWID, D, PB16(WS_U), PF32(WS_LOGA), PF32(WS_SSQ2), args.in[8]);
             if (F.G == 256 && blockIdx.x >= 64) convert_weights<2>(F, args, ((int)blockIdx.x - 64) * NWAVES + F.wave, 192 * NWAVES); else if (F.G != 256) convert_weights<2>(F, args, F.vcu * NWAVES + F.wave, F.G * NWAVES))
    PHASE(4, moba_kmean(F, PB16(WS_U), PB16(WS_KMEAN)); gla_A(F, PB16(WS_U), PF32(WS_LOGA), PF32(WS_HB), PF32(WS_HB + 12 * MiB)))
    PHASE(5, gla_scan(F, PF32(WS_HB), PF32(WS_HB + 12 * MiB), PB16(WS_HB + 8 * MiB)); moba_phase(F, PB16(WS_U), PB16(WS_KMEAN), args.in[17], PB16(WS_MIX), (GAS bf16*)(w_ + 1 * MiB), (GAS bf16*)(w_ + 9 * MiB), (GAS bf16*)(w_ + 67 * MiB), (GAS bf16*)(w_ + 75 * MiB), (GAS bf16*)(w_ + 17 * MiB), (GAS bf16*)(w_ + 246 * MiB), (GAS float*)(w_ + 254 * MiB)))
    PHASE(6, gla_C(F, PB16(WS_U), PF32(WS_LOGA), PB16(WS_HB + 8 * MiB), args.in[9], PB16(WS_MIX)))
    PHASE(7, RUN_GEMM(EpiResid<0>, PB16(WS_MIX), PB16(WS_WOUT), D, D, out, out, PB16(WS_HB), PF32(WS_SSQ3)))
    PHASE(8, RUN_GEMM(EpiSwiGLU, PB16(WS_HB), PB16(WS_WGU2), NGU, D, PB16(WS_U), FF, PF32(WS_SSQ3));
             { int kpp = DPLE, two = 2; asm volatile("" : "+s"(kpp), "+s"(two)); Gemm g{PB16(WS_PB), PB16(WS_WPP), M, D, kpp}; PpOrder S{F.G == 256 ? (int)blockIdx.x : -1, two}; pg8::EpiPlain E{PB16(WS_PP)}; pg8::gemm_phase<pg8::EpiPlain, PpOrder, PG8_ALIGN, PG8_SP2>(F.lds + RING_OFF, g, S, E); })
    PHASE(9, RUN_GEMM(EpiResid<1>, PB16(WS_U), PB16(WS_WD2), D, FF, out, out, PB16(WS_HB), PF32(WS_SSQ4)))
    PHASE(10, RUN_GEMM(EpiPle, PB16(WS_HB), PB16(WS_WPG), D, D, out, out, PB16(WS_PP), PF32(WS_SSQ4), PF32(WS_SSQ5)))
    if (IN(11)) { WSB(); final_norm(F, out, PF32(WS_SSQ5), args.in[18]); }
#undef IN
#undef BOTH
}

extern "C" void kernel_launch(void* const* d_in, const int* in_sizes, int n_in, void* d_out, int out_size, void* d_ws, size_t ws_size, hipStream_t stream) {
    static int grid = 0;
    if (grid == 0) {
        if (n_in != 19 || in_sizes[0] != M * D || out_size != M * D || ws_size < WS_END) { fprintf(stderr, "kernel_launch: unexpected shapes (n_in %d, in0 %d, out %d, ws %zu); nothing launched\n", n_in, n_in > 0 ? in_sizes[0] : -1, out_size, ws_size); grid = -1; return; }
        int dev = 0, cus = 0, per_cu = 0;
        if (hipGetDevice(&dev) != hipSuccess || hipDeviceGetAttribute(&cus, hipDeviceAttributeMultiprocessorCount, dev) != hipSuccess) { grid = -1; return; }
        if (hipFuncSetAttribute((const void*)mega_fwd, hipFuncAttributeMaxDynamicSharedMemorySize, LDS_BYTES) != hipSuccess) { fprintf(stderr, "kernel_launch: hipFuncSetAttribute failed\n"); grid = -1; return; }
        if (hipOccupancyMaxActiveBlocksPerMultiprocessor(&per_cu, (const void*)mega_fwd, NWAVES * 64, LDS_BYTES) != hipSuccess || per_cu < 1) { fprintf(stderr, "kernel_launch: occupancy query reports %d workgroups per CU\n", per_cu); }
        (void)hipGetLastError();
        grid = cus;
    }
    if (grid < 0) return;
    if (hipMemsetAsync((char*)d_ws + WS_CTL, 0, CTL_ZERO_BYTES, stream) != hipSuccess) { fprintf(stderr, "kernel_launch: hipMemsetAsync failed\n"); return; }
    Args a{};
    for (int i = 0; i < 19; ++i) a.in[i] = (const float*)d_in[i];
    a.out = (float*)d_out; a.ws = (unsigned char*)d_ws;
    for (int li = 0; li < N_LAUNCHES; ++li) {
        if (N_LAUNCHES == 1) { a.ph_lo = 0; a.ph_hi = N_PHASES; } else { a.ph_lo = li; a.ph_hi = li + 1; }
        a.li = li;
        hipLaunchKernelGGL(mega_fwd, dim3(grid), dim3(NWAVES * 64), LDS_BYTES, stream, a);
        const hipError_t le = hipPeekAtLastError();
        if (le != hipSuccess) { fprintf(stderr, "kernel_launch: launch %d failed: %s\n", li, hipGetErrorName(le)); break; }
    }
}
```

```cpp
#include <hip/hip_runtime.h>
#include <cstdio>
#include <cstdint>
namespace pg8 {
#define PG8_LAS __attribute__((address_space(3)))
typedef unsigned short bf16_t;
typedef short bf16x8 __attribute__((ext_vector_type(8)));
typedef float f32x4 __attribute__((ext_vector_type(4)));
typedef unsigned u32x4 __attribute__((ext_vector_type(4)));
constexpr int BM = 256, BK = 64, HALF = 128, HTB = HALF * BK * 2  , STAGE_BYTES = 8 * HTB, NXCD = 8, WGM = 8;

__host__ __device__ __forceinline__ int lds_byte(int r, int c) { const int st = (r >> 4) * 2 + (c >> 5), rr = r & 15, cc = c & 31, ob = rr * 64 + cc * 2; return st * 1024 + (ob ^ (((ob >> 9) & 1) << 5)); }
__host__ __device__ __forceinline__ void stage_rc(int b, int& R, int& C) { const int st = b / 1024, sb = b % 1024, swz = sb ^ (((sb >> 9) & 1) << 5); R = (st >> 1) * 16 + swz / 64; C = (st & 1) * 32 + (swz % 64) / 2; }
__host__ __device__ __forceinline__ int perm32(int rho) { const int n = rho >> 4, i = rho & 15; return 8 * (i >> 2) + 4 * n + (i & 3); }

struct Unit { int pm, pn; };
struct Gemm { const bf16_t* A; const bf16_t* Bt; int M, N, K; };

struct StaticOrder {
    int nM, nN, nwg, G, c;
    __host__ __device__ void init(int M, int N, int G_, int c_) { nM = M / BM; nN = N / BM; nwg = nM * nN; G = G_; c = c_; }
    __host__ __device__ bool next(int i, Unit& u) const {
        const long L = (long)i * G + c; if (L >= nwg) return false;
        int wgid = (int)L; { const int q = nwg / NXCD, r = nwg % NXCD, xcd = wgid % NXCD, off = wgid / NXCD; wgid = (xcd < r ? xcd * (q + 1) : r * (q + 1) + (xcd - r) * q) + off; }
        const int nig = WGM * nN, gid = wgid / nig, fm = gid * WGM, gsz = (nM - fm) < WGM ? (nM - fm) : WGM;
        u.pm = fm + ((wgid % nig) % gsz); u.pn = (wgid % nig) / gsz; return true;
    }
    __device__ __forceinline__ void a_ready(const Unit&) const {}
    __device__ __forceinline__ void done(const Unit&) const {}
};

__device__ __forceinline__ unsigned cvt_pk_bf16(float lo, float hi) { unsigned r; asm volatile("v_cvt_pk_bf16_f32 %0, %1, %2" : "=v"(r) : "v"(lo), "v"(hi)); return r; }
__device__ __forceinline__ float bf_lo(unsigned w) { return __uint_as_float(w << 16); }
__device__ __forceinline__ float bf_hi(unsigned w) { return __uint_as_float(w & 0xffff0000u); }
constexpr float RMS_EPS = 1e-6f;
__device__ __forceinline__ float row_rstd(const float* ssqp, int r, int fq) {
    const f32x4 p = *(const f32x4*)(ssqp + (size_t)r * 16 + 4 * fq);
    float s = (p[0] + p[1]) + (p[2] + p[3]);
    s += __shfl_xor(s, 16); s += __shfl_xor(s, 32);
    return __builtin_amdgcn_rsqf(s * (1.0f / 1024.0f) + RMS_EPS);
}
__device__ __forceinline__ float fast_sigmoid(float x) { return __builtin_amdgcn_rcpf(1.0f + __builtin_amdgcn_exp2f(-1.4426950408889634f * x)); }
struct EpiSwiGLU {
    static constexpr bool PERM = true, AFTER_DRAIN = false;
    bf16_t* O; int ldc; const float* ssqp;
    __device__ __forceinline__ void operator()(const f32x4 (&acc)[2][2][4][2], const Unit& u, int wr, int wc, int fr, int fq) const {
        const int row0 = u.pm * BM + wr * 64 + fr, col0 = u.pn * HALF + wc * 32 + 8 * fq;
#pragma unroll
        for (int ai = 0; ai < 2; ++ai)
#pragma unroll
            for (int m = 0; m < 4; ++m) { const int r = row0 + ai * HALF + m * 16; const float rs = row_rstd(ssqp, r, fq);
                float h[8];
#pragma unroll
                for (int n = 0; n < 2; ++n)
#pragma unroll
                    for (int j = 0; j < 4; ++j) { const float g = acc[ai][0][m][n][j] * rs, up = acc[ai][1][m][n][j] * rs; h[n * 4 + j] = g * fast_sigmoid(g) * up; }
                u32x4 w; w.x = cvt_pk_bf16(h[0], h[1]); w.y = cvt_pk_bf16(h[2], h[3]); w.z = cvt_pk_bf16(h[4], h[5]); w.w = cvt_pk_bf16(h[6], h[7]);
                *(u32x4*)(O + (size_t)r * ldc + col0) = w; }
    }
};
template <int HALF_ALPHA> struct EpiResid {
    static constexpr bool PERM = true, AFTER_DRAIN = false; static constexpr float alpha = HALF_ALPHA ? 0.5f : 1.0f;
    const bf16_t* base; bf16_t* ob; float* ssq_out;
    __device__ __forceinline__ void operator()(const f32x4 (&acc)[2][2][4][2], const Unit& u, int wr, int wc, int fr, int fq) const {
        const int row0 = u.pm * BM + wr * 64 + fr, col0 = u.pn * BM + wc * 32 + 8 * fq;
#pragma unroll
        for (int ai = 0; ai < 2; ++ai)
#pragma unroll
            for (int m = 0; m < 4; ++m) { const int r = row0 + ai * HALF + m * 16; float ss = 0.f;
#pragma unroll
                for (int bj = 0; bj < 2; ++bj) { const size_t off = (size_t)r * 1024 + col0 + bj * HALF;
                    const u32x4 bw = *(const u32x4*)(base + off);
                    f32x4 v0, v1;
                    v0[0] = bf_lo(bw.x) + acc[ai][bj][m][0][0] * alpha; v0[1] = bf_hi(bw.x) + acc[ai][bj][m][0][1] * alpha; v0[2] = bf_lo(bw.y) + acc[ai][bj][m][0][2] * alpha; v0[3] = bf_hi(bw.y) + acc[ai][bj][m][0][3] * alpha;
                    v1[0] = bf_lo(bw.z) + acc[ai][bj][m][1][0] * alpha; v1[1] = bf_hi(bw.z) + acc[ai][bj][m][1][1] * alpha; v1[2] = bf_lo(bw.w) + acc[ai][bj][m][1][2] * alpha; v1[3] = bf_hi(bw.w) + acc[ai][bj][m][1][3] * alpha;
                    u32x4 w; w.x = cvt_pk_bf16(v0[0], v0[1]); w.y = cvt_pk_bf16(v0[2], v0[3]); w.z = cvt_pk_bf16(v1[0], v1[1]); w.w = cvt_pk_bf16(v1[2], v1[3]);
                    *(u32x4*)(ob + off) = w;
                    ss += (v0[0] * v0[0] + v0[1] * v0[1]) + (v0[2] * v0[2] + v0[3] * v0[3]) + (v1[0] * v1[0] + v1[1] * v1[1]) + (v1[2] * v1[2] + v1[3] * v1[3]); }
                ss += __shfl_xor(ss, 16); ss += __shfl_xor(ss, 32);
                if (fq == 0) ssq_out[(size_t)r * 16 + 4 * u.pn + wc] = ss; }
    }
};
constexpr int UW = 3328;
struct EpiWin {
    static constexpr bool PERM = true, AFTER_DRAIN = false;
    bf16_t* U; float* loga; const float* ssqp; const float* bgk;
    __device__ __forceinline__ void operator()(const f32x4 (&acc)[2][2][4][2], const Unit& u, int wr, int wc, int fr, int fq) const {
        const int row0 = u.pm * BM + wr * 64 + fr, cl0 = wc * 32 + 8 * fq;
        const float sc = (u.pn == 0) ? 0.125f : 1.0f;
#pragma unroll
        for (int ai = 0; ai < 2; ++ai)
#pragma unroll
            for (int m = 0; m < 4; ++m) { const int r = row0 + ai * HALF + m * 16; const float rs = row_rstd(ssqp, r, fq);
#pragma unroll
                for (int bj = 0; bj < 2; ++bj) { const int cl = cl0 + bj * HALF;
                    const f32x4 v0 = acc[ai][bj][m][0] * rs, v1 = acc[ai][bj][m][1] * rs;
                    if (u.pn == 6) {
                        const f32x4 c0 = *(const f32x4*)(bgk + cl), c1 = *(const f32x4*)(bgk + cl + 4); f32x4 o0, o1;
#pragma unroll
                        for (int j = 0; j < 4; ++j) { const float x0 = v0[j] + c0[j], x1 = v1[j] + c1[j];
                            o0[j] = (fminf(x0, 0.f) - log1pf(__expf(-fabsf(x0)))) * (1.0f / 16.0f); o1[j] = (fminf(x1, 0.f) - log1pf(__expf(-fabsf(x1)))) * (1.0f / 16.0f); }
                        *(f32x4*)(loga + (size_t)r * 256 + cl) = o0; *(f32x4*)(loga + (size_t)r * 256 + cl + 4) = o1;
                    } else {
                        u32x4 w; w.x = cvt_pk_bf16(v0[0] * sc, v0[1] * sc); w.y = cvt_pk_bf16(v0[2] * sc, v0[3] * sc); w.z = cvt_pk_bf16(v1[0] * sc, v1[1] * sc); w.w = cvt_pk_bf16(v1[2] * sc, v1[3] * sc);
                        *(u32x4*)(U + (size_t)r * UW + u.pn * BM + cl) = w; } } }
    }
};
struct EpiPlain {
    static constexpr bool PERM = true, AFTER_DRAIN = false;
    bf16_t* O;
    __device__ __forceinline__ void operator()(const f32x4 (&acc)[2][2][4][2], const Unit& u, int wr, int wc, int fr, int fq) const {
        const int row0 = u.pm * BM + wr * 64 + fr, col0 = u.pn * BM + wc * 32 + 8 * fq;
#pragma unroll
        for (int ai = 0; ai < 2; ++ai)
#pragma unroll
            for (int m = 0; m < 4; ++m) { const int r = row0 + ai * HALF + m * 16;
#pragma unroll
                for (int bj = 0; bj < 2; ++bj) { const f32x4 v0 = acc[ai][bj][m][0], v1 = acc[ai][bj][m][1];
                    u32x4 w; w.x = cvt_pk_bf16(v0[0], v0[1]); w.y = cvt_pk_bf16(v0[2], v0[3]); w.z = cvt_pk_bf16(v1[0], v1[1]); w.w = cvt_pk_bf16(v1[2], v1[3]);
                    *(u32x4*)(O + (size_t)r * 1024 + col0 + bj * HALF) = w; } }
    }
};
struct EpiPle {
    static constexpr bool PERM = true, AFTER_DRAIN = false;
    const bf16_t* base; float* out; const bf16_t* pp; const float* ssqp; float* ssq_out;
    __device__ __forceinline__ void operator()(const f32x4 (&acc)[2][2][4][2], const Unit& u, int wr, int wc, int fr, int fq) const {
        const int row0 = u.pm * BM + wr * 64 + fr, col0 = u.pn * BM + wc * 32 + 8 * fq;
#pragma unroll
        for (int ai = 0; ai < 2; ++ai)
#pragma unroll
            for (int m = 0; m < 4; ++m) { const int r = row0 + ai * HALF + m * 16; const float rs = row_rstd(ssqp, r, fq); float ss = 0.f;
#pragma unroll
                for (int bj = 0; bj < 2; ++bj) { const size_t off = (size_t)r * 1024 + col0 + bj * HALF;
                    const u32x4 bw = *(const u32x4*)(base + off); const f32x4 b0 = (f32x4){bf_lo(bw.x), bf_hi(bw.x), bf_lo(bw.y), bf_hi(bw.y)}, b1 = (f32x4){bf_lo(bw.z), bf_hi(bw.z), bf_lo(bw.w), bf_hi(bw.w)};
                    const u32x4 pw = *(const u32x4*)(pp + off);
                    f32x4 v0, v1;
                    v0[0] = b0[0] + fast_sigmoid(acc[ai][bj][m][0][0] * rs) * bf_lo(pw.x); v0[1] = b0[1] + fast_sigmoid(acc[ai][bj][m][0][1] * rs) * bf_hi(pw.x);
                    v0[2] = b0[2] + fast_sigmoid(acc[ai][bj][m][0][2] * rs) * bf_lo(pw.y); v0[3] = b0[3] + fast_sigmoid(acc[ai][bj][m][0][3] * rs) * bf_hi(pw.y);
                    v1[0] = b1[0] + fast_sigmoid(acc[ai][bj][m][1][0] * rs) * bf_lo(pw.z); v1[1] = b1[1] + fast_sigmoid(acc[ai][bj][m][1][1] * rs) * bf_hi(pw.z);
                    v1[2] = b1[2] + fast_sigmoid(acc[ai][bj][m][1][2] * rs) * bf_lo(pw.w); v1[3] = b1[3] + fast_sigmoid(acc[ai][bj][m][1][3] * rs) * bf_hi(pw.w);
                    *(f32x4*)(out + off) = v0; *(f32x4*)(out + off + 4) = v1;
                    ss += (v0[0] * v0[0] + v0[1] * v0[1]) + (v0[2] * v0[2] + v0[3] * v0[3]) + (v1[0] * v1[0] + v1[1] * v1[1]) + (v1[2] * v1[2] + v1[3] * v1[3]); }
                ss += __shfl_xor(ss, 16); ss += __shfl_xor(ss, 32);
                if (fq == 0) ssq_out[(size_t)r * 16 + 4 * u.pn + wc] = ss; }
    }
};
template <class Epi, class Sched, bool ALIGN_EPI = false, bool SP2 = false>
__device__ __forceinline__ void gemm_phase(PG8_LAS unsigned char* lds, const Gemm g, const Sched& S, const Epi& E) {
    const int tid = threadIdx.x, wid = __builtin_amdgcn_readfirstlane(tid >> 6), lane = tid & 63, wr = wid >> 2, wc = wid & 3, fr = lane & 15, fq = lane >> 4;
    const int K = g.K, nt = K / BK;
    unsigned voffA[2], voffB[2];
#pragma unroll
    for (int i = 0; i < 2; ++i) { int R, C; stage_rc(tid * 16 + i * 8192, R, C); const int Rb = Epi::PERM ? ((R & ~31) + perm32(R & 31)) : R;
        voffA[i] = (unsigned)(R * K + C) * 2u; voffB[i] = (unsigned)(Rb * K + C) * 2u; }
    const size_t kstep = (size_t)(BK * 2);
    const size_t hstep = (size_t)HALF * K * 2;
    const size_t tstep = 2 * hstep;
    const unsigned ldsw = (unsigned)wid * 1024u;
    const int aoff = lds_byte(wr * 64 + fr, fq * 8), boff = lds_byte(wc * 32 + fr, fq * 8);
#define PG8_SA(b, h) (((b) * 2 + (h)) * HTB)
#define PG8_SB(b, h) ((4 + (b) * 2 + (h)) * HTB)
#define PG8_STAGE(bufoff, gbase, voff) do { _Pragma("unroll") for (int _i = 0; _i < 2; ++_i) \
        __builtin_amdgcn_global_load_lds((const unsigned*)((const char*)(gbase) + (voff)[_i]), (PG8_LAS unsigned*)(lds + (bufoff) + ldsw + _i * 8192), 16, 0, 0); } while (0)
#define PG8_LDA(dst, b, h) do { _Pragma("unroll") for (int m = 0; m < 4; ++m) _Pragma("unroll") for (int k = 0; k < 2; ++k) dst[m][k] = *(const PG8_LAS bf16x8*)(lds + PG8_SA(b, h) + aoff + m * 2048 + k * 1024); } while (0)
#define PG8_LDB(dst, b, h) do { _Pragma("unroll") for (int n = 0; n < 2; ++n) _Pragma("unroll") for (int k = 0; k < 2; ++k) dst[n][k] = *(const PG8_LAS bf16x8*)(lds + PG8_SB(b, h) + boff + n * 2048 + k * 1024); } while (0)
#define PG8_MMA(ai, bj, At, Bt) do { __builtin_amdgcn_s_setprio(1); _Pragma("unroll") for (int m = 0; m < 4; ++m) _Pragma("unroll") for (int n = 0; n < 2; ++n) _Pragma("unroll") for (int k = 0; k < 2; ++k) \
        acc[ai][bj][m][n] = __builtin_amdgcn_mfma_f32_16x16x32_bf16(Bt[n][k], At[m][k], acc[ai][bj][m][n], 0, 0, 0); __builtin_amdgcn_s_setprio(0); } while (0)
#define PG8_WAIT_V(n) asm volatile("s_waitcnt vmcnt(" #n ")" ::: "memory")
#define PG8_WAIT_L(n) asm volatile("s_waitcnt lgkmcnt(" #n ")" ::: "memory")
#define PG8_BAR __builtin_amdgcn_s_barrier()
#define PG8_SCHED __builtin_amdgcn_sched_barrier(0)
    Unit cur, nxt; int ui = 0;
    if (!S.next(0, cur)) return;
    f32x4 acc[2][2][4][2];
#pragma unroll
    for (int a = 0; a < 2; ++a)
#pragma unroll
        for (int b = 0; b < 2; ++b)
#pragma unroll
            for (int m = 0; m < 4; ++m)
#pragma unroll
                for (int n = 0; n < 2; ++n) acc[a][b][m][n] = (f32x4){0.f, 0.f, 0.f, 0.f};
    bf16x8 At[4][2], B0[2][2], B1[2][2];
    const char* cA = (const char*)g.A + (size_t)cur.pm * tstep; const char* cB = (const char*)g.Bt + (size_t)cur.pn * tstep;
    S.a_ready(cur);
    if constexpr (SP2) {
        PG8_STAGE(PG8_SB(0, 0), cB, voffB); PG8_STAGE(PG8_SB(0, 1), cB + hstep, voffB); PG8_STAGE(PG8_SA(0, 0), cA, voffA); PG8_STAGE(PG8_SA(0, 1), cA + hstep, voffA);
        if (wr == 1) PG8_BAR;
        PG8_WAIT_V(2); PG8_BAR;
        PG8_STAGE(PG8_SB(1, 0), cB + kstep, voffB); PG8_STAGE(PG8_SA(1, 0), cA + kstep, voffA); PG8_STAGE(PG8_SB(1, 1), cB + hstep + kstep, voffB);
        PG8_WAIT_V(6); PG8_BAR;
    } else {
        PG8_STAGE(PG8_SB(0, 0), cB, voffB); PG8_STAGE(PG8_SA(0, 0), cA, voffA); PG8_STAGE(PG8_SB(0, 1), cB + hstep, voffB); PG8_STAGE(PG8_SA(0, 1), cA + hstep, voffA);
        if (wr == 1) PG8_BAR;
        PG8_WAIT_V(4); PG8_BAR;
        PG8_STAGE(PG8_SB(1, 0), cB + kstep, voffB); PG8_STAGE(PG8_SA(1, 0), cA + kstep, voffA); PG8_STAGE(PG8_SB(1, 1), cB + hstep + kstep, voffB);
        PG8_WAIT_V(6); PG8_BAR;
    }
    for (;;) {
        const bool has_next = S.next(ui + 1, nxt);
        const char* nA = has_next ? (const char*)g.A + (size_t)nxt.pm * tstep : cA; const char* nB = has_next ? (const char*)g.Bt + (size_t)nxt.pn * tstep : cB;
        for (int t = 0; t < nt; t += 2) {
            const bool last = (t == nt - 2);
            const char* a1 = cA + (size_t)(t + 1) * kstep;
            const char* a2 = last ? nA : cA + (size_t)(t + 2) * kstep; const char* b2 = last ? nB : cB + (size_t)(t + 2) * kstep;
            const char* a3 = a2 + kstep; const char* b3 = b2 + kstep;
            if (last && has_next) S.a_ready(nxt);
            if constexpr (SP2) {
            PG8_LDB(B0, 0, 0); PG8_LDB(B1, 0, 1); PG8_SCHED; PG8_LDA(At, 0, 0); PG8_STAGE(PG8_SA(1, 1), a1 + hstep, voffA);
            PG8_WAIT_V(8); PG8_WAIT_L(0); PG8_BAR; PG8_MMA(0, 0, At, B0); PG8_MMA(0, 1, At, B1); PG8_BAR; PG8_SCHED;
            PG8_LDA(At, 0, 1); PG8_STAGE(PG8_SB(0, 0), b2, voffB); PG8_STAGE(PG8_SB(0, 1), b2 + hstep, voffB); PG8_STAGE(PG8_SA(0, 0), a2, voffA);
            PG8_WAIT_V(8); PG8_WAIT_L(0); PG8_BAR; PG8_MMA(1, 0, At, B0); PG8_MMA(1, 1, At, B1); PG8_BAR; PG8_SCHED;
            PG8_LDB(B0, 1, 0); PG8_LDB(B1, 1, 1); PG8_SCHED; PG8_LDA(At, 1, 0); PG8_STAGE(PG8_SA(0, 1), a2 + hstep, voffA);
            PG8_WAIT_V(8); PG8_WAIT_L(0); PG8_BAR; PG8_MMA(0, 0, At, B0); PG8_MMA(0, 1, At, B1); PG8_BAR; PG8_SCHED;
            PG8_LDA(At, 1, 1); PG8_STAGE(PG8_SB(1, 0), b3, voffB); PG8_STAGE(PG8_SB(1, 1), b3 + hstep, voffB); PG8_STAGE(PG8_SA(1, 0), a3, voffA);
            PG8_WAIT_V(8); PG8_WAIT_L(0); PG8_BAR; PG8_MMA(1, 0, At, B0); PG8_MMA(1, 1, At, B1); PG8_BAR; PG8_SCHED;
            } else {
            PG8_LDB(B0, 0, 0); PG8_SCHED; PG8_LDA(At, 0, 0); PG8_STAGE(PG8_SA(1, 1), a1 + hstep, voffA);
            PG8_WAIT_L(8); PG8_BAR; PG8_WAIT_L(0); PG8_MMA(0, 0, At, B0); PG8_BAR; PG8_SCHED;
            PG8_LDB(B1, 0, 1); PG8_STAGE(PG8_SB(0, 0), b2, voffB);
            PG8_BAR; PG8_WAIT_L(0); PG8_MMA(0, 1, At, B1); PG8_BAR;
            PG8_LDA(At, 0, 1); PG8_STAGE(PG8_SA(0, 0), a2, voffA);
            PG8_BAR; PG8_WAIT_L(0); PG8_MMA(1, 0, At, B0); PG8_BAR; PG8_SCHED;
            PG8_STAGE(PG8_SB(0, 1), b2 + hstep, voffB);
            PG8_WAIT_V(6); PG8_BAR; PG8_MMA(1, 1, At, B1); PG8_BAR;
            PG8_LDB(B0, 1, 0); PG8_SCHED; PG8_LDA(At, 1, 0); PG8_STAGE(PG8_SA(0, 1), a2 + hstep, voffA);
            PG8_WAIT_L(8); PG8_BAR; PG8_WAIT_L(0); PG8_MMA(0, 0, At, B0); PG8_BAR; PG8_SCHED;
            PG8_LDB(B1, 1, 1); PG8_STAGE(PG8_SB(1, 0), b3, voffB);
            PG8_BAR; PG8_WAIT_L(0); PG8_MMA(0, 1, At, B1); PG8_BAR;
            PG8_LDA(At, 1, 1); PG8_STAGE(PG8_SA(1, 0), a3, voffA);
            PG8_BAR; PG8_WAIT_L(0); PG8_MMA(1, 0, At, B0); PG8_BAR; PG8_SCHED;
            PG8_STAGE(PG8_SB(1, 1), b3 + hstep, voffB);
            PG8_WAIT_V(6); PG8_BAR; PG8_MMA(1, 1, At, B1); PG8_BAR;
            }
        }
        if constexpr (ALIGN_EPI) { if (wr == 0) PG8_BAR; }
        if constexpr (!Epi::AFTER_DRAIN) { E(acc, cur, wr, wc, fr, fq); S.done(cur); }
        if (!has_next) break;
#pragma unroll
        for (int a = 0; a < 2; ++a)
#pragma unroll
            for (int b = 0; b < 2; ++b)
#pragma unroll
                for (int m = 0; m < 4; ++m)
#pragma unroll
                    for (int n = 0; n < 2; ++n) acc[a][b][m][n] = (f32x4){0.f, 0.f, 0.f, 0.f};
        cur = nxt; cA = nA; cB = nB; ++ui;
        if constexpr (ALIGN_EPI) { if (wr == 1) PG8_BAR; }
    }
    PG8_WAIT_V(0);
    if constexpr (!ALIGN_EPI) { if (wr == 0) PG8_BAR; }
    PG8_BAR;
    if constexpr (Epi::AFTER_DRAIN) { E.fused(acc, cur, wr, wc, fr, fq, lds, wid, lane); S.done(cur); }
#undef PG8_SA
#undef PG8_SB
#undef PG8_STAGE
#undef PG8_LDA
#undef PG8_LDB
#undef PG8_MMA
#undef PG8_WAIT_V
#undef PG8_WAIT_L
#undef PG8_BAR
#undef PG8_SCHED
}
}
#ifndef PG8_SP2
#define PG8_SP2 true
#endif
#ifndef PG8_ALIGN
#define PG8_ALIGN true
#endif
constexpr int NWAVES = 8;
constexpr int N_PHASES = 12;
#ifndef MK_N_LAUNCHES
#define MK_N_LAUNCHES 1
#endif
constexpr int N_LAUNCHES = MK_N_LAUNCHES;

constexpr int M = 16384, D = 1024, FF = 2816, NGU = 2 * FF, DPLE = 256;
constexpr int GH = 4, GDK = 64, GDV = 128, MH = 8, MHD = 64, MBLK = 256, NBLK = M / MBLK;
constexpr int UWID = 3328;
constexpr int U_QG = 0, U_KG = 256, U_VG = 512, U_GG = 1024, U_QM = 1792, U_KM = 2304, U_VM = 2816;
constexpr float EPS = 1e-6f;

constexpr size_t MiB = 1u << 20;
constexpr size_t WS_CTL = 0, CTL_ZERO_BYTES = 1 * MiB;
constexpr size_t WS_WGU1 = 1 * MiB, WS_WD1 = 12 * MiB, WS_WIN = 18 * MiB, WS_WOUT = 25 * MiB, WS_WGU2 = 27 * MiB, WS_WD2 = 38 * MiB, WS_WPG = 44 * MiB, WS_WPP = 46 * MiB;
constexpr size_t WS_SSQ1 = 47 * MiB, WS_SSQ2 = 48 * MiB, WS_SSQ3 = 49 * MiB, WS_SSQ4 = 50 * MiB, WS_SSQ5 = 51 * MiB, WS_KMEAN = 52 * MiB;
constexpr size_t WS_HB = 54 * MiB;
constexpr size_t WS_PB = 86 * MiB;
constexpr size_t WS_MIX = 94 * MiB;
constexpr size_t WS_U = 126 * MiB;
constexpr size_t WS_LOGA = 230 * MiB;
constexpr size_t WS_PP = 214 * MiB;
constexpr size_t WS_END = 256 * MiB;
static_assert(WS_U + (size_t)M * UWID * 2 <= WS_LOGA && WS_LOGA + (size_t)M * 256 * 4 <= WS_END && WS_U + (size_t)M * FF * 2 <= WS_PP && WS_PP + (size_t)M * D * 2 <= WS_END, "d_ws map");
constexpr int CW_TMO = 0, CW_CODE = 1;
constexpr int CW_BAR = 4096;

constexpr int RING_OFF = 0, RING_BYTES = 131072;
constexpr int LDS_BYTES = 163840;
constexpr int LDSCTL_OFF = LDS_BYTES - 512, MISC_OFF = LDSCTL_OFF + 320;
#define GAS __attribute__((address_space(1)))
#define LAS __attribute__((address_space(3)))
typedef unsigned short bf16;
typedef unsigned v4u __attribute__((ext_vector_type(4)));
typedef float f32x4 __attribute__((ext_vector_type(4)));
typedef short bf16x8 __attribute__((ext_vector_type(8)));
typedef GAS unsigned gu32;
typedef GAS unsigned long long gu64;
#define RLX_AGENT __ATOMIC_RELAXED, __HIP_MEMORY_SCOPE_AGENT
#define LDS_WAIT() asm volatile("s_waitcnt lgkmcnt(0)" ::: "memory")
#define VM_WAIT() asm volatile("s_waitcnt vmcnt(0)" ::: "memory")
__device__ __forceinline__ unsigned long long rt() { return __builtin_amdgcn_s_memrealtime(); }
__device__ __forceinline__ unsigned f2bf(float f) { unsigned u = __builtin_bit_cast(unsigned, f); return (u + 0x7fffu + ((u >> 16) & 1u)) >> 16; }
__device__ __forceinline__ unsigned pk2(float lo, float hi) { return f2bf(lo) | (f2bf(hi) << 16); }

#define XB_TMO      128
#define XB_XCNT(j)  (256  + 64 * (j))
#define XB_XSUB(j)  (1280 + 64 * (j))
#define XB_XGEN(j)  (2304 + 64 * (j))
#define XB_TOP      3328
#define XB_TOPGEN   3392
#define XCD_BAR_WORDS 3456
#define XB_SPIN_CAP (1u << 18)

__device__ __forceinline__ unsigned xb_ld(unsigned* p)              { return __hip_atomic_load(p, __ATOMIC_RELAXED, __HIP_MEMORY_SCOPE_AGENT); }
__device__ __forceinline__ unsigned xb_add(unsigned* p, unsigned v) { return __hip_atomic_fetch_add(p, v, __ATOMIC_RELAXED, __HIP_MEMORY_SCOPE_AGENT); }
__device__ __forceinline__ unsigned xb_xcc_id() { return (unsigned)__builtin_amdgcn_s_getreg((3 << 11) | 20) & 0xFu; }
#define XB_SPIN(cond, bar) do { unsigned _sp = 0; while (cond) { __builtin_amdgcn_s_sleep(1); \
    if ((++_sp & 255u) == 0u) { if (xb_ld(&(bar)[XB_TMO])) break; if (_sp > XB_SPIN_CAP) { atomicAdd(&(bar)[XB_TMO], 1u); break; } } } } while (0)

struct XcdBarrier {
    unsigned* bar; unsigned x;
    volatile LAS unsigned* st;
};

__device__ __forceinline__ XcdBarrier xcd_barrier_post(unsigned* bar, volatile LAS unsigned* st) {
    XcdBarrier b; b.bar = bar; b.x = xb_xcc_id(); b.st = st;
    if (threadIdx.x == 0) (void)xb_add(&bar[XB_XCNT(b.x)], 1u);
    return b;
}
__device__ __forceinline__ void xcd_barrier_complete(unsigned* bar, unsigned x, unsigned& nloc, unsigned& nx) {
    const unsigned G = gridDim.x * gridDim.y * gridDim.z;
    unsigned sum, cnt, mine, sp = 0u;
    for (;;) {
        sum = 0u; cnt = 0u; mine = 0u;
#pragma unroll
        for (unsigned j = 0; j < 16; ++j) { const unsigned c = xb_ld(&bar[XB_XCNT(j)]); sum += c; cnt += (c > 0u) ? 1u : 0u; mine = (j == x) ? c : mine; }
        if (sum == G) break;
        __builtin_amdgcn_s_sleep(1);
        if ((++sp & 255u) == 0u) { if (xb_ld(&bar[XB_TMO])) break; if (sp > XB_SPIN_CAP) { atomicAdd(&bar[XB_TMO], 1u); break; } }
    }
    nloc = mine > 0u ? mine : 1u; nx = cnt > 0u ? cnt : 1u;
}

__device__ __forceinline__ void xcd_barrier(const XcdBarrier& b) {
    asm volatile("s_waitcnt vmcnt(0)" ::: "memory");
    __syncthreads();
    if (threadIdx.x == 0) {
        unsigned* bar = b.bar;
        __builtin_amdgcn_s_waitcnt(0);
        unsigned nloc = b.st[0], nx = b.st[1];
        if (nloc == 0u) { xcd_barrier_complete(bar, b.x, nloc, nx); b.st[0] = nloc; b.st[1] = nx; }
        const unsigned old = xb_add(&bar[XB_XSUB(b.x)], 1u);
        const unsigned gen = old / nloc;
        if (old + 1u == (gen + 1u) * nloc) {
            __builtin_amdgcn_fence(__ATOMIC_RELEASE, "agent");
            asm volatile("s_waitcnt vmcnt(0)" ::: "memory");
            const unsigned og = xb_add(&bar[XB_TOP], 1u);
            const unsigned tg = og / nx;
            if (og + 1u == (tg + 1u) * nx) xb_add(&bar[XB_TOPGEN], 1u);
            else XB_SPIN(xb_ld(&bar[XB_TOPGEN]) == tg, bar);
            __builtin_amdgcn_fence(__ATOMIC_ACQUIRE, "agent");
            xb_add(&bar[XB_XGEN(b.x)], 1u);
            asm volatile("s_waitcnt vmcnt(0)" ::: "memory");
        } else {
            XB_SPIN(xb_ld(&bar[XB_XGEN(b.x)]) == gen, bar);
            __builtin_amdgcn_fence(__ATOMIC_ACQUIRE, "agent");
            asm volatile("s_waitcnt vmcnt(0)" ::: "memory");
        }
    }
    __syncthreads();
}
struct Frame {
    LAS unsigned char* lds;
    volatile LAS unsigned* MISC;
    gu32* ctl;
    int tid, lane, wave;
    int vcu, G;
};
__device__ __forceinline__ int fresh_lane() { int l; asm volatile("v_mbcnt_lo_u32_b32 %0, -1, 0\n\tv_mbcnt_hi_u32_b32 %0, -1, %0" : "=v"(l)); return l; }
__device__ __forceinline__ float wave_sum(float v) {
#pragma unroll
    for (int o = 1; o < 64; o <<= 1) v += __shfl_xor(v, o);
    return v;
}
__device__ __forceinline__ float wave_max(float v) {
#pragma unroll
    for (int o = 1; o < 64; o <<= 1) v = fmaxf(v, __shfl_xor(v, o));
    return v;
}
__device__ __forceinline__ float bf2f(bf16 h) { return __uint_as_float((unsigned)h << 16); }
__device__ __forceinline__ float bf_lo2(unsigned w) { return __uint_as_float(w << 16); }
__device__ __forceinline__ float bf_hi2(unsigned w) { return __uint_as_float(w & 0xffff0000u); }

constexpr int TRP = 68;
__device__ __forceinline__ void tr_item(const float* W, int K, int N, const float* gain, bf16* WT, int k0, int n0dst, int c0src, LAS float* scr, int lane) {
    const int kr = lane >> 4, n4 = lane & 15;
    f32x4 v[16];
#pragma unroll
    for (int i = 0; i < 16; ++i) v[i] = *(const GAS f32x4*)(W + (size_t)(k0 + kr + 4 * i) * N + c0src + 4 * n4);
#pragma unroll
    for (int i = 0; i < 16; ++i) *(LAS f32x4*)(scr + (kr + 4 * i) * TRP + 4 * n4) = v[i];
    LDS_WAIT(); asm volatile("" ::: "memory");
#pragma unroll
    for (int c = 0; c < 8; ++c) { float f[8];
#pragma unroll
        for (int i = 0; i < 8; ++i) f[i] = scr[(8 * c + i) * TRP + lane] * (gain ? gain[k0 + 8 * c + i] : 1.0f);
        v4u o; o.x = pk2(f[0], f[1]); o.y = pk2(f[2], f[3]); o.z = pk2(f[4], f[5]); o.w = pk2(f[6], f[7]);
        *(GAS v4u*)(WT + (size_t)(n0dst + lane) * K + k0 + 8 * c) = o; }
    LDS_WAIT(); asm volatile("" ::: "memory");
}
__device__ __forceinline__ void tr_item_gk(const float* Win, const float* Wup, const float* gain, bf16* WT, int k0, int j0, int lane) {
    float wu[16];
#pragma unroll
    for (int r = 0; r < 16; ++r) wu[r] = Wup[r * 256 + j0 + lane];
#pragma unroll 2
    for (int c = 0; c < 8; ++c) { float f[8];
#pragma unroll
        for (int i = 0; i < 8; ++i) { const int k = k0 + 8 * c + i; const float* wr = Win + (size_t)k * 3088 + 1536; float a = 0.f;
#pragma unroll
            for (int r = 0; r < 16; ++r) a += wr[r] * wu[r];
            f[i] = a * gain[k]; }
        v4u o; o.x = pk2(f[0], f[1]); o.y = pk2(f[2], f[3]); o.z = pk2(f[4], f[5]); o.w = pk2(f[6], f[7]);
        *(GAS v4u*)(WT + (size_t)(1536 + j0 + lane) * 1024 + k0 + 8 * c) = o; }
}
struct Args { const float* in[19]; float* out; unsigned char* ws; int ph_lo, ph_hi, li, pad; };

template <int LIST>
__device__ __forceinline__ void convert_weights(Frame& F, const Args& A, int gw, int NGW) {
    LAS float* scr = (LAS float*)(F.lds + RING_OFF + F.wave * (64 * TRP * 4));
    GAS unsigned char* ws = (GAS unsigned char*)A.ws; asm volatile("" : "+s"(ws));
    const int lane = fresh_lane();
    constexpr int I_GU = 16 * 88, I_D = 44 * 16, I_IN = 16 * 52, I_O = 16 * 16, I_PP = 4 * 16;
    constexpr int NITEMS = LIST == 0 ? I_GU : LIST == 1 ? I_D + I_IN : 2 * I_O + I_GU + I_D + I_PP;
    for (int it = gw; it < NITEMS; it += NGW) {
        int r = it;
        if (LIST == 0) { const int kb = r / 88, nb = r % 88, t = nb >> 2, g = nb & 3; const int src = (g < 2) ? (128 * t + 64 * g) : (FF + 128 * t + 64 * (g - 2));
            tr_item(A.in[3], D, NGU, A.in[2], (bf16*)(ws + WS_WGU1), 64 * kb, 64 * nb, src, scr, lane); }
        if (LIST == 1) {
            if (r < I_D) { const int kb = r / 16, nb = r % 16; tr_item(A.in[4], FF, D, nullptr, (bf16*)(ws + WS_WD1), 64 * kb, 64 * nb, 64 * nb, scr, lane); continue; } r -= I_D;
            { const int kb = r / 52, nb = r % 52;
              if (nb >= 24 && nb < 28) tr_item_gk(A.in[6], A.in[7], A.in[5], (bf16*)(ws + WS_WIN), 64 * kb, 64 * (nb - 24), lane);
              else tr_item(A.in[6], D, 3088, A.in[5], (bf16*)(ws + WS_WIN), 64 * kb, 64 * nb, nb < 24 ? 64 * nb : 64 * nb - 240, scr, lane); } }
        if (LIST == 2) {
            if (r < 2 * I_O) { const int which = r / I_O; r -= which * I_O; const int kb = r / 16, nb = r % 16;
                tr_item(A.in[which ? 15 : 10], D, D, which ? A.in[14] : nullptr, (bf16*)(ws + (which ? WS_WPG : WS_WOUT)), 64 * kb, 64 * nb, 64 * nb, scr, lane); continue; } r -= 2 * I_O;
            if (r < I_GU) { const int kb = r / 88, nb = r % 88, t = nb >> 2, g = nb & 3; const int src = (g < 2) ? (128 * t + 64 * g) : (FF + 128 * t + 64 * (g - 2));
                tr_item(A.in[12], D, NGU, A.in[11], (bf16*)(ws + WS_WGU2), 64 * kb, 64 * nb, src, scr, lane); continue; } r -= I_GU;
            if (r < I_D) { const int kb = r / 16, nb = r % 16; tr_item(A.in[13], FF, D, nullptr, (bf16*)(ws + WS_WD2), 64 * kb, 64 * nb, 64 * nb, scr, lane); continue; } r -= I_D;
            { const int kb = r / 16, nb = r % 16; tr_item(A.in[16], DPLE, D, nullptr, (bf16*)(ws + WS_WPP), 64 * kb, 64 * nb, 64 * nb, scr, lane); } }
    }
}
__device__ __forceinline__ void p0_prologue(Frame& F, const Args& A) {
    const int gw = F.vcu * NWAVES + F.wave, NGW = F.G * NWAVES, lane = fresh_lane();
    convert_weights<0>(F, A, gw, NGW);
    GAS unsigned char* ws = (GAS unsigned char*)A.ws; asm volatile("" : "+s"(ws));
    const float* x = A.in[0]; const float* p = A.in[1];
    bf16* xb = (bf16*)(ws + WS_MIX); bf16* pb = (bf16*)(ws + WS_PB); float* ssq1 = (float*)(ws + WS_SSQ1);
    for (int m0 = gw; m0 < M; m0 += 2 * NGW) {
        f32x4 v[2][4]; f32x4 pv[2]; float sq[2];
#pragma unroll
        for (int u = 0; u < 2; ++u) { const int m = m0 + u * NGW; const GAS f32x4* xr = (const GAS f32x4*)(x + (size_t)m * D) + lane;
#pragma unroll
            for (int j = 0; j < 4; ++j) v[u][j] = xr[64 * j];
            pv[u] = ((const GAS f32x4*)(p + (size_t)m * DPLE))[lane]; }
#pragma unroll
        for (int u = 0; u < 2; ++u) { float s = 0.f;
#pragma unroll
            for (int j = 0; j < 4; ++j) s += (v[u][j].x * v[u][j].x + v[u][j].y * v[u][j].y) + (v[u][j].z * v[u][j].z + v[u][j].w * v[u][j].w);
            sq[u] = wave_sum(s); }
#pragma unroll
        for (int u = 0; u < 2; ++u) { const int m = m0 + u * NGW;
            GAS unsigned long long* o8 = (GAS unsigned long long*)(xb + (size_t)m * D) + lane;
#pragma unroll
            for (int j = 0; j < 4; ++j) o8[64 * j] = (unsigned long long)pk2(v[u][j].x, v[u][j].y) | ((unsigned long long)pk2(v[u][j].z, v[u][j].w) << 32);
            if (lane < 16) ssq1[(size_t)m * 16 + lane] = (lane == 0) ? sq[u] : 0.f;
            ((GAS unsigned long long*)(pb + (size_t)m * DPLE))[lane] = (unsigned long long)pk2(pv[u].x, pv[u].y) | ((unsigned long long)pk2(pv[u].z, pv[u].w) << 32); }
    }
}

__device__ __forceinline__ void moba_kmean(Frame& F, const bf16* U, bf16* kmean) {
    const int gw = F.vcu * NWAVES + F.wave, NGW = F.G * NWAVES, lane = fresh_lane();
    for (int u = gw; u < MH * NBLK; u += NGW) { const int h = u / NBLK, n = u % NBLK; float s = 0.f;
        const bf16* kp = U + (size_t)(n * MBLK) * UWID + U_KM + h * MHD + lane;
#pragma unroll 8
        for (int r = 0; r < MBLK; ++r) s += bf2f(kp[(size_t)r * UWID]);
        kmean[(size_t)u * 64 + lane] = (bf16)f2bf(s * (1.0f / MBLK)); }
}
__device__ __forceinline__ int rel_bucket(int n) { return n < 16 ? n : min(31, 16 + (31 - __clz(n * n)) - 8); }
typedef float f32x16 __attribute__((ext_vector_type(16)));
typedef short v4i16_t __attribute__((ext_vector_type(4)));
__device__ __forceinline__ f32x16 mfma32(bf16x8 a, bf16x8 b, f32x16 c) { return __builtin_amdgcn_mfma_f32_32x32x16_bf16(a, b, c, 0, 0, 0); }
__device__ __forceinline__ v4i16_t lds_tr(LAS unsigned char* p) { return __builtin_amdgcn_ds_read_tr16_b64_v4i16((LAS v4i16_t*)p); }
__device__ __forceinline__ unsigned cvtpk(float lo, float hi) { unsigned r; asm volatile("v_cvt_pk_bf16_f32 %0, %1, %2" : "=v"(r) : "v"(lo), "v"(hi)); return r; }
constexpr int MB_OACC = 0, MB_OP = 65, MB_LACC = 66560, MB_MREF = 67584, MB_CNT = 68608, MB_OFFS = 68864, MB_LIST = 69184, MB_NSEL = 70912, MB_VST = 71680, MB_VP = 144, MB_VSTW = 2 * 32 * MB_VP  , MB_BTAB = MB_VST + 8 * MB_VSTW, MB_NTAB = 3584;
static_assert(MB_BTAB + MB_NTAB * 4 <= LDSCTL_OFF, "MoBA LDS map");
constexpr float LOG2E = 1.4426950408889634f, MB_SC = 0.125f * LOG2E;

template <int MODE>
__device__ __forceinline__ void moba_tile(const bf16* U, int h, int n, int nchunks, int qpos, float& mref, LAS unsigned char* vst, LAS const float* rtab, bool nearblk, float cbias,
                                          f32x16& O0, f32x16& O1, float& lsum, int lane) {
    const int half = lane >> 5, l31 = lane & 31;
    bf16x8 qf[4];
    { const bf16* qp = U + (size_t)qpos * UWID + U_QM + h * 64 + 8 * half;
#pragma unroll
      for (int s = 0; s < 4; ++s) qf[s] = *(const bf16x8*)(qp + 16 * s); }
    const int r8 = lane >> 3, pc = lane & 7;
    const bf16* kp = U + (size_t)(n * MBLK + r8) * UWID + U_KM + h * 64 + pc * 8;
    const bf16* vp = U + (size_t)(n * MBLK + r8) * UWID + U_VM + h * 64 + pc * 8;
    LAS unsigned char* kst = vst + 32 * MB_VP;
    LAS unsigned char* vdst = vst + r8 * MB_VP + pc * 16;
    LAS unsigned char* kdst = kst + r8 * MB_VP + pc * 16;
    LAS const unsigned char* kfp = kst + l31 * MB_VP + 16 * half;
    LAS unsigned char* trb = vst + (4 * half + ((lane & 15) >> 2)) * MB_VP + (16 * ((lane >> 4) & 1) + 4 * (lane & 3)) * 2;
    const int jb = 3327 - qpos + n * MBLK + 4 * half;
    float m = -INFINITY;
    v4u kr[4], kn[4], vr[4], vn[4];
#pragma unroll
    for (int i = 0; i < 4; ++i) { kr[i] = *(const v4u*)(kp + (size_t)(8 * i) * UWID); kn[i] = kr[i]; }
    if (MODE != 0) {
#pragma unroll
        for (int i = 0; i < 4; ++i) { vr[i] = *(const v4u*)(vp + (size_t)(8 * i) * UWID); vn[i] = vr[i]; } }
    for (int ck = 0; ck < nchunks; ++ck) {
#pragma unroll
        for (int i = 0; i < 4; ++i) *(LAS v4u*)(kdst + 8 * i * MB_VP) = kr[i];
        if (MODE != 0) {
#pragma unroll
            for (int i = 0; i < 4; ++i) *(LAS v4u*)(vdst + 8 * i * MB_VP) = vr[i]; }
        if (ck + 1 < nchunks) {
#pragma unroll
            for (int i = 0; i < 4; ++i) kn[i] = *(const v4u*)(kp + (size_t)((ck + 1) * 32 + 8 * i) * UWID);
            if (MODE != 0) {
#pragma unroll
                for (int i = 0; i < 4; ++i) vn[i] = *(const v4u*)(vp + (size_t)((ck + 1) * 32 + 8 * i) * UWID); } }
        bf16x8 kf[4];
#pragma unroll
        for (int s = 0; s < 4; ++s) kf[s] = *(LAS const bf16x8*)(kfp + 32 * s);
        f32x16 S;
#pragma unroll
        for (int r = 0; r < 16; ++r) S[r] = 0.f;
#pragma unroll
        for (int s = 0; s < 4; ++s) S = mfma32(kf[s], qf[s], S);
        float bvv[16];
        if (nearblk) {
#pragma unroll
            for (int r = 0; r < 16; ++r) bvv[r] = rtab[jb + 32 * ck + (r & 3) + 8 * (r >> 2)];
        } else {
#pragma unroll
            for (int r = 0; r < 16; ++r) bvv[r] = cbias;
        }
#pragma unroll
        for (int r = 0; r < 16; ++r) { const int cr = (r & 3) + 8 * (r >> 2);
            float y = S[r] * MB_SC + bvv[r];
            if (MODE != 2) { const int dist = qpos - (n * MBLK + 32 * ck + 4 * half + cr); if (dist < 0) y = -INFINITY; }
            if (MODE == 0) m = fmaxf(m, y);
            else { const float p = __builtin_amdgcn_exp2f(y - mref); lsum += p; S[r] = p; } }
        if (MODE != 0) {
            bf16x8 pf0, pf1;
            { v4u w0, w1; w0.x = cvtpk(S[0], S[1]); w0.y = cvtpk(S[2], S[3]); w0.z = cvtpk(S[4], S[5]); w0.w = cvtpk(S[6], S[7]);
              w1.x = cvtpk(S[8], S[9]); w1.y = cvtpk(S[10], S[11]); w1.z = cvtpk(S[12], S[13]); w1.w = cvtpk(S[14], S[15]);
              pf0 = __builtin_bit_cast(bf16x8, w0); pf1 = __builtin_bit_cast(bf16x8, w1); }
#pragma unroll
            for (int sp = 0; sp < 2; ++sp)
#pragma unroll
                for (int dt = 0; dt < 2; ++dt) {
                    const v4i16_t lo = lds_tr(trb + sp * 16 * MB_VP + dt * 64), hi = lds_tr(trb + sp * 16 * MB_VP + dt * 64 + 8 * MB_VP);
                    const bf16x8 a = (bf16x8){lo[0], lo[1], lo[2], lo[3], hi[0], hi[1], hi[2], hi[3]};
                    if (dt == 0) O0 = mfma32(a, sp ? pf1 : pf0, O0); else O1 = mfma32(a, sp ? pf1 : pf0, O1); }
        }
#pragma unroll
        for (int i = 0; i < 4; ++i) kr[i] = kn[i];
        if (MODE != 0) {
#pragma unroll
            for (int i = 0; i < 4; ++i) vr[i] = vn[i]; }
    }
    if (MODE == 0) mref = fmaxf(m, __shfl_xor(m, 32));
}

typedef unsigned u32x2 __attribute__((ext_vector_type(2)));
#define MPARGS GAS bf16* Po00, GAS bf16* Po01, GAS bf16* Po10, GAS bf16* Po11, GAS bf16* Po20, GAS bf16* Po21, GAS float* Pl
#define MPPASS Po00, Po01, Po10, Po11, Po20, Po21, Pl
__device__ __forceinline__ void moba_unit(Frame& F, const bf16* U, const bf16* kmb, const float* relb, bf16* mix, MPARGS, int h, int b) {
    const int lane = fresh_lane(), wave = F.wave, half = lane >> 5, l31 = lane & 31, tid = wave * 64 + lane;
    LAS unsigned char* L = F.lds + RING_OFF;
    LAS float* oacc = (LAS float*)(L + MB_OACC); LAS float* lacc = (LAS float*)(L + MB_LACC); LAS float* mrefs = (LAS float*)(L + MB_MREF);
    LAS int* cnt = (LAS int*)(L + MB_CNT); LAS int* offs = (LAS int*)(L + MB_OFFS); LAS unsigned short* list = (LAS unsigned short*)(L + MB_LIST); LAS unsigned char* nsel = L + MB_NSEL;
    LAS unsigned char* vst = L + MB_VST + wave * MB_VSTW; LAS const float* rtab = (LAS const float*)(L + MB_BTAB);
    const float cbias = relb[31 * 8 + h] * LOG2E;
    if (tid < 64) cnt[tid] = 0;
    for (int j = tid; j < MB_NTAB; j += NWAVES * 64) { const int dist = 3327 - j; ((LAS float*)(L + MB_BTAB))[j] = relb[rel_bucket(dist < 0 ? 0 : dist) * 8 + h] * LOG2E; }
    __syncthreads();
    const int qi = wave * 32 + l31, qpos = b * MBLK + qi;
    float g0 = -INFINITY, g1 = -INFINITY, g2 = -INFINITY; int i0 = -1, i1 = -1, i2 = -1;
    if (b > 0) {
        bf16x8 qf[4];
        { const bf16* qp = U + (size_t)qpos * UWID + U_QM + h * 64 + 8 * half;
#pragma unroll
          for (int s = 0; s < 4; ++s) qf[s] = *(const bf16x8*)(qp + 16 * s); }
#pragma unroll
        for (int nt = 0; nt < 2; ++nt) if (32 * nt < b) {
            const bf16* ap = kmb + (size_t)(h * NBLK + 32 * nt + l31) * 64 + 8 * half;
            f32x16 G;
#pragma unroll
            for (int r = 0; r < 16; ++r) G[r] = 0.f;
#pragma unroll
            for (int s = 0; s < 4; ++s) G = mfma32(*(const bf16x8*)(ap + 16 * s), qf[s], G);
#pragma unroll
            for (int r = 0; r < 16; ++r) { const int nn = 32 * nt + (r & 3) + 8 * (r >> 2) + 4 * half; const float v = (nn < b) ? G[r] : -INFINITY;
                if (v > g0) { g2 = g1; i2 = i1; g1 = g0; i1 = i0; g0 = v; i0 = nn; }
                else if (v > g1) { g2 = g1; i2 = i1; g1 = v; i1 = nn; }
                else if (v > g2) { g2 = v; i2 = nn; } }
        }
        float pg[3]; int pi[3];
        pg[0] = __shfl_xor(g0, 32); pg[1] = __shfl_xor(g1, 32); pg[2] = __shfl_xor(g2, 32); pi[0] = __shfl_xor(i0, 32); pi[1] = __shfl_xor(i1, 32); pi[2] = __shfl_xor(i2, 32);
#pragma unroll
        for (int k = 0; k < 3; ++k) { const float v = pg[k]; const int nn = pi[k];
            if (nn >= 0) {
                if (v > g0 || (v == g0 && nn < i0)) { g2 = g1; i2 = i1; g1 = g0; i1 = i0; g0 = v; i0 = nn; }
                else if (v > g1 || (v == g1 && nn < i1)) { g2 = g1; i2 = i1; g1 = v; i1 = nn; }
                else if (v > g2 || (v == g2 && nn < i2)) { g2 = v; i2 = nn; } } }
    }
    int r0 = 0, r1 = 0, r2 = 0;
    if (half == 0) { if (i0 >= 0) r0 = __hip_atomic_fetch_add(cnt + i0, 1, __ATOMIC_RELAXED, __HIP_MEMORY_SCOPE_WORKGROUP); if (i1 >= 0) r1 = __hip_atomic_fetch_add(cnt + i1, 1, __ATOMIC_RELAXED, __HIP_MEMORY_SCOPE_WORKGROUP); if (i2 >= 0) r2 = __hip_atomic_fetch_add(cnt + i2, 1, __ATOMIC_RELAXED, __HIP_MEMORY_SCOPE_WORKGROUP); }
    __syncthreads();
    if (wave == 0) { const int c = cnt[lane]; int inc = c;
#pragma unroll
        for (int o = 1; o < 64; o <<= 1) { const int t = __shfl_up(inc, o); if (lane >= o) inc += t; }
        offs[lane] = inc - c; }
    __syncthreads();
    if (half == 0) { if (i0 >= 0) list[offs[i0] + r0] = (unsigned short)qi; if (i1 >= 0) list[offs[i1] + r1] = (unsigned short)(qi | 0x100); if (i2 >= 0) list[offs[i2] + r2] = (unsigned short)(qi | 0x200);
                      nsel[qi] = (unsigned char)((i0 >= 0) + (i1 >= 0) + (i2 >= 0)); }
    {
        float mref = 0.f, lsum = 0.f; f32x16 O0, O1;
#pragma unroll
        for (int r = 0; r < 16; ++r) { O0[r] = 0.f; O1[r] = 0.f; }
        moba_tile<0>(U, h, b, wave + 1, qpos, mref, vst, rtab, true, cbias, O0, O1, lsum, lane);
        moba_tile<1>(U, h, b, wave + 1, qpos, mref, vst, rtab, true, cbias, O0, O1, lsum, lane);
#pragma unroll
        for (int r = 0; r < 16; ++r) { const int d = (r & 3) + 8 * (r >> 2) + 4 * half; oacc[qi * MB_OP + d] = O0[r]; oacc[qi * MB_OP + 32 + d] = O1[r]; }
        lsum += __shfl_xor(lsum, 32);
        if (half == 0) { lacc[qi] = lsum; mrefs[qi] = mref; }
    }
    __syncthreads();
    { int tcount = 0;
      for (int n = 0; n < b; ++n) { const int c = __builtin_amdgcn_readfirstlane(cnt[n]), o = __builtin_amdgcn_readfirstlane(offs[n]);
        for (int t0 = 0; t0 < c; t0 += 32, ++tcount) { if ((tcount & 7) != wave) continue;
            const bool qv = (t0 + l31) < c; const int ge = list[o + (qv ? t0 + l31 : 0)]; const int gq = ge & 255, slot = ge >> 8; const int gpos = b * MBLK + gq;
            float mref = mrefs[gq], lsum = 0.f; f32x16 O0, O1;
#pragma unroll
            for (int r = 0; r < 16; ++r) { O0[r] = 0.f; O1[r] = 0.f; }
            moba_tile<2>(U, h, n, 8, gpos, mref, vst, rtab, (b - n) <= 12, cbias, O0, O1, lsum, lane);
            lsum += __shfl_xor(lsum, 32);
            if (qv) { const size_t row = (size_t)gpos * 8 + h;
                GAS bf16* p0 = (slot == 0 ? Po00 : slot == 1 ? Po10 : Po20) + row * 32 + 4 * half;
                GAS bf16* p1 = (slot == 0 ? Po01 : slot == 1 ? Po11 : Po21) + row * 32 + 4 * half;
#pragma unroll
                for (int rg = 0; rg < 4; ++rg) { u32x2 w0, w1; w0.x = cvtpk(O0[4 * rg], O0[4 * rg + 1]); w0.y = cvtpk(O0[4 * rg + 2], O0[4 * rg + 3]); w1.x = cvtpk(O1[4 * rg], O1[4 * rg + 1]); w1.y = cvtpk(O1[4 * rg + 2], O1[4 * rg + 3]);
                    *(GAS u32x2*)(p0 + 8 * rg) = w0; *(GAS u32x2*)(p1 + 8 * rg) = w1; }
                if (half == 0) Pl[row * 4 + slot] = lsum; }
        } } }
    __syncthreads();
    { const int q = tid >> 1, dh = tid & 1; const int ns = nsel[q]; const size_t row = (size_t)(b * MBLK + q) * 8 + h; LAS const float* op = oacc + q * MB_OP + 32 * dh;
      float acc[32]; float l = lacc[q];
#pragma unroll
      for (int i = 0; i < 32; ++i) acc[i] = op[i];
#pragma unroll
      for (int j = 0; j < 3; ++j) if (j < ns) { const GAS bf16* pp = (j == 0 ? (dh ? Po01 : Po00) : j == 1 ? (dh ? Po11 : Po10) : (dh ? Po21 : Po20)) + row * 32; l += Pl[row * 4 + j];
#pragma unroll
          for (int i = 0; i < 4; ++i) { const v4u w = *(const GAS v4u*)(pp + 8 * i);
              acc[8 * i + 0] += bf_lo2(w.x); acc[8 * i + 1] += bf_hi2(w.x); acc[8 * i + 2] += bf_lo2(w.y); acc[8 * i + 3] += bf_hi2(w.y);
              acc[8 * i + 4] += bf_lo2(w.z); acc[8 * i + 5] += bf_hi2(w.z); acc[8 * i + 6] += bf_lo2(w.w); acc[8 * i + 7] += bf_hi2(w.w); } }
      const float inv = 1.0f / l;
      bf16* dst = mix + (size_t)(b * MBLK + q) * D + 512 + h * 64 + 32 * dh;
#pragma unroll
      for (int i = 0; i < 4; ++i) { v4u w; w.x = pk2(acc[8 * i] * inv, acc[8 * i + 1] * inv); w.y = pk2(acc[8 * i + 2] * inv, acc[8 * i + 3] * inv); w.z = pk2(acc[8 * i + 4] * inv, acc[8 * i + 5] * inv); w.w = pk2(acc[8 * i + 6] * inv, acc[8 * i + 7] * inv);
          *(GAS v4u*)(dst + 8 * i) = w; } }
    __syncthreads();
}
__device__ __forceinline__ void moba_phase(Frame& F, const bf16* U, const bf16* kmb, const float* relb, bf16* mix, MPARGS) {
    const int h = F.vcu >> 5, bb = F.vcu & 31;
    if (F.G != 256) return;
    moba_unit(F, U, kmb, relb, mix, MPPASS, h, bb);
    moba_unit(F, U, kmb, relb, mix, MPPASS, h, 63 - bb);
}
constexpr int GA_KD = 0, GA_KDP = 160, GA_V = 40960, GA_VP = 288, GA_SEG = GA_V + 256 * GA_VP;
constexpr int GC_KE = 0, GC_KEP = 144, GC_V = 36864, GC_VP = 288, GC_SST = GC_V + 256 * GC_VP, GC_SSTP = 144;
static_assert(GA_SEG + 2048 <= RING_BYTES && GC_SST + 128 * GC_SSTP <= RING_BYTES, "GLA LDS map");
__device__ __forceinline__ bf16x8 tr_pair(LAS unsigned char* p, int second_off) { const v4i16_t lo = lds_tr(p), hi = lds_tr(p + second_off); return (bf16x8){lo[0], lo[1], lo[2], lo[3], hi[0], hi[1], hi[2], hi[3]}; }

__device__ __forceinline__ void gla_A(Frame& F, const bf16* U, float* loga, float* dS, float* dec) {
    if (F.G != 256) return;
    const int c = F.vcu >> 2, h = F.vcu & 3, lane = fresh_lane(), wave = F.wave, tid = wave * 64 + lane;
    LAS unsigned char* L = F.lds + RING_OFF; LAS float* segtot = (LAS float*)(L + GA_SEG);
    const int d = lane, seg = wave, t0 = c * 256 + seg * 32;
    float bl[32]; float run = 0.f;
#pragma unroll
    for (int i = 0; i < 32; ++i) { run += loga[(size_t)(t0 + i) * 256 + h * 64 + d]; bl[i] = run; }
    segtot[seg * 64 + d] = run;
#pragma unroll
    for (int i = 0; i < 8; ++i) { const int p = tid + 512 * i, row = p >> 4, ch = p & 15;
        *(LAS v4u*)(L + GA_V + row * GA_VP + ch * 16) = *(const v4u*)(U + (size_t)(c * 256 + row) * UWID + U_VG + h * 128 + ch * 8); }
    __syncthreads();
    float pre = 0.f, tot = 0.f;
#pragma unroll
    for (int s = 0; s < 8; ++s) { const float v = segtot[s * 64 + d]; tot += v; if (s < seg) pre += v; }
#pragma unroll
    for (int i = 0; i < 32; ++i) { const float b = bl[i] + pre; loga[(size_t)(t0 + i) * 256 + h * 64 + d] = b;
        const float kk = bf2f(U[(size_t)(t0 + i) * UWID + U_KG + h * 64 + d]);
        *(LAS bf16*)(L + GA_KD + (seg * 32 + i) * GA_KDP + d * 2) = (bf16)f2bf(kk * __expf(tot - b)); }
    if (seg == 0) dec[(size_t)(c * 4 + h) * 64 + d] = __expf(tot);
    __syncthreads();
    const int et = wave >> 1, dt = wave & 1, half = lane >> 5, l31 = lane & 31, g1 = (lane >> 4) & 1, q = (lane & 15) >> 2, p = lane & 3;
    LAS unsigned char* trA = L + GA_V + (4 * half + q) * GA_VP + (32 * et + 16 * g1 + 4 * p) * 2;
    LAS unsigned char* trB = L + GA_KD + (4 * half + q) * GA_KDP + (32 * dt + 16 * g1 + 4 * p) * 2;
    f32x16 acc;
#pragma unroll
    for (int r = 0; r < 16; ++r) acc[r] = 0.f;
#pragma unroll 4
    for (int s = 0; s < 16; ++s) { const bf16x8 a = tr_pair(trA + s * 16 * GA_VP, 8 * GA_VP), b = tr_pair(trB + s * 16 * GA_KDP, 8 * GA_KDP); acc = mfma32(a, b, acc); }
    float* dst = dS + (size_t)(c * 4 + h) * 8192;
#pragma unroll
    for (int r = 0; r < 16; ++r) { const int e = 32 * et + (r & 3) + 8 * (r >> 2) + 4 * half; dst[e * 64 + 32 * dt + l31] = acc[r]; }
    __syncthreads();
}
__device__ __forceinline__ void gla_scan(Frame& F, const float* dS, const float* dec, bf16* Sst) {
    const int lane = fresh_lane(), tid = F.wave * 64 + lane;
    if (tid >= 128 || F.G != 256) return;
    const int idx = F.vcu * 128 + tid, h = idx >> 13, d = idx & 63, el = idx & 8191;
    float S = 0.f;
#pragma unroll 1
    for (int c0 = 0; c0 < 64; c0 += 32) {
        float ds[32], dc[32];
#pragma unroll
        for (int c = 0; c < 32; ++c) { ds[c] = dS[(size_t)((c0 + c) * 4 + h) * 8192 + el]; dc[c] = dec[(size_t)((c0 + c) * 4 + h) * 64 + d]; }
#pragma unroll
        for (int c = 0; c < 32; ++c) { Sst[(size_t)((c0 + c) * 4 + h) * 8192 + el] = (bf16)f2bf(S); S = dc[c] * S + ds[c]; }
    }
}
__device__ __forceinline__ void gla_C(Frame& F, const bf16* U, const float* bcum, const bf16* Sst, const float* gain, bf16* mix) {
    if (F.G != 256) return;
    const int c = F.vcu >> 2, h = F.vcu & 3, lane = fresh_lane(), wave = F.wave, tid = wave * 64 + lane;
    LAS unsigned char* L = F.lds + RING_OFF;
    { const int d = lane, seg = wave, t0 = c * 256 + seg * 32;
#pragma unroll 8
      for (int i = 0; i < 32; ++i) { const float b = bcum[(size_t)(t0 + i) * 256 + h * 64 + d]; const float kk = bf2f(U[(size_t)(t0 + i) * UWID + U_KG + h * 64 + d]);
          *(LAS bf16*)(L + GC_KE + (seg * 32 + i) * GC_KEP + d * 2) = (bf16)f2bf(kk * __expf(-b)); } }
#pragma unroll
    for (int i = 0; i < 8; ++i) { const int p = tid + 512 * i, row = p >> 4, ch = p & 15;
        *(LAS v4u*)(L + GC_V + row * GC_VP + ch * 16) = *(const v4u*)(U + (size_t)(c * 256 + row) * UWID + U_VG + h * 128 + ch * 8); }
#pragma unroll
    for (int i = 0; i < 2; ++i) { const int p = tid + 512 * i, row = p >> 3, ch = p & 7;
        *(LAS v4u*)(L + GC_SST + row * GC_SSTP + ch * 16) = *(const v4u*)(Sst + (size_t)((c * 4 + h) * 128 + row) * 64 + ch * 8); }
    __syncthreads();
    const int half = lane >> 5, l31 = lane & 31, g1 = (lane >> 4) & 1, q = (lane & 15) >> 2, p = lane & 3;
    const size_t tok = (size_t)c * 256 + wave * 32 + l31;
    bf16x8 qf[4];
#pragma unroll
    for (int s = 0; s < 4; ++s) { const v4u q8 = *(const v4u*)(U + tok * UWID + U_QG + h * 64 + 16 * s + 8 * half);
        const f32x4 b0 = *(const f32x4*)(bcum + tok * 256 + h * 64 + 16 * s + 8 * half), b1 = *(const f32x4*)(bcum + tok * 256 + h * 64 + 16 * s + 8 * half + 4);
        v4u w; w.x = cvtpk(bf_lo2(q8.x) * __expf(b0[0]), bf_hi2(q8.x) * __expf(b0[1])); w.y = cvtpk(bf_lo2(q8.y) * __expf(b0[2]), bf_hi2(q8.y) * __expf(b0[3]));
        w.z = cvtpk(bf_lo2(q8.z) * __expf(b1[0]), bf_hi2(q8.z) * __expf(b1[1])); w.w = cvtpk(bf_lo2(q8.w) * __expf(b1[2]), bf_hi2(q8.w) * __expf(b1[3]));
        qf[s] = __builtin_bit_cast(bf16x8, w); }
    f32x16 O[4];
#pragma unroll
    for (int et = 0; et < 4; ++et)
#pragma unroll
        for (int r = 0; r < 16; ++r) O[et][r] = 0.f;
#pragma unroll
    for (int et = 0; et < 4; ++et)
#pragma unroll
        for (int s = 0; s < 4; ++s) O[et] = mfma32(*(LAS const bf16x8*)(L + GC_SST + (32 * et + l31) * GC_SSTP + (16 * s + 8 * half) * 2), qf[s], O[et]);
    LAS unsigned char* trV = L + GC_V + (4 * half + q) * GC_VP + (16 * g1 + 4 * p) * 2;
    for (int jt = 0; jt <= wave; ++jt) {
        f32x16 ST;
#pragma unroll
        for (int r = 0; r < 16; ++r) ST[r] = 0.f;
#pragma unroll
        for (int s = 0; s < 4; ++s) ST = mfma32(*(LAS const bf16x8*)(L + GC_KE + (32 * jt + l31) * GC_KEP + (16 * s + 8 * half) * 2), qf[s], ST);
        if (jt == wave) {
#pragma unroll
            for (int r = 0; r < 16; ++r) { const int jl = (r & 3) + 8 * (r >> 2) + 4 * half; if (jl > l31) ST[r] = 0.f; } }
        bf16x8 pf0, pf1;
        { v4u w0, w1; w0.x = cvtpk(ST[0], ST[1]); w0.y = cvtpk(ST[2], ST[3]); w0.z = cvtpk(ST[4], ST[5]); w0.w = cvtpk(ST[6], ST[7]);
          w1.x = cvtpk(ST[8], ST[9]); w1.y = cvtpk(ST[10], ST[11]); w1.z = cvtpk(ST[12], ST[13]); w1.w = cvtpk(ST[14], ST[15]);
          pf0 = __builtin_bit_cast(bf16x8, w0); pf1 = __builtin_bit_cast(bf16x8, w1); }
#pragma unroll
        for (int sp = 0; sp < 2; ++sp)
#pragma unroll
            for (int et = 0; et < 4; ++et) { const bf16x8 a = tr_pair(trV + (32 * jt + 16 * sp) * GC_VP + et * 64, 8 * GC_VP); O[et] = mfma32(a, sp ? pf1 : pf0, O[et]); }
    }
    float ss = 0.f;
#pragma unroll
    for (int et = 0; et < 4; ++et)
#pragma unroll
        for (int r = 0; r < 16; ++r) ss += O[et][r] * O[et][r];
    ss += __shfl_xor(ss, 32);
    const float rs = 1.0f / sqrtf(ss * (1.0f / 128.0f) + EPS);
#pragma unroll
    for (int et = 0; et < 4; ++et)
#pragma unroll
        for (int rg = 0; rg < 4; ++rg) { const int e0 = 32 * et + 8 * rg + 4 * half;
            const uint2 gw = *(const uint2*)(U + tok * UWID + U_GG + h * 128 + e0); const f32x4 gn = *(const f32x4*)(gain + e0);
            const float g0 = bf_lo2(gw.x), g1v = bf_hi2(gw.x), g2 = bf_lo2(gw.y), g3 = bf_hi2(gw.y);
            const float y0 = O[et][4 * rg + 0] * rs * gn[0] * (g0 / (1.0f + __expf(-g0))), y1 = O[et][4 * rg + 1] * rs * gn[1] * (g1v / (1.0f + __expf(-g1v)));
            const float y2 = O[et][4 * rg + 2] * rs * gn[2] * (g2 / (1.0f + __expf(-g2))), y3 = O[et][4 * rg + 3] * rs * gn[3] * (g3 / (1.0f + __expf(-g3)));
            uint2 o; o.x = cvtpk(y0, y1); o.y = cvtpk(y2, y3);
            *(uint2*)(mix + tok * D + h * 128 + e0) = o; }
    __syncthreads();
}
__device__ __forceinline__ void final_norm(Frame& F, float* out, const float* ssqp, const float* gain) {
    const int gw = F.vcu * NWAVES + F.wave, NGW = F.G * NWAVES, lane = fresh_lane();
    for (int m = gw; m < M; m += NGW) {
        float s = (lane < 16) ? ssqp[(size_t)m * 16 + lane] : 0.f; s = wave_sum(s);
        const float rs = 1.0f / sqrtf(s * (1.0f / 1024.0f) + EPS);
        GAS f32x4* xr = (GAS f32x4*)(out + (size_t)m * D) + lane;
#pragma unroll
        for (int j = 0; j < 4; ++j) { f32x4 v = xr[64 * j]; const f32x4 g = ((const GAS f32x4*)gain)[lane + 64 * j]; v = v * rs * g; xr[64 * j] = v; }
    }
}
struct PpOrder { int c, nu;
    __device__ __forceinline__ bool next(int i, pg8::Unit& u) const { if (c < 128 || i >= nu) return false; const int L = (c - 128) + 128 * i; u.pm = L >> 2; u.pn = L & 3; return true; }
    __device__ __forceinline__ void a_ready(const pg8::Unit&) const {}
    __device__ __forceinline__ void done(const pg8::Unit&) const {} };
__global__ void __launch_bounds__(NWAVES * 64, 2) mega_fwd(Args args) {
    extern __shared__ __attribute__((aligned(16))) unsigned char lds[];
    Frame F;
    F.lds = (LAS unsigned char*)lds;
    F.MISC = (volatile LAS unsigned*)(F.lds + MISC_OFF);
    F.tid = threadIdx.x; F.lane = F.tid & 63; F.wave = __builtin_amdgcn_readfirstlane(F.tid >> 6);
    F.G = gridDim.x; { const int bx = blockIdx.x; F.vcu = (F.G % 8 == 0) ? (bx % 8) * (F.G / 8) + bx / 8 : bx; }
    unsigned char* ws = args.ws;
    F.ctl = (gu32*)(ws + WS_CTL);
    for (int u = F.tid; u < (LDS_BYTES - LDSCTL_OFF) / 4; u += NWAVES * 64) ((LAS unsigned*)(F.lds + LDSCTL_OFF))[u] = 0u;
    __syncthreads();
    XcdBarrier bar; bar.bar = (unsigned*)(F.ctl + CW_BAR); bar.x = 0; bar.st = nullptr;
    if (N_LAUNCHES != N_PHASES) bar = xcd_barrier_post((unsigned*)(F.ctl + CW_BAR), F.MISC + 8);
#define GRID_BAR() do { if (N_LAUNCHES == N_PHASES) { if (F.tid == 0) __hip_atomic_store(F.ctl + CW_TMO, 0xBADBA0u, RLX_AGENT); } else { xcd_barrier(bar); } } while (0)
    const int lo = args.ph_lo, hi = args.ph_hi;
#define IN(k) (lo <= (k) && (k) < hi)
#define BOTH(k) (IN(k) && IN((k) + 1))
    using pg8::Gemm; using pg8::StaticOrder;
#define RUN_GEMM(EPI, A_, B_, N_, K_, ...) do { Gemm g{A_, B_, M, N_, K_}; StaticOrder S; S.init(M, N_, F.G, (int)blockIdx.x); pg8::EPI E{__VA_ARGS__}; \
        pg8::gemm_phase<pg8::EPI, StaticOrder, PG8_ALIGN, PG8_SP2>(F.lds + RING_OFF, g, S, E); } while (0)
#define WSB() GAS unsigned char* w_ = (GAS unsigned char*)args.ws; GAS float* out_ = (GAS float*)args.out; asm volatile("" : "+s"(w_), "+s"(out_)); float* out = (float*)out_
#define PB16(off) ((bf16*)(w_ + (off)))
#define PF32(off) ((float*)(w_ + (off)))
#define PHASE(k, ...) if (IN(k)) { WSB(); __VA_ARGS__; if (BOTH(k)) GRID_BAR(); }
    PHASE(0, p0_prologue(F, args))
    PHASE(1, RUN_GEMM(EpiSwiGLU, PB16(WS_MIX), PB16(WS_WGU1), NGU, D, PB16(WS_U), FF, PF32(WS_SSQ1));
             if (F.G == 256 && blockIdx.x >= 128) convert_weights<1>(F, args, ((int)blockIdx.x - 128) * NWAVES + F.wave, 128 * NWAVES); else if (F.G != 256) convert_weights<1>(F, args, F.vcu * NWAVES + F.wave, F.G * NWAVES))
    PHASE(2, RUN_GEMM(EpiResid<1>, PB16(WS_U), PB16(WS_WD1), D, FF, PB16(WS_MIX), (bf16*)out, PF32(WS_SSQ2))    )
    PHASE(3, RUN_GEMM(EpiWin, (bf16*)out, PB16(WS_WIN), UWID, D, PB16(WS_U), PF32(WS_LOGA), PF32(WS_SSQ2), args.in[8]);
             if (F.G == 256 && blockIdx.x >= 64) convert_weights<2>(F, args, ((int)blockIdx.x - 64) * NWAVES + F.wave, 192 * NWAVES); else if (F.G != 256) convert_weights<2>(F, args, F.vcu * NWAVES + F.wave, F.G * NWAVES))
    PHASE(4, moba_kmean(F, PB16(WS_U), PB16(WS_KMEAN)); gla_A(F, PB16(WS_U), PF32(WS_LOGA), PF32(WS_HB), PF32(WS_HB + 12 * MiB)))
    PHASE(5, gla_scan(F, PF32(WS_HB), PF32(WS_HB + 12 * MiB), PB16(WS_HB + 8 * MiB)); moba_phase(F, PB16(WS_U), PB16(WS_KMEAN), args.in[17], PB16(WS_MIX), (GAS bf16*)(w_ + 1 * MiB), (GAS bf16*)(w_ + 9 * MiB), (GAS bf16*)(w_ + 67 * MiB), (GAS bf16*)(w_ + 75 * MiB), (GAS bf16*)(w_ + 17 * MiB), (GAS bf16*)(w_ + 246 * MiB), (GAS float*)(w_ + 254 * MiB)))
    PHASE(6, gla_C(F, PB16(WS_U), PF32(WS_LOGA), PB16(WS_HB + 8 * MiB), args.in[9], PB16(WS_MIX)))
    PHASE(7, RUN_GEMM(EpiResid<0>, PB16(WS_MIX), PB16(WS_WOUT), D, D, (bf16*)out, PB16(WS_HB), PF32(WS_SSQ3)))
    PHASE(8, RUN_GEMM(EpiSwiGLU, PB16(WS_HB), PB16(WS_WGU2), NGU, D, PB16(WS_U), FF, PF32(WS_SSQ3));
             { int kpp = DPLE, two = 2; asm volatile("" : "+s"(kpp), "+s"(two)); Gemm g{PB16(WS_PB), PB16(WS_WPP), M, D, kpp}; PpOrder S{F.G == 256 ? (int)blockIdx.x : -1, two}; pg8::EpiPlain E{PB16(WS_PP)}; pg8::gemm_phase<pg8::EpiPlain, PpOrder, PG8_ALIGN, PG8_SP2>(F.lds + RING_OFF, g, S, E); })
    PHASE(9, RUN_GEMM(EpiResid<1>, PB16(WS_U), PB16(WS_WD2), D, FF, PB16(WS_HB), PB16(WS_HB), PF32(WS_SSQ4)))
    PHASE(10, RUN_GEMM(EpiPle, PB16(WS_HB), PB16(WS_WPG), D, D, PB16(WS_HB), out, PB16(WS_PP), PF32(WS_SSQ4), PF32(WS_SSQ5)))
    if (IN(11)) { WSB(); final_norm(F, out, PF32(WS_SSQ5), args.in[18]); }
#undef IN
#undef BOTH
}

extern "C" void kernel_launch(void* const* d_in, const int* in_sizes, int n_in, void* d_out, int out_size, void* d_ws, size_t ws_size, hipStream_t stream) {
    static int grid = 0;
    if (grid == 0) {
        if (n_in != 19 || in_sizes[0] != M * D || out_size != M * D || ws_size < WS_END) { fprintf(stderr, "kernel_launch: unexpected shapes (n_in %d, in0 %d, out %d, ws %zu); nothing launched\n", n_in, n_in > 0 ? in_sizes[0] : -1, out_size, ws_size); grid = -1; return; }
        int dev = 0, cus = 0, per_cu = 0;
        if (hipGetDevice(&dev) != hipSuccess || hipDeviceGetAttribute(&cus, hipDeviceAttributeMultiprocessorCount, dev) != hipSuccess) { grid = -1; return; }
        if (hipFuncSetAttribute((const void*)mega_fwd, hipFuncAttributeMaxDynamicSharedMemorySize, LDS_BYTES) != hipSuccess) { fprintf(stderr, "kernel_launch: hipFuncSetAttribute failed\n"); grid = -1; return; }
        if (hipOccupancyMaxActiveBlocksPerMultiprocessor(&per_cu, (const void*)mega_fwd, NWAVES * 64, LDS_BYTES) != hipSuccess || per_cu < 1) { fprintf(stderr, "kernel_launch: occupancy query reports %d workgroups per CU\n", per_cu); }
        (void)hipGetLastError();
        grid = cus;
    }
    if (grid < 0) return;
    if (hipMemsetAsync((char*)d_ws + WS_CTL, 0, CTL_ZERO_BYTES, stream) != hipSuccess) { fprintf(stderr, "kernel_launch: hipMemsetAsync failed\n"); return; }
    Args a{};
    for (int i = 0; i < 19; ++i) a.in[i] = (const float*)d_in[i];
    a.out = (float*)d_out; a.ws = (unsigned char*)d_ws;
    for (int li = 0; li < N_LAUNCHES; ++li) {
        if (N_LAUNCHES == 1) { a.ph_lo = 0; a.ph_hi = N_PHASES; } else { a.ph_lo = li; a.ph_hi = li + 1; }
        a.li = li;
        hipLaunchKernelGGL(mega_fwd, dim3(grid), dim3(NWAVES * 64), LDS_BYTES, stream, a);
        const hipError_t le = hipPeekAtLastError();
        if (le != hipSuccess) { fprintf(stderr, "kernel_launch: launch %d failed: %s\n", li, hipGetErrorName(le)); break; }
    }
}
```
